# Optimizing an MI355X kernel written in HIP

```python
import math
import jax
import jax.numpy as jnp
from jax import lax
import numpy as np

D_MODEL = 1024
BATCH = 4
SEQ = 8192
DEPTH = 4

GRID_W = 64
CTX_LEN = 256
EPS = 1e-6
ROPE_THETA = 10000.0
ROT_DIM = 32
Q_BLOCK = 128

DA_HEADS = 6
DA_DIM = ROT_DIM
DA_VDIM = 2 * DA_DIM
DA_W = DA_HEADS * DA_VDIM

MLA_HEADS = 6
MLA_Q_RANK = 256
MLA_KV_RANK = 128
MLA_NOPE = 64
MLA_ROPE = ROT_DIM
MLA_VDIM = 64
MLA_W = MLA_HEADS * MLA_VDIM

HG_HEADS = 4
HG_KDIM = 128
HG_VDIM = 64
HG_CHUNK = 64
HG_KW = HG_HEADS * HG_KDIM
HG_VW = HG_HEADS * HG_VDIM
FORGET_FLOOR = 1e-30

D_MIX = DA_W + MLA_W + HG_VW
D_IN = 3 * DA_W + MLA_Q_RANK + MLA_KV_RANK + MLA_ROPE + 3 * HG_KW + 2 * HG_VW
D_FF = 4 * D_MODEL
N_MOD = 6

kernel_name = 'hybrid_parallel_group_dit_block'


def rmsnorm(x, g):
    xf = x.astype(jnp.float32)
    y = xf * lax.rsqrt(jnp.mean(jnp.square(xf), axis=-1, keepdims=True) + EPS)
    return (y * g.astype(jnp.float32)).astype(x.dtype)


def ada_norm(x, g, shift, scale):
    return rmsnorm(x, g) * (1 + scale[..., None, :]) + shift[..., None, :]


def axial_rope_tables(n):
    rows = n // GRID_W
    row = jnp.repeat(jnp.arange(rows, dtype=jnp.float32), GRID_W)
    col = jnp.tile(jnp.arange(GRID_W, dtype=jnp.float32), rows)
    n_freq = ROT_DIM // 4
    inv = ROPE_THETA ** (-jnp.arange(n_freq, dtype=jnp.float32) / n_freq)
    ang = jnp.stack([row[:, None] * inv, col[:, None] * inv], axis=1)
    return jnp.cos(ang), jnp.sin(ang)


def apply_rope(x, cos, sin):
    shp = x.shape
    xr = x.astype(jnp.float32).reshape(shp[:-1] + (2, 2, shp[-1] // 4))
    cc = cos[None, :, None]
    ss = sin[None, :, None]
    x1 = xr[..., 0, :]
    x2 = xr[..., 1, :]
    out = jnp.stack([x1 * cc - x2 * ss, x2 * cc + x1 * ss], axis=-2)
    return out.reshape(shp).astype(x.dtype)


def project(h, w_in, w_uq, w_ukv, g_cq, g_ckv, rope):
    bsz, n = h.shape[0], h.shape[1]
    p = jnp.einsum('bnd,de->bne', h, w_in)
    sizes = (DA_W, DA_W, DA_W, MLA_Q_RANK, MLA_KV_RANK, MLA_ROPE, HG_KW, HG_KW, HG_KW, HG_VW, HG_VW)
    idx = []
    acc = 0
    for s in sizes[:-1]:
        acc += s
        idx.append(acc)
    da_q, da_k, da_v, cq, ckv, kr, hq, hzf, hzb, hv, hgate = jnp.split(p, idx, axis=-1)
    da_q = da_q.reshape(bsz, n, DA_HEADS * 2, DA_DIM)
    da_k = da_k.reshape(bsz, n, DA_HEADS * 2, DA_DIM)
    qu = (rmsnorm(cq, g_cq) @ w_uq).reshape(bsz, n, MLA_HEADS, MLA_NOPE + MLA_ROPE)
    kvu = (rmsnorm(ckv, g_ckv) @ w_ukv).reshape(bsz, n, MLA_HEADS, MLA_NOPE + MLA_VDIM)
    q_nope, q_rope = qu[..., :MLA_NOPE], qu[..., MLA_NOPE:]
    k_nope, mla_v = kvu[..., :MLA_NOPE], kvu[..., MLA_NOPE:]
    kr = kr[:, :, None, :]
    if rope is not None:
        cos, sin = rope
        da_q = apply_rope(da_q, cos, sin)
        da_k = apply_rope(da_k, cos, sin)
        q_rope = apply_rope(q_rope, cos, sin)
        kr = apply_rope(kr, cos, sin)
    return {
        'da_q': da_q.reshape(bsz, n, DA_HEADS, 2, DA_DIM),
        'da_k': da_k.reshape(bsz, n, DA_HEADS, 2, DA_DIM),
        'da_v': da_v.reshape(bsz, n, DA_HEADS, DA_VDIM),
        'q_nope': q_nope, 'q_rope': q_rope, 'k_nope': k_nope, 'k_rope': kr[:, :, 0], 'mla_v': mla_v,
        'hg_q': hq.reshape(bsz, n, HG_HEADS, HG_KDIM),
        'hg_zf': hzf.reshape(bsz, n, HG_HEADS, HG_KDIM),
        'hg_zb': hzb.reshape(bsz, n, HG_HEADS, HG_KDIM),
        'hg_v': hv.reshape(bsz, n, HG_HEADS, HG_VDIM),
        'hg_gate': hgate.reshape(bsz, n, HG_HEADS, HG_VDIM),
    }


def sweep_query_blocks(fn, *q_arrays):
    n = q_arrays[0].shape[1]
    nb = n // Q_BLOCK
    blocks = tuple(a.reshape((a.shape[0], nb, Q_BLOCK) + a.shape[2:]).swapaxes(0, 1) for a in q_arrays)
    out = lax.map(lambda qs: fn(*qs), blocks)
    out = out.swapaxes(0, 1)
    return out.reshape((out.shape[0], n) + out.shape[3:])


def diff_attn_core(q, k, v, lam):
    s = jnp.einsum('bqhcd,bkhcd->bhcqk', q, k).astype(jnp.float32) * (DA_DIM ** -0.5)
    p = jax.nn.softmax(s, axis=-1)
    w = p[:, :, 0] - lam * p[:, :, 1]
    return jnp.einsum('bhqk,bkhe->bqhe', w.astype(v.dtype), v)


def da_post(o, g, lam_init):
    o = rmsnorm(o, g) * (1.0 - lam_init)
    return o.reshape(o.shape[:2] + (-1,))


def mla_core(q_nope, q_rope, k_nope, k_rope, v):
    s = (jnp.einsum('bqhd,bkhd->bhqk', q_nope, k_nope)
         + jnp.einsum('bqhr,bkr->bhqk', q_rope, k_rope)).astype(jnp.float32) * ((MLA_NOPE + MLA_ROPE) ** -0.5)
    p = jax.nn.softmax(s, axis=-1)
    return jnp.einsum('bhqk,bkhd->bqhd', p.astype(v.dtype), v)


def forget_gate(z, lb):
    lb = lb.reshape(HG_HEADS, HG_KDIM)
    zf = z.astype(jnp.float32)
    f = lb + (1.0 - lb) * jax.nn.sigmoid(zf)
    key = (1.0 - lb) * jax.nn.sigmoid(-zf)
    return jnp.log(jnp.maximum(f, FORGET_FLOOR)), key


def hgrn2_chunk_scan(q, k, v, logf, s0):
    bsz, n = q.shape[0], q.shape[1]
    nc = n // HG_CHUNK

    def to_chunks(a):
        return a.astype(jnp.float32).reshape(bsz, nc, HG_CHUNK, HG_HEADS, a.shape[-1]).transpose(1, 0, 3, 2, 4)

    mask = jnp.tril(jnp.ones((HG_CHUNK, HG_CHUNK), dtype=bool))[:, :, None]

    def step(S, xs):
        qc, kc, vc, gc = xs
        b = jnp.cumsum(gc, axis=-2)
        o_inter = jnp.einsum('bhtk,bhkv->bhtv', qc * jnp.exp(b), S)
        rel = jnp.where(mask, b[..., :, None, :] - b[..., None, :, :], 0.0)
        decay = jnp.where(mask, jnp.exp(rel), 0.0)
        A = jnp.einsum('bhtsk,bhsk->bhts', qc[..., :, None, :] * decay, kc)
        o = o_inter + jnp.einsum('bhts,bhsv->bhtv', A, vc)
        b_last = b[..., -1:, :]
        S_new = jnp.exp(b_last[..., 0, :])[..., None] * S + jnp.einsum('bhsk,bhsv->bhkv', kc * jnp.exp(b_last - b), vc)
        return S_new, o

    S, o = lax.scan(step, s0, (to_chunks(q), to_chunks(k), to_chunks(v), to_chunks(logf)))
    o = o.transpose(1, 0, 3, 2, 4).reshape(bsz, n, HG_HEADS, v.shape[-1])
    return o, S


def hgrn2_bidir(p, lb_f, lb_b, s0_f, s0_b):
    lf_f, k_f = forget_gate(p['hg_zf'], lb_f)
    lf_b, k_b = forget_gate(p['hg_zb'], lb_b)
    q, v = p['hg_q'], p['hg_v']
    o_f, s_f = hgrn2_chunk_scan(q, k_f, v, lf_f, s0_f)
    flip = lambda a: a[:, ::-1]
    o_b, s_b = hgrn2_chunk_scan(flip(q), flip(k_b), flip(v), flip(lf_b), s0_b)
    return (o_f + flip(o_b)).astype(q.dtype), s_f, s_b


def hgrn2_out(o, p, g):
    o = rmsnorm(o, g) * jax.nn.silu(p['hg_gate'])
    return o.reshape(o.shape[:2] + (-1,))


def sqrelu_mlp(h, w1, w2):
    return jnp.square(jax.nn.relu(h @ w1)) @ w2


def setup_inputs(seed: int = 0) -> dict:
    key = jax.random.key(seed)
    ks = jax.random.split(key, 24)
    f32 = jnp.float32

    def nrm(k, shape, scale):
        return jax.random.normal(k, shape, f32) * scale

    return {
        'x': nrm(ks[0], (BATCH, SEQ, D_MODEL), 1.0),
        'c': nrm(ks[1], (BATCH, D_MODEL), 1.0),
        'ctx': nrm(ks[2], (BATCH, CTX_LEN, D_MODEL), 1.0),
        'c_ctx': nrm(ks[3], (D_MODEL,), 1.0),
        'w_mod': nrm(ks[4], (DEPTH, D_MODEL, N_MOD * D_MODEL), 0.5 * D_MODEL ** -0.5),
        'b_mod': nrm(ks[5], (DEPTH, N_MOD * D_MODEL), 0.01),
        'g_mix': 1.0 + nrm(ks[6], (DEPTH, D_MODEL), 0.05),
        'g_mlp': 1.0 + nrm(ks[7], (DEPTH, D_MODEL), 0.05),
        'w_in': nrm(ks[8], (DEPTH, D_MODEL, D_IN), D_MODEL ** -0.5),
        'w_out': nrm(ks[9], (DEPTH, D_MIX, D_MODEL), D_MIX ** -0.5),
        'da_lambda': nrm(ks[10], (DEPTH, 4, DA_DIM), 0.1),
        'da_subln_g': 1.0 + nrm(ks[11], (DEPTH, DA_VDIM), 0.05),
        'mla_g_cq': 1.0 + nrm(ks[12], (DEPTH, MLA_Q_RANK), 0.05),
        'mla_g_ckv': 1.0 + nrm(ks[13], (DEPTH, MLA_KV_RANK), 0.05),
        'mla_w_uq': nrm(ks[14], (DEPTH, MLA_Q_RANK, MLA_HEADS * (MLA_NOPE + MLA_ROPE)), MLA_Q_RANK ** -0.5),
        'mla_w_ukv': nrm(ks[15], (DEPTH, MLA_KV_RANK, MLA_HEADS * (MLA_NOPE + MLA_VDIM)), MLA_KV_RANK ** -0.5),
        'hg_lower_bounds': 1.0 + nrm(ks[16], (2, DEPTH, HG_KW), 0.1),
        'hg_norm_g': 1.0 + nrm(ks[17], (DEPTH, HG_VDIM), 0.05),
        'w_ff1': nrm(ks[18], (DEPTH, D_MODEL, D_FF), D_MODEL ** -0.5),
        'w_ff2': nrm(ks[19], (DEPTH, D_FF, D_MODEL), D_FF ** -0.5),
        'g_final': 1.0 + nrm(ks[20], (D_MODEL,), 0.05),
    }


def reference(x, c, ctx, c_ctx, w_mod, b_mod, g_mix, g_mlp, w_in, w_out, da_lambda, da_subln_g,
              mla_g_cq, mla_g_ckv, mla_w_uq, mla_w_ukv, hg_lower_bounds, hg_norm_g, w_ff1, w_ff2, g_final):
    bsz, n = x.shape[0], x.shape[1]
    rope = axial_rope_tables(n)
    lb = jax.nn.softmax(hg_lower_bounds.astype(jnp.float32), axis=1)
    lb = jnp.cumsum(lb, axis=1) - lb[:, :1]
    silu_c = jax.nn.silu(c)
    silu_cc = jax.nn.silu(c_ctx)
    xc = ctx
    for l in range(DEPTH):
        last = l == DEPTH - 1
        mod = jnp.split(silu_c @ w_mod[l] + b_mod[l], N_MOD, axis=-1)
        modc = jnp.split(silu_cc @ w_mod[l] + b_mod[l], N_MOD, axis=-1)
        lam_init = 0.8 - 0.6 * math.exp(-0.3 * l)
        lam = (jnp.exp(jnp.sum(da_lambda[l, 0] * da_lambda[l, 1]))
               - jnp.exp(jnp.sum(da_lambda[l, 2] * da_lambda[l, 3])) + lam_init).astype(jnp.float32)

        hl = ada_norm(x, g_mix[l], mod[0], mod[1])
        hc = ada_norm(xc, g_mix[l], modc[0], modc[1])
        pl = project(hl, w_in[l], mla_w_uq[l], mla_w_ukv[l], mla_g_cq[l], mla_g_ckv[l], rope)
        pc = project(hc, w_in[l], mla_w_uq[l], mla_w_ukv[l], mla_g_cq[l], mla_g_ckv[l], None)

        k_da = jnp.concatenate([pc['da_k'], pl['da_k']], axis=1)
        v_da = jnp.concatenate([pc['da_v'], pl['da_v']], axis=1)
        o_da = sweep_query_blocks(lambda qb: diff_attn_core(qb, k_da, v_da, lam), pl['da_q'])

        kn_all = jnp.concatenate([pc['k_nope'], pl['k_nope']], axis=1)
        kr_all = jnp.concatenate([pc['k_rope'], pl['k_rope']], axis=1)
        v_all = jnp.concatenate([pc['mla_v'], pl['mla_v']], axis=1)
        o_mla = sweep_query_blocks(lambda qn, qr: mla_core(qn, qr, kn_all, kr_all, v_all), pl['q_nope'], pl['q_rope'])

        zeros = jnp.zeros((bsz, HG_HEADS, HG_KDIM, HG_VDIM), jnp.float32)
        oc_hg, s_f, s_b = hgrn2_bidir(pc, lb[0, l], lb[1, l], zeros, zeros)
        ol_hg, _, _ = hgrn2_bidir(pl, lb[0, l], lb[1, l], s_f, s_b)

        y = jnp.concatenate([da_post(o_da, da_subln_g[l], lam_init),
                             o_mla.reshape(bsz, n, MLA_W),
                             hgrn2_out(ol_hg, pl, hg_norm_g[l])], axis=-1)
        x = x + mod[2][..., None, :] * (y @ w_out[l])
        x = x + mod[5][..., None, :] * sqrelu_mlp(ada_norm(x, g_mlp[l], mod[3], mod[4]), w_ff1[l], w_ff2[l])

        if not last:
            oc_da = diff_attn_core(pc['da_q'], pc['da_k'], pc['da_v'], lam)
            oc_mla = mla_core(pc['q_nope'], pc['q_rope'], pc['k_nope'], pc['k_rope'], pc['mla_v'])
            yc = jnp.concatenate([da_post(oc_da, da_subln_g[l], lam_init),
                                  oc_mla.reshape(bsz, oc_mla.shape[1], MLA_W),
                                  hgrn2_out(oc_hg, pc, hg_norm_g[l])], axis=-1)
            xc = xc + modc[2][..., None, :] * (yc @ w_out[l])
            xc = xc + modc[5][..., None, :] * sqrelu_mlp(ada_norm(xc, g_mlp[l], modc[3], modc[4]), w_ff1[l], w_ff2[l])
    return rmsnorm(x, g_final)
```

```cpp
#include <hip/hip_runtime.h>
#include <hip/hip_cooperative_groups.h>
#include <stdint.h>
#include <cstdio>
namespace cg = cooperative_groups;

#define GAS __attribute__((address_space(1)))
typedef unsigned short bf16_t;
typedef short bf16x8 __attribute__((ext_vector_type(8)));
typedef short bf16x4 __attribute__((ext_vector_type(4)));
typedef float f32x16 __attribute__((ext_vector_type(16)));
typedef float f32x4 __attribute__((ext_vector_type(4)));
typedef unsigned u32x4 __attribute__((ext_vector_type(4)));
typedef unsigned u32x2 __attribute__((ext_vector_type(2)));
#define MK8(a,b,c,d) __builtin_bit_cast(bf16x8, (u32x4){(a),(b),(c),(d)})
#define MK4(a,b) __builtin_bit_cast(bf16x4, (u32x2){(a),(b)})

constexpr int T_LAT = 32768, T_CTX = 1024, T_ALL = 33792, NKEY = 8448, DM = 1024, NIN = 3712, DFF = 4096;
constexpr float EPS = 1e-6f;
constexpr float LOG2E = 1.4426950408889634f;

constexpr size_t WS_WIN = 0;
constexpr size_t WS_WOUT = WS_WIN + (size_t)NIN * 1024 * 2;
constexpr size_t WS_WFF1 = WS_WOUT + (size_t)1024 * 1024 * 2;
constexpr size_t WS_WFF2 = WS_WFF1 + (size_t)4096 * 1024 * 2;
constexpr size_t WS_WUQ = WS_WFF2 + (size_t)4096 * 1024 * 2;
constexpr size_t WS_WUKV = WS_WUQ + (size_t)768 * 256 * 2;
constexpr size_t WS_XC = WS_WUKV + (size_t)768 * 128 * 2;
constexpr size_t WS_MOD = WS_XC + (size_t)1024 * 1024 * 4;
constexpr size_t WS_LB = WS_MOD + (size_t)4 * 5 * 6144 * 4;
constexpr size_t WS_LAM = WS_LB + (size_t)2 * 4 * 512 * 4;
constexpr size_t WS_ROPE = WS_LAM + 256;
constexpr size_t WS_KMAX = WS_ROPE + 8192;
constexpr size_t WS_DSEG = WS_KMAX + 2048;
constexpr size_t WS_H = WS_DSEG + (size_t)32 * 33 * 128 * 4;
constexpr size_t WS_R = WS_H + (size_t)T_ALL * 1024 * 2;
constexpr size_t WS_QDA = WS_R;
constexpr size_t WS_KDA = WS_QDA + (size_t)T_ALL * 384 * 2;
constexpr size_t WS_VDAT = WS_KDA + (size_t)T_ALL * 384 * 2;
constexpr size_t WS_QMLA = WS_VDAT + (size_t)T_ALL * 384 * 2;
constexpr size_t WS_KMLA = WS_QMLA + (size_t)T_ALL * 576 * 2;
constexpr size_t WS_VMLAT = WS_KMLA + (size_t)T_ALL * 576 * 2;
constexpr size_t WS_CQ = WS_VMLAT + (size_t)T_ALL * 384 * 2;
constexpr size_t WS_CKV = WS_CQ + (size_t)T_ALL * 256 * 2;
constexpr size_t WS_KR = WS_CKV + (size_t)T_ALL * 128 * 2;
constexpr size_t WS_HG = WS_KR + (size_t)T_ALL * 32 * 2;
constexpr size_t WS_SST = WS_HG + (size_t)T_ALL * 2048 * 2;
constexpr size_t WS_END = WS_SST + (size_t)32 * 33 * 8192 * 4;
constexpr size_t WS_XBAR = WS_END;
constexpr size_t WS_SSQ = WS_XBAR + 16384;
constexpr size_t WS_END2 = WS_SSQ + (size_t)T_ALL * 4 * 4;
constexpr size_t WS_H1 = WS_R;
constexpr size_t WS_BAR = WS_LAM + 128;
static_assert(WS_R + (size_t)T_ALL * 4096 * 2 <= WS_END + (64u << 20), "h1 overlay");
static_assert(WS_END2 <= 536870912ull, "workspace too large");
static_assert(WS_R + (size_t)T_ALL * 4096 * 2 <= 536870912ull, "workspace too large (h1)");

constexpr int SMEM_BYTES = 73728 + 1024;

struct Params {
    const float *x, *c, *ctx, *c_ctx, *w_mod, *b_mod, *g_mix, *g_mlp, *w_in, *w_out, *da_lambda, *da_subln_g, *g_cq, *g_ckv, *w_uq, *w_ukv, *hg_lb, *hg_norm_g, *w_ff1, *w_ff2, *g_final;
    float* out;
    char* ws;
};

__device__ __forceinline__ int opaque_tid() { int t = threadIdx.x; asm volatile("" : "+v"(t)); return t; }
__device__ __forceinline__ bf16_t f2bf(float f) { unsigned u = __float_as_uint(f); u += 0x7fffu + ((u >> 16) & 1u); return (bf16_t)(u >> 16); }
__device__ __forceinline__ float bf2f(bf16_t h) { return __uint_as_float(((unsigned)h) << 16); }
typedef __bf16 bf16v2_t __attribute__((ext_vector_type(2)));
typedef float f32v2_t __attribute__((ext_vector_type(2)));
__device__ __forceinline__ unsigned pack2(float a, float b) { const f32v2_t f = {a, b}; const bf16v2_t r = __builtin_convertvector(f, bf16v2_t); return __builtin_bit_cast(unsigned, r); }
__device__ __forceinline__ unsigned cvt_pk(float lo, float hi) { return pack2(lo, hi); }
__device__ __forceinline__ float ld_coh(const float* p) { return __hip_atomic_load(p, __ATOMIC_RELAXED, __HIP_MEMORY_SCOPE_AGENT); }
__device__ __forceinline__ float fexp2(float x) { return __builtin_amdgcn_exp2f(x); }
__device__ __forceinline__ float fexp(float x) { return __builtin_amdgcn_exp2f(x * LOG2E); }

__device__ __forceinline__ void row_bk(int row, int& b, int& key, bool& lat) {
    if (row < T_LAT) { b = row >> 13; key = 256 + (row & 8191); lat = true; }
    else { int r = row - T_LAT; b = r >> 8; key = r & 255; lat = false; }
}
__device__ __forceinline__ const float* xrow_in(const Params& p, int row) {
    return row < T_LAT ? p.x + (size_t)row * 1024 : p.ctx + (size_t)(row - T_LAT) * 1024;
}
__device__ __forceinline__ float* xrow(const Params& p, int row) {
    return row < T_LAT ? p.out + (size_t)row * 1024 : (float*)(p.ws + WS_XC) + (size_t)(row - T_LAT) * 1024;
}

__device__ __forceinline__ void gemm_tile_core(const bf16_t* __restrict__ A, int lda, const bf16_t* __restrict__ Bt, int ldb, int K, char* smem) {
    const int tid = opaque_tid(), lane = tid & 63, wid = tid >> 6;
    const int wm = wid >> 1, wn = wid & 1, l31 = lane & 31, hi = lane >> 5;
    f32x16 acc[2][2];
#pragma unroll
    for (int i = 0; i < 2; ++i)
#pragma unroll
        for (int j = 0; j < 2; ++j)
#pragma unroll
            for (int r = 0; r < 16; ++r) acc[i][j][r] = 0.f;
    const int lrow = tid >> 3, lkc = tid & 7;
    const bf16_t* ap = A + (size_t)lrow * lda + lkc * 8;
    const bf16_t* bp = Bt + (size_t)lrow * ldb + lkc * 8;
    uint4 p0, p1, p2, p3, p4, p5, p6, p7, q0, q1, q2, q3, q4, q5, q6, q7;
    const int nk = K >> 6;
    const size_t sA = (size_t)32 * lda, sB = (size_t)32 * ldb;
#define G_LOAD0(KT) { const bf16_t* a_ = ap + (KT) * 64; const bf16_t* b_ = bp + (KT) * 64; p0 = *(const uint4*)(a_); p1 = *(const uint4*)(a_ + sA); p2 = *(const uint4*)(a_ + 2 * sA); p3 = *(const uint4*)(a_ + 3 * sA); \
        p4 = *(const uint4*)(b_); p5 = *(const uint4*)(b_ + sB); p6 = *(const uint4*)(b_ + 2 * sB); p7 = *(const uint4*)(b_ + 3 * sB); }
#define G_LOAD1(KT) { const bf16_t* a_ = ap + (KT) * 64; const bf16_t* b_ = bp + (KT) * 64; q0 = *(const uint4*)(a_); q1 = *(const uint4*)(a_ + sA); q2 = *(const uint4*)(a_ + 2 * sA); q3 = *(const uint4*)(a_ + 3 * sA); \
        q4 = *(const uint4*)(b_); q5 = *(const uint4*)(b_ + sB); q6 = *(const uint4*)(b_ + 2 * sB); q7 = *(const uint4*)(b_ + 3 * sB); }
#define G_WRITE0(BUF) { char* wa_ = smem + (BUF) * 36864 + lrow * 144 + lkc * 16; char* wb_ = wa_ + 18432; *(uint4*)(wa_) = p0; *(uint4*)(wa_ + 4608) = p1; *(uint4*)(wa_ + 9216) = p2; *(uint4*)(wa_ + 13824) = p3; \
        *(uint4*)(wb_) = p4; *(uint4*)(wb_ + 4608) = p5; *(uint4*)(wb_ + 9216) = p6; *(uint4*)(wb_ + 13824) = p7; }
#define G_WRITE1(BUF) { char* wa_ = smem + (BUF) * 36864 + lrow * 144 + lkc * 16; char* wb_ = wa_ + 18432; *(uint4*)(wa_) = q0; *(uint4*)(wa_ + 4608) = q1; *(uint4*)(wa_ + 9216) = q2; *(uint4*)(wa_ + 13824) = q3; \
        *(uint4*)(wb_) = q4; *(uint4*)(wb_ + 4608) = q5; *(uint4*)(wb_ + 9216) = q6; *(uint4*)(wb_ + 13824) = q7; }
#define G_COMPUTE(BUF) { const char* sa = smem + (BUF) * 36864; const char* sb = sa + 18432; \
        _Pragma("unroll") for (int ks = 0; ks < 4; ++ks) { bf16x8 af[2], bfr[2]; \
            _Pragma("unroll") for (int i = 0; i < 2; ++i) af[i] = *(const bf16x8*)(sa + (wm * 64 + i * 32 + l31) * 144 + ks * 32 + hi * 16); \
            _Pragma("unroll") for (int j = 0; j < 2; ++j) bfr[j] = *(const bf16x8*)(sb + (wn * 64 + j * 32 + l31) * 144 + ks * 32 + hi * 16); \
            _Pragma("unroll") for (int i = 0; i < 2; ++i) _Pragma("unroll") for (int j = 0; j < 2; ++j) acc[i][j] = __builtin_amdgcn_mfma_f32_32x32x16_bf16(af[i], bfr[j], acc[i][j], 0, 0, 0); } }
    G_LOAD0(0);
    G_WRITE0(0);
    G_LOAD0(1);
    { const int k2 = nk > 2 ? 2 : nk - 1; G_LOAD1(k2); }
    __syncthreads();
    for (int kt = 0; kt < nk; kt += 2) {
        G_COMPUTE(0);
        G_WRITE0(1);
        { const int k3 = kt + 3 < nk ? kt + 3 : nk - 1; G_LOAD0(k3); }
        __syncthreads();
        G_COMPUTE(1);
        G_WRITE1(0);
        { const int k4 = kt + 4 < nk ? kt + 4 : nk - 1; G_LOAD1(k4); }
        __syncthreads();
    }
#undef G_LOAD0
#undef G_LOAD1
#undef G_WRITE0
#undef G_WRITE1
#undef G_COMPUTE
    float* cs = (float*)smem;
#pragma unroll
    for (int i = 0; i < 2; ++i)
#pragma unroll
        for (int j = 0; j < 2; ++j)
#pragma unroll
            for (int r = 0; r < 16; ++r)
                cs[(wm * 64 + i * 32 + 8 * (r >> 2) + 4 * hi + (r & 3)) * 132 + wn * 64 + j * 32 + l31] = acc[i][j][r];
    __syncthreads();
}


struct Acc2 { f32x16 a[4][2]; };
__device__ __forceinline__ void gemm_tile_core2(const bf16_t* __restrict__ A, int lda, const bf16_t* __restrict__ Bt, int ldb, int K, char* smem, Acc2& C) {
    const int tid = opaque_tid(), lane = tid & 63, wid = tid >> 6;
    const int wm = wid >> 1, wn = wid & 1, l31 = lane & 31, hi = lane >> 5;
#pragma unroll
    for (int i = 0; i < 4; ++i)
#pragma unroll
        for (int j = 0; j < 2; ++j)
#pragma unroll
            for (int r = 0; r < 16; ++r) C.a[i][j][r] = 0.f;
    const int lrow = tid >> 2, lkc = tid & 3;
    const bf16_t* ap = A + (size_t)lrow * lda + lkc * 8;
    const bf16_t* bp = Bt + (size_t)lrow * ldb + lkc * 8;
    const size_t sA = (size_t)64 * lda, sB = (size_t)64 * ldb;
    uint4 p0, p1, p2, p3, p4, p5, q0, q1, q2, q3, q4, q5;
    const int nk = K >> 5;
    constexpr int STG = 30720, BOFF = 20480;
#define H_LOAD0(KT) { const bf16_t* a_ = ap + (KT) * 32; const bf16_t* b_ = bp + (KT) * 32; p0 = *(const uint4*)(a_); p1 = *(const uint4*)(a_ + sA); p2 = *(const uint4*)(a_ + 2 * sA); p3 = *(const uint4*)(a_ + 3 * sA); \
        p4 = *(const uint4*)(b_); p5 = *(const uint4*)(b_ + sB); }
#define H_LOAD1(KT) { const bf16_t* a_ = ap + (KT) * 32; const bf16_t* b_ = bp + (KT) * 32; q0 = *(const uint4*)(a_); q1 = *(const uint4*)(a_ + sA); q2 = *(const uint4*)(a_ + 2 * sA); q3 = *(const uint4*)(a_ + 3 * sA); \
        q4 = *(const uint4*)(b_); q5 = *(const uint4*)(b_ + sB); }
#define H_WRITE0(BUF) { char* wa_ = smem + (BUF) * STG + lrow * 80 + lkc * 16; char* wb_ = wa_ + BOFF; *(uint4*)(wa_) = p0; *(uint4*)(wa_ + 5120) = p1; *(uint4*)(wa_ + 10240) = p2; *(uint4*)(wa_ + 15360) = p3; \
        *(uint4*)(wb_) = p4; *(uint4*)(wb_ + 5120) = p5; }
#define H_WRITE1(BUF) { char* wa_ = smem + (BUF) * STG + lrow * 80 + lkc * 16; char* wb_ = wa_ + BOFF; *(uint4*)(wa_) = q0; *(uint4*)(wa_ + 5120) = q1; *(uint4*)(wa_ + 10240) = q2; *(uint4*)(wa_ + 15360) = q3; \
        *(uint4*)(wb_) = q4; *(uint4*)(wb_ + 5120) = q5; }
#define H_COMPUTE(BUF) { const char* sa = smem + (BUF) * STG; const char* sb = sa + BOFF; \
        _Pragma("unroll") for (int ks = 0; ks < 2; ++ks) { bf16x8 af[4], bfr[2]; \
            _Pragma("unroll") for (int i = 0; i < 4; ++i) af[i] = *(const bf16x8*)(sa + (wm * 128 + i * 32 + l31) * 80 + ks * 32 + hi * 16); \
            _Pragma("unroll") for (int j = 0; j < 2; ++j) bfr[j] = *(const bf16x8*)(sb + (wn * 64 + j * 32 + l31) * 80 + ks * 32 + hi * 16); \
            _Pragma("unroll") for (int i = 0; i < 4; ++i) _Pragma("unroll") for (int j = 0; j < 2; ++j) C.a[i][j] = __builtin_amdgcn_mfma_f32_32x32x16_bf16(af[i], bfr[j], C.a[i][j], 0, 0, 0); } }
    H_LOAD0(0);
    H_WRITE0(0);
    H_LOAD0(1);
    { const int k2 = nk > 2 ? 2 : nk - 1; H_LOAD1(k2); }
    __syncthreads();
    for (int kt = 0; kt < nk; kt += 2) {
        H_COMPUTE(0);
        H_WRITE0(1);
        { const int k3 = kt + 3 < nk ? kt + 3 : nk - 1; H_LOAD0(k3); }
        __syncthreads();
        H_COMPUTE(1);
        H_WRITE1(0);
        { const int k4 = kt + 4 < nk ? kt + 4 : nk - 1; H_LOAD1(k4); }
        __syncthreads();
    }
#undef H_LOAD0
#undef H_LOAD1
#undef H_WRITE0
#undef H_WRITE1
#undef H_COMPUTE
}
__device__ __forceinline__ void gemm2_stage(const Acc2& C, int half, char* smem) {
    const int tid = opaque_tid(), lane = tid & 63, wid = tid >> 6;
    const int wm = wid >> 1, wn = wid & 1, l31 = lane & 31, hi = lane >> 5;
    float* cs = (float*)smem;
    if (wm == half) {
#pragma unroll
        for (int i = 0; i < 4; ++i)
#pragma unroll
            for (int j = 0; j < 2; ++j)
#pragma unroll
                for (int r = 0; r < 16; ++r)
                    cs[(i * 32 + 8 * (r >> 2) + 4 * hi + (r & 3)) * 132 + wn * 64 + j * 32 + l31] = C.a[i][j][r];
    }
    __syncthreads();
}

__device__ __forceinline__ void epi_copy_bf16(const float* cs, bf16_t* dst, int ld, int row0, int col0, float sc) {
    const int tid = opaque_tid(), c4 = (tid & 31) * 4, r0 = tid >> 5;
#pragma unroll 4
    for (int i = 0; i < 16; ++i) {
        const int r = r0 + 8 * i;
        const f32x4 v = *(const f32x4*)(cs + r * 132 + c4);
        uint2 w; w.x = pack2(v[0] * sc, v[1] * sc); w.y = pack2(v[2] * sc, v[3] * sc);
        *(uint2*)(dst + (size_t)(row0 + r) * ld + col0 + c4) = w;
    }
}
__device__ __forceinline__ void epi_store_T(const float* cs, int cbase, int ndcols, bf16_t* dstbase  , const float* rs) {
    const int tid = opaque_tid();
    const int items = ndcols * 16;
    for (int it = tid; it < items; it += 256) {
        const int c = it % ndcols, rg = it / ndcols;
        float v[8];
#pragma unroll
        for (int j = 0; j < 8; ++j) { v[j] = cs[(rg * 8 + j) * 132 + cbase + c]; if (rs) v[j] *= rs[rg * 8 + j]; }
        uint4 w; w.x = pack2(v[0], v[1]); w.y = pack2(v[2], v[3]); w.z = pack2(v[4], v[5]); w.w = pack2(v[6], v[7]);
        *(uint4*)(dstbase + (size_t)c * NKEY + rg * 8) = w;
    }
}
__device__ __forceinline__ void rope32(float (&v)[32], int n, const float* rope) {
#pragma unroll
    for (int a = 0; a < 2; ++a) {
        const int pos = a == 0 ? (n >> 6) : (n & 63);
#pragma unroll
        for (int f = 0; f < 8; ++f) {
            const float cs_ = rope[(pos * 8 + f) * 2], sn = rope[(pos * 8 + f) * 2 + 1];
            const float x1 = v[a * 16 + f], x2 = v[a * 16 + 8 + f];
            v[a * 16 + f] = x1 * cs_ - x2 * sn;
            v[a * 16 + 8 + f] = x2 * cs_ + x1 * sn;
        }
    }
}
__device__ __forceinline__ float wave_max(float v) {
#pragma unroll
    for (int o = 32; o >= 1; o >>= 1) v = fmaxf(v, __shfl_xor(v, o));
    return v;
}
__device__ __forceinline__ void store32_bf16(bf16_t* dst, const float (&v)[32], float sc) {
#pragma unroll
    for (int q = 0; q < 4; ++q) {
        uint4 w; w.x = pack2(v[q * 8 + 0] * sc, v[q * 8 + 1] * sc); w.y = pack2(v[q * 8 + 2] * sc, v[q * 8 + 3] * sc);
        w.z = pack2(v[q * 8 + 4] * sc, v[q * 8 + 5] * sc); w.w = pack2(v[q * 8 + 6] * sc, v[q * 8 + 7] * sc);
        *(uint4*)(dst + q * 8) = w;
    }
}

__device__ void epi_inproj(const Params& p, int l, int m0, int tn, const float* cs) {
    const int tid = opaque_tid();
    int b, key0; bool lat; row_bk(m0, b, key0, lat);
    const float* rope = (const float*)(p.ws + WS_ROPE);
    if (tn < 6 || tn == 28) {
        const int r = tid & 127, half = tid >> 7;
        const int row = m0 + r, key = key0 + r;
        const int ngrp = (tn == 28) ? 1 : 4;
        for (int gi = half; gi < ngrp; gi += 2) {
            float v[32];
#pragma unroll
            for (int q = 0; q < 8; ++q) { const f32x4 t = *(const f32x4*)(cs + r * 132 + gi * 32 + q * 4); v[q * 4] = t[0]; v[q * 4 + 1] = t[1]; v[q * 4 + 2] = t[2]; v[q * 4 + 3] = t[3]; }
            if (lat) rope32(v, row & 8191, rope);
            if (tn < 3) {
                bf16_t* dst = (bf16_t*)(p.ws + WS_QDA) + ((size_t)(b * 12 + tn * 4 + gi) * NKEY + key) * 32;
                store32_bf16(dst, v, 0.17677669529663687f * LOG2E);
            } else if (tn < 6) {
                const int hc = (tn - 3) * 4 + gi;
                bf16_t* dst = (bf16_t*)(p.ws + WS_KDA) + ((size_t)(b * 12 + hc) * NKEY + key) * 32;
                store32_bf16(dst, v, 1.0f);
                float n2 = 0.f;
#pragma unroll
                for (int q = 0; q < 32; ++q) n2 += v[q] * v[q];
                n2 = wave_max(n2);
                if ((tid & 63) == 0) atomicMax((unsigned*)(p.ws + WS_KMAX) + (l * 4 + b) * 32 + hc, __float_as_uint(n2));
            } else {
                bf16_t* dst = (bf16_t*)(p.ws + WS_KR) + (size_t)row * 32;
                store32_bf16(dst, v, 1.0f);
            }
        }
    } else if (tn < 9) {
        const int h0 = (tn - 6) * 2;
        bf16_t* dst = (bf16_t*)(p.ws + WS_VDAT) + ((size_t)(b * 6 + h0) * 64) * NKEY + key0;
        epi_store_T(cs, 0, 128, dst, nullptr);
    } else if (tn < 12) {
        if (tn < 11) epi_copy_bf16(cs, (bf16_t*)(p.ws + WS_CQ), 256, m0, (tn - 9) * 128, 1.0f);
        else epi_copy_bf16(cs, (bf16_t*)(p.ws + WS_CKV), 128, m0, 0, 1.0f);
        if (tid < 128) {
            float ssq = 0.f;
#pragma unroll 8
            for (int q = 0; q < 32; ++q) { const f32x4 t = *(const f32x4*)(cs + tid * 132 + q * 4); ssq += t[0] * t[0] + t[1] * t[1] + t[2] * t[2] + t[3] * t[3]; }
            ((float*)(p.ws + WS_SSQ))[(size_t)(m0 + tid) * 4 + (tn - 9)] = ssq;
        }
    } else {
        epi_copy_bf16(cs, (bf16_t*)(p.ws + WS_HG), 2048, m0, (tn - 12) * 128, 1.0f);
    }
}

__device__ __forceinline__ void row_rstd(const Params& p, int which  , int m0, float* rs) {
    const int tid = opaque_tid();
    if (tid < 128) {
        const float* q = (const float*)(p.ws + WS_SSQ) + (size_t)(m0 + tid) * 4;
        rs[tid] = which == 0 ? rsqrtf((q[0] + q[1]) * (1.0f / 256.0f) + EPS) : rsqrtf(q[2] * (1.0f / 128.0f) + EPS);
    }
}
__device__ void epi_uq(const Params& p, int m0, int h, const float* cs, const float* rs) {
    const int tid = opaque_tid(), r = tid & 127, half = tid >> 7;
    int b, key0; bool lat; row_bk(m0, b, key0, lat);
    const int row = m0 + r, key = key0 + r;
    const float sc = rs[r] * 0.10206207261596575f * LOG2E;
    bf16_t* dst = (bf16_t*)(p.ws + WS_QMLA) + ((size_t)(b * 6 + h) * NKEY + key) * 96;
    if (half == 0) {
        float v[32];
#pragma unroll
        for (int q = 0; q < 8; ++q) { const f32x4 t = *(const f32x4*)(cs + r * 132 + q * 4); v[q * 4] = t[0]; v[q * 4 + 1] = t[1]; v[q * 4 + 2] = t[2]; v[q * 4 + 3] = t[3]; }
        store32_bf16(dst, v, sc);
#pragma unroll
        for (int q = 0; q < 4; ++q) { const f32x4 t = *(const f32x4*)(cs + r * 132 + 32 + q * 4); v[q * 4] = t[0]; v[q * 4 + 1] = t[1]; v[q * 4 + 2] = t[2]; v[q * 4 + 3] = t[3]; }
#pragma unroll
        for (int q = 0; q < 2; ++q) {
            uint4 w; w.x = pack2(v[q * 8 + 0] * sc, v[q * 8 + 1] * sc); w.y = pack2(v[q * 8 + 2] * sc, v[q * 8 + 3] * sc);
            w.z = pack2(v[q * 8 + 4] * sc, v[q * 8 + 5] * sc); w.w = pack2(v[q * 8 + 6] * sc, v[q * 8 + 7] * sc);
            *(uint4*)(dst + 32 + q * 8) = w;
        }
    } else {
        float v[32];
#pragma unroll
        for (int q = 0; q < 4; ++q) { const f32x4 t = *(const f32x4*)(cs + r * 132 + 48 + q * 4); v[q * 4] = t[0]; v[q * 4 + 1] = t[1]; v[q * 4 + 2] = t[2]; v[q * 4 + 3] = t[3]; }
#pragma unroll
        for (int q = 0; q < 2; ++q) {
            uint4 w; w.x = pack2(v[q * 8 + 0] * sc, v[q * 8 + 1] * sc); w.y = pack2(v[q * 8 + 2] * sc, v[q * 8 + 3] * sc);
            w.z = pack2(v[q * 8 + 4] * sc, v[q * 8 + 5] * sc); w.w = pack2(v[q * 8 + 6] * sc, v[q * 8 + 7] * sc);
            *(uint4*)(dst + 48 + q * 8) = w;
        }
#pragma unroll
        for (int q = 0; q < 8; ++q) { const f32x4 t = *(const f32x4*)(cs + r * 132 + 64 + q * 4); v[q * 4] = t[0]; v[q * 4 + 1] = t[1]; v[q * 4 + 2] = t[2]; v[q * 4 + 3] = t[3]; }
        if (lat) rope32(v, row & 8191, (const float*)(p.ws + WS_ROPE));
        store32_bf16(dst + 64, v, sc);
    }
}
__device__ void epi_ukv(const Params& p, int l, int m0, int h, const float* cs, const float* rs) {
    const int tid = opaque_tid();
    int b, key0; bool lat; row_bk(m0, b, key0, lat);
    bf16_t* vdst = (bf16_t*)(p.ws + WS_VMLAT) + ((size_t)(b * 6 + h) * 64) * NKEY + key0;
    epi_store_T(cs, 64, 64, vdst, rs);
    if (tid < 128) {
        const int r = tid, row = m0 + r, key = key0 + r;
        const float sc = rs[r];
        bf16_t* dst = (bf16_t*)(p.ws + WS_KMLA) + ((size_t)(b * 6 + h) * NKEY + key) * 96;
        float n2 = 0.f;
        float v[32];
#pragma unroll
        for (int part = 0; part < 2; ++part) {
#pragma unroll
            for (int q = 0; q < 8; ++q) { const f32x4 t = *(const f32x4*)(cs + r * 132 + part * 32 + q * 4); v[q * 4] = t[0] * sc; v[q * 4 + 1] = t[1] * sc; v[q * 4 + 2] = t[2] * sc; v[q * 4 + 3] = t[3] * sc; }
#pragma unroll
            for (int q = 0; q < 32; ++q) n2 += v[q] * v[q];
            store32_bf16(dst + part * 32, v, 1.0f);
        }
        const bf16_t* kr = (const bf16_t*)(p.ws + WS_KR) + (size_t)row * 32;
#pragma unroll
        for (int q = 0; q < 4; ++q) {
            const uint4 w = *(const uint4*)(kr + q * 8);
            *(uint4*)(dst + 64 + q * 8) = w;
            const unsigned ww[4] = {w.x, w.y, w.z, w.w};
#pragma unroll
            for (int j = 0; j < 4; ++j) { const float f0 = __uint_as_float(ww[j] << 16), f1 = __uint_as_float(ww[j] & 0xffff0000u); n2 += f0 * f0 + f1 * f1; }
        }
        n2 = wave_max(n2);
        if ((tid & 63) == 0) atomicMax((unsigned*)(p.ws + WS_KMAX) + (l * 4 + b) * 32 + 12 + h, __float_as_uint(n2));
    }
}
__device__ __forceinline__ void epi_resid(const Params& p, int l, int m0, int n0, int goff, const float* cs) {
    const int tid = opaque_tid(), c4 = (tid & 31) * 4, r0 = tid >> 5;
    int b, key0; bool lat; row_bk(m0, b, key0, lat);
    const float* gate = (const float*)(p.ws + WS_MOD) + (size_t)(l * 5 + (lat ? b : 4)) * 6144 + goff + n0 + c4;
    const f32x4 g = *(const f32x4*)gate;
#pragma unroll 4
    for (int i = 0; i < 16; ++i) {
        const int r = r0 + 8 * i;
        const f32x4 v = *(const f32x4*)(cs + r * 132 + c4);
        float* xp = xrow(p, m0 + r) + n0 + c4;
        const float* xs = (l == 0 && goff == 2 * 1024) ? xrow_in(p, m0 + r) + n0 + c4 : xp;
        f32x4 x = *(const f32x4*)xs;
        x += g * v;
        *(f32x4*)xp = x;
    }
}
__device__ __forceinline__ void epi_ff1(const Params& p, int m0, int n0, const float* cs) {
    const int tid = opaque_tid(), c4 = (tid & 31) * 4, r0 = tid >> 5;
    bf16_t* dst = (bf16_t*)(p.ws + WS_H1);
#pragma unroll 4
    for (int i = 0; i < 16; ++i) {
        const int r = r0 + 8 * i;
        f32x4 v = *(const f32x4*)(cs + r * 132 + c4);
#pragma unroll
        for (int j = 0; j < 4; ++j) { const float t = fmaxf(v[j], 0.f); v[j] = t * t; }
        uint2 w; w.x = pack2(v[0], v[1]); w.y = pack2(v[2], v[3]);
        *(uint2*)(dst + (size_t)(m0 + r) * 4096 + n0 + c4) = w;
    }
}

template <int DQK>
__device__ __forceinline__ void attn_pass(const bf16_t* __restrict__ Qb, const bf16_t* __restrict__ Kb, const bf16_t* __restrict__ VTb,
                                          int q0, int nkt, float kmax, char* smem, f32x16& O0, f32x16& O1, float& lsum) {
    constexpr int KS = DQK * 2 + 16, VS = 136, STAGE = 64 * KS + 64 * VS, NKC = DQK / 32, CPR = DQK / 8;
    const int tid = opaque_tid(), lane = tid & 63, wid = tid >> 6, l31 = lane & 31, hi = lane >> 5;
    bf16x8 qf[DQK / 16];
    const bf16_t* qp = Qb + (size_t)(q0 + wid * 32 + l31) * DQK + hi * 8;
    float qn = 0.f;
#pragma unroll
    for (int ks = 0; ks < DQK / 16; ++ks) {
        qf[ks] = *(const bf16x8*)(qp + ks * 16);
#pragma unroll
        for (int j = 0; j < 8; ++j) { const float f = bf2f((bf16_t)qf[ks][j]); qn += f * f; }
    }
    qn += __shfl_xor(qn, 32);
    const float negm = -(sqrtf(qn) * kmax);
#pragma unroll
    for (int r = 0; r < 16; ++r) { O0[r] = 0.f; O1[r] = 0.f; }
    lsum = 0.f;
    const int kr0 = tid / CPR, kc0 = tid % CPR, kr1 = (tid + 256) / CPR, kc1 = (tid + 256) % CPR, kr2 = (tid + 512) / CPR, kc2 = (tid + 512) % CPR;
    const int vr0 = tid >> 3, vc0 = tid & 7;
    const bf16_t* vg = VTb + (size_t)vr0 * NKEY + vc0 * 8;
    uint4 a0, a1, a2, a3, a4;
#define AT_LOADA(KT) { const bf16_t* kp_ = Kb + (size_t)(KT) * 64 * DQK; a0 = *(const uint4*)(kp_ + (size_t)tid * 8); \
        if constexpr (NKC > 1) { a1 = *(const uint4*)(kp_ + (size_t)(tid + 256) * 8); a2 = *(const uint4*)(kp_ + (size_t)(tid + 512) * 8); } \
        a3 = *(const uint4*)(vg + (KT) * 64); a4 = *(const uint4*)(vg + (size_t)32 * NKEY + (KT) * 64); }
#define AT_WRITE(X0, X1, X2, X3, X4, BUF) { char* sk_ = smem + (BUF) * STAGE; char* sv_ = sk_ + 64 * KS; \
        *(uint4*)(sk_ + kr0 * KS + kc0 * 16) = X0; \
        if constexpr (NKC > 1) { *(uint4*)(sk_ + kr1 * KS + kc1 * 16) = X1; *(uint4*)(sk_ + kr2 * KS + kc2 * 16) = X2; } \
        { uint2* d_ = (uint2*)(sv_ + vr0 * VS + vc0 * 16); d_[0] = make_uint2(X3.x, X3.y); d_[1] = make_uint2(X3.z, X3.w); } \
        { uint2* d_ = (uint2*)(sv_ + (vr0 + 32) * VS + vc0 * 16); d_[0] = make_uint2(X4.x, X4.y); d_[1] = make_uint2(X4.z, X4.w); } }
    f32x16 NEG;
#pragma unroll
    for (int r = 0; r < 16; ++r) NEG[r] = negm;
    auto compute = [&](int buf) {
        const char* sk = smem + buf * STAGE; const char* sv = sk + 64 * KS;
        constexpr int NKS = DQK / 16;
        bf16x8 k0[NKS], k1[NKS], v0[4], v1[4];
#pragma unroll
        for (int ks = 0; ks < NKS; ++ks) k0[ks] = *(const bf16x8*)(sk + (l31)*KS + ks * 32 + hi * 16);
#pragma unroll
        for (int ks = 0; ks < NKS; ++ks) k1[ks] = *(const bf16x8*)(sk + (32 + l31) * KS + ks * 32 + hi * 16);
#pragma unroll
        for (int u = 0; u < 2; ++u)
#pragma unroll
            for (int db = 0; db < 2; ++db) {
                const char* vp = sv + (db * 32 + l31) * VS + (16 * u + 4 * hi) * 2;
                const uint2 x0 = *(const uint2*)vp, x1 = *(const uint2*)(vp + 16);
                v0[u * 2 + db] = MK8(x0.x, x0.y, x1.x, x1.y);
            }
        __builtin_amdgcn_sched_barrier(0);
        f32x16 S0, S1;
#pragma unroll
        for (int ks = 0; ks < NKS; ++ks) S0 = __builtin_amdgcn_mfma_f32_32x32x16_bf16(k0[ks], qf[ks], ks == 0 ? NEG : S0, 0, 0, 0);
#pragma unroll
        for (int ks = 0; ks < NKS; ++ks) S1 = __builtin_amdgcn_mfma_f32_32x32x16_bf16(k1[ks], qf[ks], ks == 0 ? NEG : S1, 0, 0, 0);
        __builtin_amdgcn_sched_barrier(0);
#pragma unroll
        for (int u = 0; u < 2; ++u)
#pragma unroll
            for (int db = 0; db < 2; ++db) {
                const char* vp = sv + (db * 32 + l31) * VS + (32 + 16 * u + 4 * hi) * 2;
                const uint2 x0 = *(const uint2*)vp, x1 = *(const uint2*)(vp + 16);
                v1[u * 2 + db] = MK8(x0.x, x0.y, x1.x, x1.y);
            }
        unsigned pk0[8], pk1[8];
#pragma unroll
        for (int r = 0; r < 16; r += 2) { const float e0 = fexp2(S0[r]), e1 = fexp2(S0[r + 1]); lsum += e0 + e1; pk0[r >> 1] = cvt_pk(e0, e1); }
        __builtin_amdgcn_sched_barrier(0);
#pragma unroll
        for (int u = 0; u < 2; ++u) {
            const bf16x8 pbv = MK8(pk0[4 * u], pk0[4 * u + 1], pk0[4 * u + 2], pk0[4 * u + 3]);
            O0 = __builtin_amdgcn_mfma_f32_32x32x16_bf16(v0[u * 2 + 0], pbv, O0, 0, 0, 0);
            O1 = __builtin_amdgcn_mfma_f32_32x32x16_bf16(v0[u * 2 + 1], pbv, O1, 0, 0, 0);
        }
#pragma unroll
        for (int r = 0; r < 16; r += 2) { const float e0 = fexp2(S1[r]), e1 = fexp2(S1[r + 1]); lsum += e0 + e1; pk1[r >> 1] = cvt_pk(e0, e1); }
        __builtin_amdgcn_sched_barrier(0);
#pragma unroll
        for (int u = 0; u < 2; ++u) {
            const bf16x8 pbv = MK8(pk1[4 * u], pk1[4 * u + 1], pk1[4 * u + 2], pk1[4 * u + 3]);
            O0 = __builtin_amdgcn_mfma_f32_32x32x16_bf16(v1[u * 2 + 0], pbv, O0, 0, 0, 0);
            O1 = __builtin_amdgcn_mfma_f32_32x32x16_bf16(v1[u * 2 + 1], pbv, O1, 0, 0, 0);
        }
    };
    a1 = a2 = make_uint4(0u, 0u, 0u, 0u);
    AT_LOADA(0);
    AT_WRITE(a0, a1, a2, a3, a4, 0);
    AT_LOADA(1);
    __syncthreads();
    for (int kt = 0; kt < nkt; kt += 2) {
        compute(0);
        AT_WRITE(a0, a1, a2, a3, a4, 1);
        { const int k2 = kt + 2 < nkt ? kt + 2 : nkt - 1; AT_LOADA(k2); }
        __syncthreads();
        compute(1);
        AT_WRITE(a0, a1, a2, a3, a4, 0);
        { const int k3 = kt + 3 < nkt ? kt + 3 : nkt - 1; AT_LOADA(k3); }
        __syncthreads();
    }
#undef AT_LOADA
#undef AT_WRITE
    lsum += __shfl_xor(lsum, 32);
}

__device__ void attn_unit(const Params& p, int l, int b, int hh, int qbi, char* smem) {
    const int q0 = qbi < 64 ? 256 + qbi * 128 : (qbi - 64) * 128;
    const int nkt = qbi < 64 ? 132 : 4;
    const int tid = opaque_tid(), lane = tid & 63, wid = tid >> 6, l31 = lane & 31, hi = lane >> 5;
    const int qkey = q0 + wid * 32 + l31;
    const int row = qkey < 256 ? T_LAT + b * 256 + qkey : b * 8192 + qkey - 256;
    const float* kmx = (const float*)(p.ws + WS_KMAX) + (l * 4 + b) * 32;
    bf16_t* Y = (bf16_t*)(p.ws + WS_H);
    if (hh < 6) {
        const int h = hh;
        const bf16_t* VT = (const bf16_t*)(p.ws + WS_VDAT) + ((size_t)(b * 6 + h) * 64) * NKEY;
        f32x16 A0, A1, B0, B1; float la, lb;
        {
            const size_t off = (size_t)(b * 12 + 2 * h) * NKEY * 32;
            attn_pass<32>((const bf16_t*)(p.ws + WS_QDA) + off, (const bf16_t*)(p.ws + WS_KDA) + off, VT, q0, nkt, sqrtf(ld_coh(kmx + 2 * h)), smem, A0, A1, la);
        }
        {
            const size_t off = (size_t)(b * 12 + 2 * h + 1) * NKEY * 32;
            attn_pass<32>((const bf16_t*)(p.ws + WS_QDA) + off, (const bf16_t*)(p.ws + WS_KDA) + off, VT, q0, nkt, sqrtf(ld_coh(kmx + 2 * h + 1)), smem, B0, B1, lb);
        }
        const float lam = ((const float*)(p.ws + WS_LAM))[l];
        const float lam_init = 0.8f - 0.6f * expf(-0.3f * (float)l);
        const float ia = 1.0f / la, ib = lam / lb;
        float ss = 0.f;
#pragma unroll
        for (int r = 0; r < 16; ++r) { A0[r] = A0[r] * ia - B0[r] * ib; A1[r] = A1[r] * ia - B1[r] * ib; ss += A0[r] * A0[r] + A1[r] * A1[r]; }
        ss += __shfl_xor(ss, 32);
        const float rinv = rsqrtf(ss * (1.0f / 64.0f) + EPS) * (1.0f - lam_init);
        const float* g = p.da_subln_g + l * 64;
        bf16_t* yp = Y + (size_t)row * 1024 + h * 64;
#pragma unroll
        for (int q = 0; q < 4; ++q) {
            const int d = 8 * q + 4 * hi;
            const f32x4 g0 = *(const f32x4*)(g + d), g1 = *(const f32x4*)(g + 32 + d);
            uint2 w0, w1;
            w0.x = pack2(A0[4 * q] * rinv * g0[0], A0[4 * q + 1] * rinv * g0[1]); w0.y = pack2(A0[4 * q + 2] * rinv * g0[2], A0[4 * q + 3] * rinv * g0[3]);
            w1.x = pack2(A1[4 * q] * rinv * g1[0], A1[4 * q + 1] * rinv * g1[1]); w1.y = pack2(A1[4 * q + 2] * rinv * g1[2], A1[4 * q + 3] * rinv * g1[3]);
            *(uint2*)(yp + d) = w0; *(uint2*)(yp + 32 + d) = w1;
        }
    } else {
        const int h = hh - 6;
        const bf16_t* VT = (const bf16_t*)(p.ws + WS_VMLAT) + ((size_t)(b * 6 + h) * 64) * NKEY;
        const size_t off = (size_t)(b * 6 + h) * NKEY * 96;
        f32x16 A0, A1; float la;
        attn_pass<96>((const bf16_t*)(p.ws + WS_QMLA) + off, (const bf16_t*)(p.ws + WS_KMLA) + off, VT, q0, nkt, sqrtf(ld_coh(kmx + 12 + h)), smem, A0, A1, la);
        const float ia = 1.0f / la;
        bf16_t* yp = Y + (size_t)row * 1024 + 384 + h * 64;
#pragma unroll
        for (int q = 0; q < 4; ++q) {
            const int d = 8 * q + 4 * hi;
            uint2 w0, w1;
            w0.x = pack2(A0[4 * q] * ia, A0[4 * q + 1] * ia); w0.y = pack2(A0[4 * q + 2] * ia, A0[4 * q + 3] * ia);
            w1.x = pack2(A1[4 * q] * ia, A1[4 * q + 1] * ia); w1.y = pack2(A1[4 * q + 2] * ia, A1[4 * q + 3] * ia);
            *(uint2*)(yp + d) = w0; *(uint2*)(yp + 32 + d) = w1;
        }
    }
}

constexpr int HG_QT = 0, HG_KT = 4352, HG_KH = 8704, HG_VT = 13824, HG_DD = 16384, HG_OSEG = 17408;
template <int MODE>
__device__ void hgrn_pass(const Params& p, int l, int dir, int b, int h, int g, char* smem) {
    const int tid = opaque_tid(), lane = tid & 63, wid = tid >> 6, c = lane & 15, gq = lane >> 4;
    int r0, sgn;
    if (dir == 0) { r0 = g == 0 ? T_LAT + b * 256 : b * 8192 + (g - 1) * 256; sgn = 1; }
    else { r0 = g == 0 ? T_LAT + b * 256 + 255 : b * 8192 + 8191 - (g - 1) * 256; sgn = -1; }
    const bf16_t* HG = (const bf16_t*)(p.ws + WS_HG);
    const int k = tid >> 1, hf = tid & 1;
    const float lbv = ((const float*)(p.ws + WS_LB))[(dir * 4 + l) * 512 + h * 128 + k];
    const float omlb = 1.0f - lbv;
    const int zoff = 512 + dir * 512 + h * 128 + k, qoff = h * 128 + k;
    bf16_t* QT = (bf16_t*)(smem + HG_QT); bf16_t* KT = (bf16_t*)(smem + HG_KT); bf16_t* KH = (bf16_t*)(smem + HG_KH); bf16_t* VT = (bf16_t*)(smem + HG_VT);
    float* DD = (float*)(smem + HG_DD); bf16_t* OSEG = (bf16_t*)(smem + HG_OSEG);
    const int chain = (dir * 4 + b) * 4 + h;
    float* sst = (float*)(p.ws + WS_SST) + (size_t)(chain * 33 + g) * 8192;
    f32x4 S[8];
#pragma unroll
    for (int kb = 0; kb < 8; ++kb)
#pragma unroll
        for (int r = 0; r < 4; ++r) S[kb][r] = (MODE == 0) ? 0.f : sst[(16 * kb + 4 * gq + r) * 64 + 16 * wid + c];
    float btot = 0.f;
    struct HPre { bf16_t z0, z1, z2, z3, z4, z5, z6, z7, q0, q1, q2, q3, q4, q5, q6, q7; uint2 vv; };
    const int vt_t = tid >> 4, vt_v4 = (tid & 15) * 4;
#define HG_ROW(SC, T) ((size_t)(r0 + sgn * ((SC) * 16 + (T))) * 2048)
    auto prefetch = [&](HPre& R, int sc) {
        const bf16_t* zb_ = HG + zoff;
        R.z0 = zb_[HG_ROW(sc, hf * 8 + 0)]; R.z1 = zb_[HG_ROW(sc, hf * 8 + 1)]; R.z2 = zb_[HG_ROW(sc, hf * 8 + 2)]; R.z3 = zb_[HG_ROW(sc, hf * 8 + 3)];
        R.z4 = zb_[HG_ROW(sc, hf * 8 + 4)]; R.z5 = zb_[HG_ROW(sc, hf * 8 + 5)]; R.z6 = zb_[HG_ROW(sc, hf * 8 + 6)]; R.z7 = zb_[HG_ROW(sc, hf * 8 + 7)];
        R.q0 = R.q1 = R.q2 = R.q3 = R.q4 = R.q5 = R.q6 = R.q7 = 0;
        if (MODE != 0) { const bf16_t* qb_ = HG + qoff;
            R.q0 = qb_[HG_ROW(sc, hf * 8 + 0)]; R.q1 = qb_[HG_ROW(sc, hf * 8 + 1)]; R.q2 = qb_[HG_ROW(sc, hf * 8 + 2)]; R.q3 = qb_[HG_ROW(sc, hf * 8 + 3)];
            R.q4 = qb_[HG_ROW(sc, hf * 8 + 4)]; R.q5 = qb_[HG_ROW(sc, hf * 8 + 5)]; R.q6 = qb_[HG_ROW(sc, hf * 8 + 6)]; R.q7 = qb_[HG_ROW(sc, hf * 8 + 7)]; }
        R.vv = *(const uint2*)(HG + HG_ROW(sc, vt_t) + 1536 + h * 64 + vt_v4);
    };
    auto elem = [&](const HPre& R, int sc) {
        float bt[8], ky[8], qv[8];
        {
            const bf16_t zz[8] = {R.z0, R.z1, R.z2, R.z3, R.z4, R.z5, R.z6, R.z7};
            const bf16_t qq[8] = {R.q0, R.q1, R.q2, R.q3, R.q4, R.q5, R.q6, R.q7};
            float cum = 0.f;
#pragma unroll
            for (int i = 0; i < 8; ++i) {
                const float z = bf2f(zz[i]);
                const float e = fexp(-z);
                const float sg = __builtin_amdgcn_rcpf(1.0f + e);
                const float f = lbv + omlb * sg;
                cum += __builtin_amdgcn_logf(fmaxf(f, 1e-30f)) * 0.6931471805599453f;
                bt[i] = cum; ky[i] = omlb * (1.0f - sg); qv[i] = bf2f(qq[i]);
            }
            const float other = __shfl_xor(cum, 1);
            const float blast = cum + other;
            const float add = hf ? other : 0.f;
#pragma unroll
            for (int i = 0; i < 8; ++i) {
                const int t = hf * 8 + i;
                const float b_ = bt[i] + add;
                if (MODE != 0) {
                    QT[t * 136 + k] = f2bf(qv[i] * fexp(b_));
                    KT[t * 136 + k] = f2bf(ky[i] * fexp(fminf(-b_, 80.f)));
                }
                KH[k * 20 + t] = f2bf(ky[i] * fexp(blast - b_));
            }
            if (hf == 0) DD[k] = fexp(blast);
            btot += blast;
            VT[(vt_v4 + 0) * 20 + vt_t] = (bf16_t)(R.vv.x & 0xffff); VT[(vt_v4 + 1) * 20 + vt_t] = (bf16_t)(R.vv.x >> 16);
            VT[(vt_v4 + 2) * 20 + vt_t] = (bf16_t)(R.vv.y & 0xffff); VT[(vt_v4 + 3) * 20 + vt_t] = (bf16_t)(R.vv.y >> 16);
        }
    };
    auto mfma_stage = [&](int sc) {
        const uint2 vtu = *(const uint2*)(VT + (16 * wid + c) * 20 + 4 * gq);
        const bf16x8 vtf = MK8(vtu.x, vtu.y, 0u, 0u);
        if (MODE != 0) {
            f32x4 AT = {0.f, 0.f, 0.f, 0.f};
#pragma unroll
            for (int ks = 0; ks < 4; ++ks) {
                const bf16x8 a = *(const bf16x8*)(KT + c * 136 + ks * 32 + gq * 8);
                const bf16x8 bq = *(const bf16x8*)(QT + c * 136 + ks * 32 + gq * 8);
                AT = __builtin_amdgcn_mfma_f32_16x16x32_bf16(a, bq, AT, 0, 0, 0);
            }
#pragma unroll
            for (int r = 0; r < 4; ++r) if (4 * gq + r > c) AT[r] = 0.f;
            const bf16x8 pfv = MK8(pack2(AT[0], AT[1]), pack2(AT[2], AT[3]), 0u, 0u);
            f32x4 oT = {0.f, 0.f, 0.f, 0.f};
            oT = __builtin_amdgcn_mfma_f32_16x16x32_bf16(vtf, pfv, oT, 0, 0, 0);
#pragma unroll
            for (int u = 0; u < 4; ++u) {
                const bf16x8 sfv = MK8(pack2(S[2 * u][0], S[2 * u][1]), pack2(S[2 * u][2], S[2 * u][3]), pack2(S[2 * u + 1][0], S[2 * u + 1][1]), pack2(S[2 * u + 1][2], S[2 * u + 1][3]));
                const uint2 q0 = *(const uint2*)(QT + c * 136 + 32 * u + 4 * gq), q1 = *(const uint2*)(QT + c * 136 + 32 * u + 16 + 4 * gq);
                const bf16x8 qpv = MK8(q0.x, q0.y, q1.x, q1.y);
                oT = __builtin_amdgcn_mfma_f32_16x16x32_bf16(sfv, qpv, oT, 0, 0, 0);
            }
            const int pos = sc * 16 + c;
            const int ti = (MODE == 1) ? pos : 255 - pos;
            bf16_t* op = OSEG + ti * 68 + 16 * wid + 4 * gq;
            if (MODE == 2) {
                const uint2 old = *(const uint2*)op;
                oT[0] += __uint_as_float(old.x << 16); oT[1] += __uint_as_float(old.x & 0xffff0000u);
                oT[2] += __uint_as_float(old.y << 16); oT[3] += __uint_as_float(old.y & 0xffff0000u);
            }
            uint2 w; w.x = pack2(oT[0], oT[1]); w.y = pack2(oT[2], oT[3]);
            *(uint2*)op = w;
        }
#pragma unroll
        for (int kb = 0; kb < 8; ++kb) {
            const uint2 khu = *(const uint2*)(KH + (16 * kb + c) * 20 + 4 * gq);
            const bf16x8 kh = MK8(khu.x, khu.y, 0u, 0u);
            const f32x4 d4 = *(const f32x4*)(DD + 16 * kb + 4 * gq);
            S[kb] = __builtin_amdgcn_mfma_f32_16x16x32_bf16(kh, vtf, S[kb] * d4, 0, 0, 0);
        }
    };
    HPre P0, P1;
    prefetch(P0, 0); prefetch(P1, 1);
    for (int sc = 0; sc < 16; sc += 2) {
        elem(P0, sc);
        __syncthreads();
        { const int scn = sc + 2 < 16 ? sc + 2 : 15; prefetch(P0, scn); }
        mfma_stage(sc);
        __syncthreads();
        elem(P1, sc + 1);
        __syncthreads();
        { const int scn = sc + 3 < 16 ? sc + 3 : 15; prefetch(P1, scn); }
        mfma_stage(sc + 1);
        __syncthreads();
    }
    if (MODE == 0) {
#pragma unroll
        for (int kb = 0; kb < 8; ++kb)
#pragma unroll
            for (int r = 0; r < 4; ++r) sst[(16 * kb + 4 * gq + r) * 64 + 16 * wid + c] = S[kb][r];
        if (hf == 0) ((float*)(p.ws + WS_DSEG))[(size_t)(chain * 33 + g) * 128 + k] = fexp(btot);
    }
#undef HG_ROW
}

struct H1Pre { bf16_t z0, z1, z2, z3, z4, z5, z6, z7; uint2 vv; };
struct H1Ctx { int r0, sgn, zoff, hv, chain, g; float lbv, omlb, btot; f32x4 S[8]; };
__device__ void hgrn_h1_pair(const Params& p, int l, int b, int h, int g, char* smem) {
    const int tid = opaque_tid(), lane = tid & 63, wid = tid >> 6, c = lane & 15, gq = lane >> 4;
    const int k = tid >> 1, hf = tid & 1, vt_t = tid >> 4, vt_v4 = (tid & 15) * 4;
    const bf16_t* HG = (const bf16_t*)(p.ws + WS_HG);
    auto init = [&](H1Ctx& X, int dir) {
        if (dir == 0) { X.r0 = g == 0 ? T_LAT + b * 256 : b * 8192 + (g - 1) * 256; X.sgn = 1; }
        else { X.r0 = g == 0 ? T_LAT + b * 256 + 255 : b * 8192 + 8191 - (g - 1) * 256; X.sgn = -1; }
        X.lbv = ((const float*)(p.ws + WS_LB))[(dir * 4 + l) * 512 + h * 128 + k]; X.omlb = 1.0f - X.lbv;
        X.zoff = 512 + dir * 512 + h * 128 + k; X.hv = 1536 + h * 64 + vt_v4; X.chain = (dir * 4 + b) * 4 + h; X.g = g; X.btot = 0.f;
#pragma unroll
        for (int kb = 0; kb < 8; ++kb) X.S[kb] = (f32x4){0.f, 0.f, 0.f, 0.f};
    };
    auto prefetch = [&](const H1Ctx& X, H1Pre& R, int sc) {
        const bf16_t* zb = HG + X.zoff;
#define H1_ROW(T) ((size_t)(X.r0 + X.sgn * (sc * 16 + (T))) * 2048)
        R.z0 = zb[H1_ROW(hf * 8 + 0)]; R.z1 = zb[H1_ROW(hf * 8 + 1)]; R.z2 = zb[H1_ROW(hf * 8 + 2)]; R.z3 = zb[H1_ROW(hf * 8 + 3)];
        R.z4 = zb[H1_ROW(hf * 8 + 4)]; R.z5 = zb[H1_ROW(hf * 8 + 5)]; R.z6 = zb[H1_ROW(hf * 8 + 6)]; R.z7 = zb[H1_ROW(hf * 8 + 7)];
        R.vv = *(const uint2*)(HG + H1_ROW(vt_t) + X.hv);
#undef H1_ROW
    };
    auto elem = [&](H1Ctx& X, const H1Pre& R, char* sm) {
        bf16_t* KH = (bf16_t*)(sm + HG_KH); bf16_t* VT = (bf16_t*)(sm + HG_VT); float* DD = (float*)(sm + HG_DD);
        const bf16_t zz[8] = {R.z0, R.z1, R.z2, R.z3, R.z4, R.z5, R.z6, R.z7};
        float bt[8], ky[8]; float cum = 0.f;
#pragma unroll
        for (int i = 0; i < 8; ++i) {
            const float e = fexp(-bf2f(zz[i]));
            const float sg = __builtin_amdgcn_rcpf(1.0f + e);
            cum += __builtin_amdgcn_logf(fmaxf(X.lbv + X.omlb * sg, 1e-30f)) * 0.6931471805599453f;
            bt[i] = cum; ky[i] = X.omlb * (1.0f - sg);
        }
        const float other = __shfl_xor(cum, 1);
        const float blast = cum + other, add = hf ? other : 0.f;
#pragma unroll
        for (int i = 0; i < 8; ++i) KH[k * 20 + hf * 8 + i] = f2bf(ky[i] * fexp(blast - (bt[i] + add)));
        if (hf == 0) DD[k] = fexp(blast);
        X.btot += blast;
        VT[(vt_v4 + 0) * 20 + vt_t] = (bf16_t)(R.vv.x & 0xffff); VT[(vt_v4 + 1) * 20 + vt_t] = (bf16_t)(R.vv.x >> 16);
        VT[(vt_v4 + 2) * 20 + vt_t] = (bf16_t)(R.vv.y & 0xffff); VT[(vt_v4 + 3) * 20 + vt_t] = (bf16_t)(R.vv.y >> 16);
    };
    auto update = [&](H1Ctx& X, const char* sm) {
        const bf16_t* KH = (const bf16_t*)(sm + HG_KH); const bf16_t* VT = (const bf16_t*)(sm + HG_VT); const float* DD = (const float*)(sm + HG_DD);
        const uint2 vtu = *(const uint2*)(VT + (16 * wid + c) * 20 + 4 * gq);
        const bf16x8 vtf = MK8(vtu.x, vtu.y, 0u, 0u);
#pragma unroll
        for (int kb = 0; kb < 8; ++kb) {
            const uint2 khu = *(const uint2*)(KH + (16 * kb + c) * 20 + 4 * gq);
            const f32x4 d4 = *(const f32x4*)(DD + 16 * kb + 4 * gq);
            X.S[kb] = __builtin_amdgcn_mfma_f32_16x16x32_bf16(MK8(khu.x, khu.y, 0u, 0u), vtf, X.S[kb] * d4, 0, 0, 0);
        }
    };
    auto store = [&](H1Ctx& X) {
        float* sst = (float*)(p.ws + WS_SST) + (size_t)(X.chain * 33 + X.g) * 8192;
#pragma unroll
        for (int kb = 0; kb < 8; ++kb)
#pragma unroll
            for (int r = 0; r < 4; ++r) sst[(16 * kb + 4 * gq + r) * 64 + 16 * wid + c] = X.S[kb][r];
        if (hf == 0) ((float*)(p.ws + WS_DSEG))[(size_t)(X.chain * 33 + X.g) * 128 + k] = fexp(X.btot);
    };
    H1Ctx A, B; H1Pre A0, A1, B0, B1;
    init(A, 0); init(B, 1);
    prefetch(A, A0, 0); prefetch(B, B0, 0); prefetch(A, A1, 1); prefetch(B, B1, 1);
    for (int sc = 0; sc < 16; sc += 2) {
        elem(A, A0, smem); elem(B, B0, smem + 17408);
        __syncthreads();
        { const int scn = sc + 2 < 16 ? sc + 2 : 15; prefetch(A, A0, scn); prefetch(B, B0, scn); }
        update(A, smem); update(B, smem + 17408);
        __syncthreads();
        elem(A, A1, smem); elem(B, B1, smem + 17408);
        __syncthreads();
        { const int scn = sc + 3 < 16 ? sc + 3 : 15; prefetch(A, A1, scn); prefetch(B, B1, scn); }
        update(A, smem); update(B, smem + 17408);
        __syncthreads();
    }
    store(A); store(B);
}
__device__ void hgrn3_unit(const Params& p, int l, int u, char* smem) {
    const int tb = u % 33, bh = u / 33, h = bh & 3, b = bh >> 2;
    hgrn_pass<1>(p, l, 0, b, h, tb, smem);
    hgrn_pass<2>(p, l, 1, b, h, tb == 0 ? 0 : 33 - tb, smem);
    const int ti = opaque_tid();
    const int row = tb == 0 ? T_LAT + b * 256 + ti : b * 8192 + (tb - 1) * 256 + ti;
    const bf16_t* OSEG = (const bf16_t*)(smem + HG_OSEG) + ti * 68;
    const bf16_t* gp = (const bf16_t*)(p.ws + WS_HG) + (size_t)row * 2048 + 1792 + h * 64;
    const float* gn = p.hg_norm_g + l * 64;
    bf16_t* yp = (bf16_t*)(p.ws + WS_H) + (size_t)row * 1024 + 768 + h * 64;
    float ss = 0.f;
#pragma unroll
    for (int q = 0; q < 16; ++q) {
        const uint2 w = *(const uint2*)(OSEG + q * 4);
        const float a0 = __uint_as_float(w.x << 16), a1 = __uint_as_float(w.x & 0xffff0000u), a2 = __uint_as_float(w.y << 16), a3 = __uint_as_float(w.y & 0xffff0000u);
        ss += a0 * a0 + a1 * a1 + a2 * a2 + a3 * a3;
    }
    const float rinv = rsqrtf(ss * (1.0f / 64.0f) + EPS);
#pragma unroll
    for (int q = 0; q < 16; ++q) {
        const uint2 w = *(const uint2*)(OSEG + q * 4);
        const uint2 gw = *(const uint2*)(gp + q * 4);
        float o[4] = {__uint_as_float(w.x << 16), __uint_as_float(w.x & 0xffff0000u), __uint_as_float(w.y << 16), __uint_as_float(w.y & 0xffff0000u)};
        const float gt[4] = {__uint_as_float(gw.x << 16), __uint_as_float(gw.x & 0xffff0000u), __uint_as_float(gw.y << 16), __uint_as_float(gw.y & 0xffff0000u)};
#pragma unroll
        for (int j = 0; j < 4; ++j) { const float sl = gt[j] / (1.0f + fexp(-gt[j])); o[j] = o[j] * rinv * gn[q * 4 + j] * sl; }
        uint2 ow; ow.x = pack2(o[0], o[1]); ow.y = pack2(o[2], o[3]);
        *(uint2*)(yp + q * 4) = ow;
    }
    __syncthreads();
}

__device__ void convert_T(const float* in, int K, int Nin, bf16_t* out, int Nout, int mode, const float* gs, size_t gtid, size_t gthreads) {
    const size_t total = (size_t)Nout * (K / 8);
    for (size_t idx = gtid; idx < total; idx += gthreads) {
        const int n = (int)(idx % Nout), k8 = (int)(idx / Nout);
        int src = n;
        if (mode == 1) {
            if (n < 1536) src = n; else if (n < 3584) src = n + 32; else if (n < 3616) src = n - 3584 + 1536; else src = -1;
        } else if (mode == 2) {
            const int hh = n >> 7, d = n & 127; src = d < 96 ? hh * 96 + d : -1;
        }
        float v[8];
#pragma unroll
        for (int j = 0; j < 8; ++j) {
            const int k = k8 * 8 + j;
            v[j] = src >= 0 ? in[(size_t)k * Nin + src] * (gs ? gs[k] : 1.0f) : 0.f;
        }
        uint4 w; w.x = pack2(v[0], v[1]); w.y = pack2(v[2], v[3]); w.z = pack2(v[4], v[5]); w.w = pack2(v[6], v[7]);
        *(uint4*)(out + (size_t)n * K + k8 * 8) = w;
    }
}
__device__ void convert_layer(const Params& p, int l, size_t gtid, size_t gthreads) {
    convert_T(p.w_in + (size_t)l * 1024 * 3616, 1024, 3616, (bf16_t*)(p.ws + WS_WIN), NIN, 1, nullptr, gtid, gthreads);
    convert_T(p.w_out + (size_t)l * 1024 * 1024, 1024, 1024, (bf16_t*)(p.ws + WS_WOUT), 1024, 0, nullptr, gtid, gthreads);
    convert_T(p.w_ff1 + (size_t)l * 1024 * 4096, 1024, 4096, (bf16_t*)(p.ws + WS_WFF1), 4096, 0, nullptr, gtid, gthreads);
    convert_T(p.w_ff2 + (size_t)l * 4096 * 1024, 4096, 1024, (bf16_t*)(p.ws + WS_WFF2), 1024, 0, nullptr, gtid, gthreads);
    convert_T(p.w_uq + (size_t)l * 256 * 576, 256, 576, (bf16_t*)(p.ws + WS_WUQ), 768, 2, p.g_cq + l * 256, gtid, gthreads);
    convert_T(p.w_ukv + (size_t)l * 128 * 768, 128, 768, (bf16_t*)(p.ws + WS_WUKV), 768, 0, p.g_ckv + l * 128, gtid, gthreads);
}
__device__ void adaln_phase(const Params& p, int l, const float* g, int shift_off, int scale_off, int nrows) {
    const int lane = opaque_tid() & 63;
    const int gw = blockIdx.x * 4 + (threadIdx.x >> 6), nw = gridDim.x * 4;
    bf16_t* H = (bf16_t*)(p.ws + WS_H);
    for (int row = gw; row < nrows; row += nw) {
        const float* xp = (l == 0 && shift_off == 0) ? xrow_in(p, row) : xrow(p, row);
        int b, key; bool lat; row_bk(row, b, key, lat);
        const float* md = (const float*)(p.ws + WS_MOD) + (size_t)(l * 5 + (lat ? b : 4)) * 6144;
        f32x4 v[4]; float ss = 0.f;
#pragma unroll
        for (int i = 0; i < 4; ++i) { v[i] = *(const f32x4*)(xp + i * 256 + lane * 4); ss += v[i][0] * v[i][0] + v[i][1] * v[i][1] + v[i][2] * v[i][2] + v[i][3] * v[i][3]; }
#pragma unroll
        for (int o = 32; o >= 1; o >>= 1) ss += __shfl_xor(ss, o);
        const float rinv = rsqrtf(ss * (1.0f / 1024.0f) + EPS);
#pragma unroll
        for (int i = 0; i < 4; ++i) {
            const int d = i * 256 + lane * 4;
            const f32x4 gg = *(const f32x4*)(g + d), sh = *(const f32x4*)(md + shift_off + d), sc = *(const f32x4*)(md + scale_off + d);
            float o[4];
#pragma unroll
            for (int j = 0; j < 4; ++j) o[j] = v[i][j] * rinv * gg[j] * (1.0f + sc[j]) + sh[j];
            uint2 w; w.x = pack2(o[0], o[1]); w.y = pack2(o[2], o[3]);
            *(uint2*)(H + (size_t)row * 1024 + d) = w;
        }
    }
}
__device__ void phase0(const Params& p, char* smem) {
    const size_t gtid = (size_t)blockIdx.x * 256 + threadIdx.x, gthreads = (size_t)gridDim.x * 256;
    const int tid = opaque_tid();
    if (gtid < 2 * 512) {
        const int dir = (int)gtid >> 9, cidx = (int)gtid & 511;
        float e[4], mx = -1e30f, s = 0.f;
#pragma unroll
        for (int l = 0; l < 4; ++l) { e[l] = p.hg_lb[(dir * 4 + l) * 512 + cidx]; mx = fmaxf(mx, e[l]); }
#pragma unroll
        for (int l = 0; l < 4; ++l) { e[l] = expf(e[l] - mx); s += e[l]; }
        float cum = 0.f;
#pragma unroll
        for (int l = 0; l < 4; ++l) { if (l > 0) cum += e[l] / s; ((float*)(p.ws + WS_LB))[(dir * 4 + l) * 512 + cidx] = cum; }
    }
    if (gtid >= 1024 && gtid < 1024 + 1024) {
        const int i = (int)gtid - 1024, pos = i >> 3, f = i & 7;
        const float inv = powf(10000.0f, -(float)f / 8.0f);
        const float ang = (float)pos * inv;
        ((float*)(p.ws + WS_ROPE))[i * 2] = cosf(ang); ((float*)(p.ws + WS_ROPE))[i * 2 + 1] = sinf(ang);
    }
    if (gtid >= 2048 && gtid < 2048 + 4) {
        const int l = (int)gtid - 2048;
        float s1 = 0.f, s2 = 0.f;
        for (int i = 0; i < 32; ++i) { s1 += p.da_lambda[(l * 4 + 0) * 32 + i] * p.da_lambda[(l * 4 + 1) * 32 + i]; s2 += p.da_lambda[(l * 4 + 2) * 32 + i] * p.da_lambda[(l * 4 + 3) * 32 + i]; }
        ((float*)(p.ws + WS_LAM))[l] = expf(s1) - expf(s2) + (0.8f - 0.6f * expf(-0.3f * (float)l));
    }
    if (gtid >= 4096 && gtid < 4096 + 512) ((unsigned*)(p.ws + WS_KMAX))[gtid - 4096] = 0u;
    float* sl = (float*)smem;
    float* red = sl + 5 * 1024;
    for (int i = tid; i < 5 * 1024; i += 256) {
        const int r = i >> 10, d = i & 1023;
        const float cv = r < 4 ? p.c[r * 1024 + d] : p.c_ctx[d];
        sl[i] = cv / (1.0f + expf(-cv));
    }
    __syncthreads();
    for (int u = blockIdx.x; u < 4 * 96; u += gridDim.x) {
        const int l = u / 96, cb = u % 96, col = tid & 63, kg = tid >> 6;
        const float* w = p.w_mod + (size_t)l * 1024 * 6144 + cb * 64 + col;
        float a[5] = {0.f, 0.f, 0.f, 0.f, 0.f};
        for (int d = kg * 256; d < kg * 256 + 256; ++d) {
            const float wv = w[(size_t)d * 6144];
#pragma unroll
            for (int r = 0; r < 5; ++r) a[r] += sl[r * 1024 + d] * wv;
        }
#pragma unroll
        for (int r = 0; r < 5; ++r) red[(kg * 5 + r) * 64 + col] = a[r];
        __syncthreads();
        if (tid < 64) {
#pragma unroll
            for (int r = 0; r < 5; ++r) {
                const float s = red[(0 * 5 + r) * 64 + tid] + red[(1 * 5 + r) * 64 + tid] + red[(2 * 5 + r) * 64 + tid] + red[(3 * 5 + r) * 64 + tid];
                ((float*)(p.ws + WS_MOD))[(size_t)(l * 5 + r) * 6144 + cb * 64 + tid] = s + p.b_mod[l * 6144 + cb * 64 + tid];
            }
        }
        __syncthreads();
    }
}
__device__ void hgrn_scan(const Params& p) {
    const size_t gtid = (size_t)blockIdx.x * 256 + opaque_tid(), gthreads = (size_t)gridDim.x * 256;
    float* sstb = (float*)(p.ws + WS_SST);
    const float* dseg = (const float*)(p.ws + WS_DSEG);
    for (size_t i = gtid; i < (size_t)32 * 8192; i += gthreads) {
        const int chain = (int)(i >> 13), e = (int)(i & 8191), k = e >> 6;
        float S = 0.f;
        float* sp = sstb + (size_t)chain * 33 * 8192 + e;
        const float* dp = dseg + (size_t)chain * 33 * 128 + k;
#pragma unroll 1
        for (int g0 = 0; g0 < 33; g0 += 11) {
            float t[11], d[11];
#pragma unroll
            for (int q = 0; q < 11; ++q) { t[q] = sp[(size_t)(g0 + q) * 8192]; d[q] = dp[(g0 + q) * 128]; }
#pragma unroll
            for (int q = 0; q < 11; ++q) { sp[(size_t)(g0 + q) * 8192] = S; S = d[q] * S + t[q]; }
        }
    }
}
__device__ void final_norm(const Params& p) {
    const int lane = opaque_tid() & 63;
    const int gw = blockIdx.x * 4 + (threadIdx.x >> 6), nw = gridDim.x * 4;
    for (int row = gw; row < T_LAT; row += nw) {
        float* xp = p.out + (size_t)row * 1024;
        f32x4 v[4]; float ss = 0.f;
#pragma unroll
        for (int i = 0; i < 4; ++i) { v[i] = *(const f32x4*)(xp + i * 256 + lane * 4); ss += v[i][0] * v[i][0] + v[i][1] * v[i][1] + v[i][2] * v[i][2] + v[i][3] * v[i][3]; }
#pragma unroll
        for (int o = 32; o >= 1; o >>= 1) ss += __shfl_xor(ss, o);
        const float rinv = rsqrtf(ss * (1.0f / 1024.0f) + EPS);
#pragma unroll
        for (int i = 0; i < 4; ++i) {
            const f32x4 gg = *(const f32x4*)(p.g_final + i * 256 + lane * 4);
            f32x4 o;
#pragma unroll
            for (int j = 0; j < 4; ++j) o[j] = v[i][j] * rinv * gg[j];
            *(f32x4*)(xp + i * 256 + lane * 4) = o;
        }
    }
}


#define XB_TMO      128
#define XB_XCNT(j)  (256  + 64 * (j))
#define XB_XSUB(j)  (1280 + 64 * (j))
#define XB_XGEN(j)  (2304 + 64 * (j))
#define XB_TOP      3328
#define XB_TOPGEN   3392
#define XCD_BAR_WORDS 3456
#define XB_SPIN_CAP (1u << 22)
__device__ __forceinline__ unsigned xb_ld(unsigned* p)              { return __hip_atomic_load(p, __ATOMIC_RELAXED, __HIP_MEMORY_SCOPE_AGENT); }
__device__ __forceinline__ unsigned xb_add(unsigned* p, unsigned v) { return __hip_atomic_fetch_add(p, v, __ATOMIC_RELAXED, __HIP_MEMORY_SCOPE_AGENT); }
__device__ __forceinline__ unsigned xb_xcc_id() { return (unsigned)__builtin_amdgcn_s_getreg((3 << 11) | 20) & 0xFu; }
#define XB_SPIN(cond, bar) do { unsigned _sp = 0; while (cond) { __builtin_amdgcn_s_sleep(1); \
    if ((++_sp & 255u) == 0u) { if (xb_ld(&(bar)[XB_TMO])) break; if (_sp > XB_SPIN_CAP) { atomicAdd(&(bar)[XB_TMO], 1u); break; } } } } while (0)
__device__ __forceinline__ void xcd_barrier_complete(unsigned* bar, unsigned x, unsigned& nloc, unsigned& nx) {
    const unsigned G = gridDim.x;
    unsigned sum, cnt, mine, sp = 0u;
    for (;;) {
        sum = 0u; cnt = 0u; mine = 0u;
#pragma unroll
        for (unsigned j = 0; j < 16; ++j) { const unsigned c = xb_ld(&bar[XB_XCNT(j)]); sum += c; cnt += (c > 0u) ? 1u : 0u; mine = (j == x) ? c : mine; }
        if (sum == G) break;
        __builtin_amdgcn_s_sleep(1);
        if ((++sp & 255u) == 0u) { if (xb_ld(&bar[XB_TMO])) break; if (sp > XB_SPIN_CAP) { atomicAdd(&bar[XB_TMO], 1u); break; } }
    }
    nloc = mine > 0u ? mine : 1u; nx = cnt > 0u ? cnt : 1u;
}
__device__ __forceinline__ void gsync(char* ws, unsigned& epoch) {
    asm volatile("s_waitcnt vmcnt(0) lgkmcnt(0)" ::: "memory");
    __syncthreads();
    ++epoch;
    if (threadIdx.x == 0) {
        extern __shared__ __attribute__((aligned(16))) char smem_[];
        volatile unsigned* st = (volatile unsigned*)(smem_ + 73728 + 768);
        unsigned* bar = (unsigned*)(ws + WS_XBAR);
        const unsigned x = xb_xcc_id();
        __builtin_amdgcn_s_waitcnt(0);
        unsigned nloc = st[0], nx = st[1];
        if (nloc == 0u) { xcd_barrier_complete(bar, x, nloc, nx); st[0] = nloc; st[1] = nx; }
        const unsigned old = xb_add(&bar[XB_XSUB(x)], 1u);
        const unsigned gen = old / nloc;
        if (old + 1u == (gen + 1u) * nloc) {
            __builtin_amdgcn_fence(__ATOMIC_RELEASE, "agent");
            asm volatile("s_waitcnt vmcnt(0)" ::: "memory");
            const unsigned og = xb_add(&bar[XB_TOP], 1u);
            const unsigned tg = og / nx;
            if (og + 1u == (tg + 1u) * nx) xb_add(&bar[XB_TOPGEN], 1u);
            else XB_SPIN(xb_ld(&bar[XB_TOPGEN]) == tg, bar);
            __builtin_amdgcn_fence(__ATOMIC_ACQUIRE, "agent");
            xb_add(&bar[XB_XGEN(x)], 1u);
            asm volatile("s_waitcnt vmcnt(0)" ::: "memory");
        } else {
            XB_SPIN(xb_ld(&bar[XB_XGEN(x)]) == gen, bar);
            __builtin_amdgcn_fence(__ATOMIC_ACQUIRE, "agent");
            asm volatile("s_waitcnt vmcnt(0)" ::: "memory");
        }
    }
    __syncthreads();
}

__device__ __forceinline__ int next_unit(char* ws, int qidx, char* smem) {
    int* sh = (int*)(smem + 73728 + 512);
    __syncthreads();
    if (threadIdx.x == 0) *sh = (int)__hip_atomic_fetch_add((unsigned*)(ws + WS_BAR + 32) + qidx, 1u, __ATOMIC_RELAXED, __HIP_MEMORY_SCOPE_AGENT);
    __syncthreads();
    return *sh;
}

__device__ __forceinline__ bool tile_of(int r, int nt, int total, int& tm, int& tn, int G = 8) {
    const int bx = blockIdx.x, nx = gridDim.x >> 3;
    const int L = (r * 8 + (bx & 7)) * nx + (bx >> 3);
    if (L >= total || nx != 64) { if (nx == 64) return false; const int u = bx + r * gridDim.x; if (u >= total) return false; tm = u / nt; tn = u % nt; return true; }
    const int mg = L / (nt * G), rem = L % (nt * G);
    tn = rem / G; tm = mg * G + (rem % G);
    return true;
}
__device__ __forceinline__ Params launder(const Params& p) {
    Params q = p;
    GAS char* w = (GAS char*)p.ws; GAS float* o = (GAS float*)p.out;
    asm volatile("" : "+s"(w), "+s"(o));
    q.ws = (char*)w; q.out = (float*)o;
    return q;
}
__global__ void __launch_bounds__(256, 2) fwd_megakernel(Params p0) {
    extern __shared__ __attribute__((aligned(16))) char smem[];
    cg::grid_group grid = cg::this_grid();
    const size_t gtid = (size_t)blockIdx.x * 256 + threadIdx.x, gthreads = (size_t)gridDim.x * 256;
    float* rs = (float*)(smem + 73728);
    unsigned epoch = 0;
    if (threadIdx.x == 0) { volatile unsigned* st = (volatile unsigned*)(smem + 73728 + 768); st[0] = 0u; st[1] = 0u; (void)xb_add((unsigned*)(p0.ws + WS_XBAR) + XB_XCNT(xb_xcc_id()), 1u); }
    __syncthreads();
    grid.sync();

#ifndef OPK
#define OPK 1024
#define OPK0 0
#endif
#ifndef REP_SKIP_ATT
#define REP_SKIP_ATT 0
#endif
#ifndef REP_B
#define REP_B 1
#endif
#ifndef REP_D
#define REP_D 1
#endif
#ifndef REP_E
#define REP_E 1
#endif
#ifndef REP_H
#define REP_H 1
#endif
#ifndef PM
#define PM 0xffff
#endif
    { const Params p = launder(p0); if (PM & 1) phase0(p, smem); }
    { const Params p = launder(p0); if (PM & 2) convert_layer(p, 0, gtid, gthreads); }
    gsync(p0.ws, epoch);

    for (int l = 0; l < 4; ++l) {
        const bool last = (l == 3);
        { const Params p = launder(p0); if (PM & 4) adaln_phase(p, l, p.g_mix + l * 1024, 0, 1024, T_ALL); }
        { const Params p = launder(p0); if ((PM & 2) && l > 0) convert_layer(p, l, gtid, gthreads); }
        gsync(p0.ws, epoch);
        if (PM & 8) for (int rr = 0;; ++rr) {
            int tm, tn; if (!tile_of(rr, 29, 132 * 29, tm, tn, 4)) break;
            const Params p = launder(p0);
            Acc2 C;
            gemm_tile_core2((const bf16_t*)(p.ws + WS_H) + (size_t)tm * 256 * 1024, 1024, (const bf16_t*)(p.ws + WS_WIN) + (size_t)tn * 128 * 1024, 1024, 1024, smem, C);
            gemm2_stage(C, 0, smem);
            epi_inproj(p, l, tm * 256, tn, (const float*)smem);
            __syncthreads();
            gemm2_stage(C, 1, smem);
            epi_inproj(p, l, tm * 256 + 128, tn, (const float*)smem);
            __syncthreads();
        }
        gsync(p0.ws, epoch);
        for (int rep = 0; rep < REP_D; ++rep) { if (rep) gsync(p0.ws, epoch);
        for (;;) {
            const int u = next_unit(p0.ws, l * 2 + 0 + rep * 8, smem);
            if (u >= 528 + 2 * 1584) break;
            const Params p = launder(p0);
            if (u < 528) { if (PM & 16) {
                const int g = u % 33, ch = u / 33, h = ch & 3, b = (ch >> 2) & 3;
                hgrn_h1_pair(p, l, b, h, g, smem); }
            } else if (!(PM & 32)) {} else if (u < 528 + 1584) {
                const int v = u - 528, tm = v / 6, h = v % 6;
                row_rstd(p, 0, tm * 128, rs);
                gemm_tile_core((const bf16_t*)(p.ws + WS_CQ) + (size_t)tm * 128 * 256, 256, (const bf16_t*)(p.ws + WS_WUQ) + (size_t)h * 128 * 256, 256, 256, smem);
                epi_uq(p, tm * 128, h, (const float*)smem, rs);
                __syncthreads();
            } else {
                const int v = u - 528 - 1584, tm = v / 6, h = v % 6;
                row_rstd(p, 1, tm * 128, rs);
                gemm_tile_core((const bf16_t*)(p.ws + WS_CKV) + (size_t)tm * 128 * 128, 128, (const bf16_t*)(p.ws + WS_WUKV) + (size_t)h * 128 * 128, 128, 128, smem);
                epi_ukv(p, l, tm * 128, h, (const float*)smem, rs);
                __syncthreads();
            }
        } }
        gsync(p0.ws, epoch);
        { const Params p = launder(p0); if (PM & 64) hgrn_scan(p); }
        gsync(p0.ws, epoch);
        {
            { int* st2 = (int*)(smem + 73728 + 520); __syncthreads(); if (threadIdx.x == 0) { st2[0] = 0; } }
            for (;;) {
                    int* sh = (int*)(smem + 73728 + 512);
                    __syncthreads();
                    if (threadIdx.x == 0) {
                        const int qlen_ = 450 + (l == 3 ? 0 : 12);
                        const unsigned xq_ = xb_xcc_id() & 7u;
                        int dq_ = sh[2], got = -1, qq = 0;
                        while (dq_ < 8) {
                            qq = (int)((xq_ + dq_) & 7u);
                            const int v = (int)__hip_atomic_fetch_add((unsigned*)(p0.ws + WS_XBAR) + l * 8 + qq, 1u, __ATOMIC_RELAXED, __HIP_MEMORY_SCOPE_AGENT);
                            if (v < qlen_) { got = v; break; }
                            ++dq_;
                        }
                        sh[2] = dq_; sh[0] = got; sh[1] = qq;
                    }
                    __syncthreads();
                    const int i = __builtin_amdgcn_readfirstlane(sh[0]), q = __builtin_amdgcn_readfirstlane(sh[1]);
                    if (i < 0) break;
                    const Params p = launder(p0);
                    const int nh3 = (i + 5) / 6 < 66 ? (i + 5) / 6 : 66;
                    if (i < 450 && i % 6 == 0 && i / 6 < 66) { if (PM & 256) hgrn3_unit(p, l, q * 66 + i / 6, smem); }
                    else {
                        int b, hh, qbi;
                        if (i < 450) { const int a = i - nh3; const int bh = q + 8 * (a >> 6); qbi = a & 63; b = (bh / 6) & 3; hh = (bh >= 24 ? 6 : 0) + bh % 6; }
                        else { const int cidx = q * 12 + (i - 450); qbi = 64 + (cidx & 1); const int bh = cidx >> 1; hh = bh % 12; b = bh / 12; }
                        if (PM & 128) attn_unit(p, l, b, hh, qbi, smem);
                    }
            }
        }
        gsync(p0.ws, epoch);
        const int ntm = last ? 256 : 264;
        if (PM & 512) for (int rr = 0;; ++rr) {
            int tm, tn; if (!tile_of(rr, 8, ntm * 8, tm, tn)) break;
            const Params p = launder(p0);
            gemm_tile_core((const bf16_t*)(p.ws + WS_H) + (size_t)tm * 128 * 1024 + OPK0, 1024, (const bf16_t*)(p.ws + WS_WOUT) + (size_t)tn * 128 * 1024 + OPK0, 1024, OPK, smem);
            epi_resid(p, l, tm * 128, tn * 128, 2 * 1024, (const float*)smem);
            __syncthreads();
        }
        gsync(p0.ws, epoch);
        { const Params p = launder(p0); adaln_phase(p, l, p.g_mlp + l * 1024, 3 * 1024, 4 * 1024, ntm * 128); }
        gsync(p0.ws, epoch);
        if (PM & 1024) for (int rr = 0;; ++rr) {
            int tm, tn; if (!tile_of(rr, 32, (ntm / 2) * 32, tm, tn, 4)) break;
            const Params p = launder(p0);
            Acc2 C;
            gemm_tile_core2((const bf16_t*)(p.ws + WS_H) + (size_t)tm * 256 * 1024, 1024, (const bf16_t*)(p.ws + WS_WFF1) + (size_t)tn * 128 * 1024, 1024, 1024, smem, C);
            gemm2_stage(C, 0, smem);
            epi_ff1(p, tm * 256, tn * 128, (const float*)smem);
            __syncthreads();
            gemm2_stage(C, 1, smem);
            epi_ff1(p, tm * 256 + 128, tn * 128, (const float*)smem);
            __syncthreads();
        }
        gsync(p0.ws, epoch);
        if (PM & 2048) for (int rr = 0;; ++rr) {
            int tm, tn; if (!tile_of(rr, 8, ntm * 8, tm, tn)) break;
            const Params p = launder(p0);
            gemm_tile_core((const bf16_t*)(p.ws + WS_H1) + (size_t)tm * 128 * 4096, 4096, (const bf16_t*)(p.ws + WS_WFF2) + (size_t)tn * 128 * 4096, 4096, 4096, smem);
            epi_resid(p, l, tm * 128, tn * 128, 5 * 1024, (const float*)smem);
            __syncthreads();
        }
        gsync(p0.ws, epoch);
    }
    { const Params p = launder(p0); final_norm(p); }
}

extern "C" void kernel_launch(void* const* d_in, const int* in_sizes, int n_in, void* d_out, int out_size, void* d_ws, size_t ws_size, hipStream_t stream) {
    static int grid_blocks = 0;
    if (!grid_blocks) {
        int dev = 0, cus = 0, per_cu = 0;
        hipGetDevice(&dev);
        hipDeviceGetAttribute(&cus, hipDeviceAttributeMultiprocessorCount, dev);
        hipFuncSetAttribute((const void*)fwd_megakernel, hipFuncAttributeMaxDynamicSharedMemorySize, SMEM_BYTES);
        hipOccupancyMaxActiveBlocksPerMultiprocessor(&per_cu, (const void*)fwd_megakernel, 256, SMEM_BYTES);
        if (per_cu < 1) per_cu = 1;
        if (per_cu > 2) per_cu = 2;
        grid_blocks = cus * per_cu;
        if (ws_size < WS_END2) fprintf(stderr, "workspace too small: %zu < %zu\n", ws_size, (size_t)WS_END2);
    }
    hipMemsetAsync((char*)d_ws + WS_BAR, 0, 128, stream);
    hipMemsetAsync((char*)d_ws + WS_XBAR, 0, XCD_BAR_WORDS * 4, stream);
    Params p{};
    const float** pp = (const float**)&p;
    for (int i = 0; i < 21; ++i) pp[i] = (const float*)d_in[i];
    p.out = (float*)d_out; p.ws = (char*)d_ws;
    void* args[] = {&p};
    hipError_t e = hipLaunchCooperativeKernel((const void*)fwd_megakernel, dim3(grid_blocks), dim3(256), args, SMEM_BYTES, stream);
    if (e != hipSuccess) fprintf(stderr, "cooperative launch failed: %s (grid %d)\n", hipGetErrorString(e), grid_blocks);
}
```

```cpp
#include <hip/hip_runtime.h>
#include <hip/hip_cooperative_groups.h>
#include <stdint.h>
#include <cstdio>
namespace cg = cooperative_groups;

#define GAS __attribute__((address_space(1)))
typedef unsigned short bf16_t;
typedef short bf16x8 __attribute__((ext_vector_type(8)));
typedef short bf16x4 __attribute__((ext_vector_type(4)));
typedef float f32x16 __attribute__((ext_vector_type(16)));
typedef float f32x4 __attribute__((ext_vector_type(4)));
typedef unsigned u32x4 __attribute__((ext_vector_type(4)));
typedef unsigned u32x2 __attribute__((ext_vector_type(2)));
#define MK8(a,b,c,d) __builtin_bit_cast(bf16x8, (u32x4){(a),(b),(c),(d)})
#define MK4(a,b) __builtin_bit_cast(bf16x4, (u32x2){(a),(b)})

constexpr int T_LAT = 32768, T_CTX = 1024, T_ALL = 33792, NKEY = 8448, DM = 1024, NIN = 3712, DFF = 4096;
constexpr float EPS = 1e-6f;
constexpr float LOG2E = 1.4426950408889634f;

constexpr size_t WS_WIN = 0;
constexpr size_t WS_WOUT = WS_WIN + (size_t)NIN * 1024 * 2;
constexpr size_t WS_WFF1 = WS_WOUT + (size_t)1024 * 1024 * 2;
constexpr size_t WS_WFF2 = WS_WFF1 + (size_t)4096 * 1024 * 2;
constexpr size_t WS_WUQ = WS_WFF2 + (size_t)4096 * 1024 * 2;
constexpr size_t WS_WUKV = WS_WUQ + (size_t)768 * 256 * 2;
constexpr size_t WS_XC = WS_WUKV + (size_t)768 * 128 * 2;
constexpr size_t WS_MOD = WS_XC + (size_t)1024 * 1024 * 4;
constexpr size_t WS_LB = WS_MOD + (size_t)4 * 5 * 6144 * 4;
constexpr size_t WS_LAM = WS_LB + (size_t)2 * 4 * 512 * 4;
constexpr size_t WS_ROPE = WS_LAM + 256;
constexpr size_t WS_KMAX = WS_ROPE + 8192;
constexpr size_t WS_DSEG = WS_KMAX + 2048;
constexpr size_t WS_H = WS_DSEG + (size_t)32 * 33 * 128 * 4;
constexpr size_t WS_R = WS_H + (size_t)T_ALL * 1024 * 2;
constexpr size_t WS_QDA = WS_R;
constexpr size_t WS_KDA = WS_QDA + (size_t)T_ALL * 384 * 2;
constexpr size_t WS_VDAT = WS_KDA + (size_t)T_ALL * 384 * 2;
constexpr size_t WS_QMLA = WS_VDAT + (size_t)T_ALL * 384 * 2;
constexpr size_t WS_KMLA = WS_QMLA + (size_t)T_ALL * 576 * 2;
constexpr size_t WS_VMLAT = WS_KMLA + (size_t)T_ALL * 576 * 2;
constexpr size_t WS_CQ = WS_VMLAT + (size_t)T_ALL * 384 * 2;
constexpr size_t WS_CKV = WS_CQ + (size_t)T_ALL * 256 * 2;
constexpr size_t WS_KR = WS_CKV + (size_t)T_ALL * 128 * 2;
constexpr size_t WS_HG = WS_KR + (size_t)T_ALL * 32 * 2;
constexpr size_t WS_SST = WS_HG + (size_t)T_ALL * 2048 * 2;
constexpr size_t WS_END = WS_SST + (size_t)32 * 33 * 8192 * 4;
constexpr size_t WS_XBAR = WS_END;
constexpr size_t WS_SSQ = WS_XBAR + 16384;
constexpr size_t WS_END2 = WS_SSQ + (size_t)T_ALL * 4 * 4;
constexpr size_t WS_H1 = WS_R;
constexpr size_t WS_BAR = WS_LAM + 128;
static_assert(WS_R + (size_t)T_ALL * 4096 * 2 <= WS_END + (64u << 20), "h1 overlay");
static_assert(WS_END2 <= 536870912ull, "workspace too large");
static_assert(WS_R + (size_t)T_ALL * 4096 * 2 <= 536870912ull, "workspace too large (h1)");

constexpr int SMEM_BYTES = 73728 + 1024;

struct Params {
    const float *x, *c, *ctx, *c_ctx, *w_mod, *b_mod, *g_mix, *g_mlp, *w_in, *w_out, *da_lambda, *da_subln_g, *g_cq, *g_ckv, *w_uq, *w_ukv, *hg_lb, *hg_norm_g, *w_ff1, *w_ff2, *g_final;
    float* out;
    char* ws;
};

__device__ __forceinline__ int opaque_tid() { int t = threadIdx.x; asm volatile("" : "+v"(t)); return t; }
__device__ __forceinline__ bf16_t f2bf(float f) { unsigned u = __float_as_uint(f); u += 0x7fffu + ((u >> 16) & 1u); return (bf16_t)(u >> 16); }
__device__ __forceinline__ float bf2f(bf16_t h) { return __uint_as_float(((unsigned)h) << 16); }
typedef __bf16 bf16v2_t __attribute__((ext_vector_type(2)));
typedef float f32v2_t __attribute__((ext_vector_type(2)));
__device__ __forceinline__ unsigned pack2(float a, float b) { const f32v2_t f = {a, b}; const bf16v2_t r = __builtin_convertvector(f, bf16v2_t); return __builtin_bit_cast(unsigned, r); }
__device__ __forceinline__ unsigned cvt_pk(float lo, float hi) { return pack2(lo, hi); }
__device__ __forceinline__ float ld_coh(const float* p) { return __hip_atomic_load(p, __ATOMIC_RELAXED, __HIP_MEMORY_SCOPE_AGENT); }
__device__ __forceinline__ float fexp2(float x) { return __builtin_amdgcn_exp2f(x); }
__device__ __forceinline__ float fexp(float x) { return __builtin_amdgcn_exp2f(x * LOG2E); }

__device__ __forceinline__ void row_bk(int row, int& b, int& key, bool& lat) {
    if (row < T_LAT) { b = row >> 13; key = 256 + (row & 8191); lat = true; }
    else { int r = row - T_LAT; b = r >> 8; key = r & 255; lat = false; }
}
__device__ __forceinline__ const float* xrow_in(const Params& p, int row) {
    return row < T_LAT ? p.x + (size_t)row * 1024 : p.ctx + (size_t)(row - T_LAT) * 1024;
}
__device__ __forceinline__ float* xrow(const Params& p, int row) {
    return row < T_LAT ? p.out + (size_t)row * 1024 : (float*)(p.ws + WS_XC) + (size_t)(row - T_LAT) * 1024;
}

__device__ __forceinline__ void gemm_tile_core(const bf16_t* __restrict__ A, int lda, const bf16_t* __restrict__ Bt, int ldb, int K, char* smem) {
    const int tid = opaque_tid(), lane = tid & 63, wid = tid >> 6;
    const int wm = wid >> 1, wn = wid & 1, l31 = lane & 31, hi = lane >> 5;
    f32x16 acc[2][2];
#pragma unroll
    for (int i = 0; i < 2; ++i)
#pragma unroll
        for (int j = 0; j < 2; ++j)
#pragma unroll
            for (int r = 0; r < 16; ++r) acc[i][j][r] = 0.f;
    const int lrow = tid >> 3, lkc = tid & 7;
    const bf16_t* ap = A + (size_t)lrow * lda + lkc * 8;
    const bf16_t* bp = Bt + (size_t)lrow * ldb + lkc * 8;
    uint4 p0, p1, p2, p3, p4, p5, p6, p7, q0, q1, q2, q3, q4, q5, q6, q7;
    const int nk = K >> 6;
    const size_t sA = (size_t)32 * lda, sB = (size_t)32 * ldb;
#define G_LOAD0(KT) { const bf16_t* a_ = ap + (KT) * 64; const bf16_t* b_ = bp + (KT) * 64; p0 = *(const uint4*)(a_); p1 = *(const uint4*)(a_ + sA); p2 = *(const uint4*)(a_ + 2 * sA); p3 = *(const uint4*)(a_ + 3 * sA); \
        p4 = *(const uint4*)(b_); p5 = *(const uint4*)(b_ + sB); p6 = *(const uint4*)(b_ + 2 * sB); p7 = *(const uint4*)(b_ + 3 * sB); }
#define G_LOAD1(KT) { const bf16_t* a_ = ap + (KT) * 64; const bf16_t* b_ = bp + (KT) * 64; q0 = *(const uint4*)(a_); q1 = *(const uint4*)(a_ + sA); q2 = *(const uint4*)(a_ + 2 * sA); q3 = *(const uint4*)(a_ + 3 * sA); \
        q4 = *(const uint4*)(b_); q5 = *(const uint4*)(b_ + sB); q6 = *(const uint4*)(b_ + 2 * sB); q7 = *(const uint4*)(b_ + 3 * sB); }
#define G_WRITE0(BUF) { char* wa_ = smem + (BUF) * 36864 + lrow * 144 + lkc * 16; char* wb_ = wa_ + 18432; *(uint4*)(wa_) = p0; *(uint4*)(wa_ + 4608) = p1; *(uint4*)(wa_ + 9216) = p2; *(uint4*)(wa_ + 13824) = p3; \
        *(uint4*)(wb_) = p4; *(uint4*)(wb_ + 4608) = p5; *(uint4*)(wb_ + 9216) = p6; *(uint4*)(wb_ + 13824) = p7; }
#define G_WRITE1(BUF) { char* wa_ = smem + (BUF) * 36864 + lrow * 144 + lkc * 16; char* wb_ = wa_ + 18432; *(uint4*)(wa_) = q0; *(uint4*)(wa_ + 4608) = q1; *(uint4*)(wa_ + 9216) = q2; *(uint4*)(wa_ + 13824) = q3; \
        *(uint4*)(wb_) = q4; *(uint4*)(wb_ + 4608) = q5; *(uint4*)(wb_ + 9216) = q6; *(uint4*)(wb_ + 13824) = q7; }
#define G_COMPUTE(BUF) { const char* sa = smem + (BUF) * 36864; const char* sb = sa + 18432; \
        _Pragma("unroll") for (int ks = 0; ks < 4; ++ks) { bf16x8 af[2], bfr[2]; \
            _Pragma("unroll") for (int i = 0; i < 2; ++i) af[i] = *(const bf16x8*)(sa + (wm * 64 + i * 32 + l31) * 144 + ks * 32 + hi * 16); \
            _Pragma("unroll") for (int j = 0; j < 2; ++j) bfr[j] = *(const bf16x8*)(sb + (wn * 64 + j * 32 + l31) * 144 + ks * 32 + hi * 16); \
            _Pragma("unroll") for (int i = 0; i < 2; ++i) _Pragma("unroll") for (int j = 0; j < 2; ++j) acc[i][j] = __builtin_amdgcn_mfma_f32_32x32x16_bf16(af[i], bfr[j], acc[i][j], 0, 0, 0); } }
    G_LOAD0(0);
    G_WRITE0(0);
    G_LOAD0(1);
    { const int k2 = nk > 2 ? 2 : nk - 1; G_LOAD1(k2); }
    __syncthreads();
    for (int kt = 0; kt < nk; kt += 2) {
        G_COMPUTE(0);
        G_WRITE0(1);
        { const int k3 = kt + 3 < nk ? kt + 3 : nk - 1; G_LOAD0(k3); }
        __syncthreads();
        G_COMPUTE(1);
        G_WRITE1(0);
        { const int k4 = kt + 4 < nk ? kt + 4 : nk - 1; G_LOAD1(k4); }
        __syncthreads();
    }
#undef G_LOAD0
#undef G_LOAD1
#undef G_WRITE0
#undef G_WRITE1
#undef G_COMPUTE
    float* cs = (float*)smem;
#pragma unroll
    for (int i = 0; i < 2; ++i)
#pragma unroll
        for (int j = 0; j < 2; ++j)
#pragma unroll
            for (int r = 0; r < 16; ++r)
                cs[(wm * 64 + i * 32 + 8 * (r >> 2) + 4 * hi + (r & 3)) * 132 + wn * 64 + j * 32 + l31] = acc[i][j][r];
    __syncthreads();
}


struct Acc2 { f32x16 a[4][2]; };
__device__ __forceinline__ void gemm_tile_core2(const bf16_t* __restrict__ A, int lda, const bf16_t* __restrict__ Bt, int ldb, int K, char* smem, Acc2& C) {
    const int tid = opaque_tid(), lane = tid & 63, wid = tid >> 6;
    const int wm = wid >> 1, wn = wid & 1, l31 = lane & 31, hi = lane >> 5;
#pragma unroll
    for (int i = 0; i < 4; ++i)
#pragma unroll
        for (int j = 0; j < 2; ++j)
#pragma unroll
            for (int r = 0; r < 16; ++r) C.a[i][j][r] = 0.f;
    const int lrow = tid >> 2, lkc = tid & 3;
    const bf16_t* ap = A + (size_t)lrow * lda + lkc * 8;
    const bf16_t* bp = Bt + (size_t)lrow * ldb + lkc * 8;
    const size_t sA = (size_t)64 * lda, sB = (size_t)64 * ldb;
    uint4 p0, p1, p2, p3, p4, p5, q0, q1, q2, q3, q4, q5;
    const int nk = K >> 5;
    constexpr int STG = 30720, BOFF = 20480;
#define H_LOAD0(KT) { const bf16_t* a_ = ap + (KT) * 32; const bf16_t* b_ = bp + (KT) * 32; p0 = *(const uint4*)(a_); p1 = *(const uint4*)(a_ + sA); p2 = *(const uint4*)(a_ + 2 * sA); p3 = *(const uint4*)(a_ + 3 * sA); \
        p4 = *(const uint4*)(b_); p5 = *(const uint4*)(b_ + sB); }
#define H_LOAD1(KT) { const bf16_t* a_ = ap + (KT) * 32; const bf16_t* b_ = bp + (KT) * 32; q0 = *(const uint4*)(a_); q1 = *(const uint4*)(a_ + sA); q2 = *(const uint4*)(a_ + 2 * sA); q3 = *(const uint4*)(a_ + 3 * sA); \
        q4 = *(const uint4*)(b_); q5 = *(const uint4*)(b_ + sB); }
#define H_WRITE0(BUF) { char* wa_ = smem + (BUF) * STG + lrow * 80 + lkc * 16; char* wb_ = wa_ + BOFF; *(uint4*)(wa_) = p0; *(uint4*)(wa_ + 5120) = p1; *(uint4*)(wa_ + 10240) = p2; *(uint4*)(wa_ + 15360) = p3; \
        *(uint4*)(wb_) = p4; *(uint4*)(wb_ + 5120) = p5; }
#define H_WRITE1(BUF) { char* wa_ = smem + (BUF) * STG + lrow * 80 + lkc * 16; char* wb_ = wa_ + BOFF; *(uint4*)(wa_) = q0; *(uint4*)(wa_ + 5120) = q1; *(uint4*)(wa_ + 10240) = q2; *(uint4*)(wa_ + 15360) = q3; \
        *(uint4*)(wb_) = q4; *(uint4*)(wb_ + 5120) = q5; }
#define H_COMPUTE(BUF) { const char* sa = smem + (BUF) * STG; const char* sb = sa + BOFF; \
        _Pragma("unroll") for (int ks = 0; ks < 2; ++ks) { bf16x8 af[4], bfr[2]; \
            _Pragma("unroll") for (int i = 0; i < 4; ++i) af[i] = *(const bf16x8*)(sa + (wm * 128 + i * 32 + l31) * 80 + ks * 32 + hi * 16); \
            _Pragma("unroll") for (int j = 0; j < 2; ++j) bfr[j] = *(const bf16x8*)(sb + (wn * 64 + j * 32 + l31) * 80 + ks * 32 + hi * 16); \
            _Pragma("unroll") for (int i = 0; i < 4; ++i) _Pragma("unroll") for (int j = 0; j < 2; ++j) C.a[i][j] = __builtin_amdgcn_mfma_f32_32x32x16_bf16(af[i], bfr[j], C.a[i][j], 0, 0, 0); } }
    H_LOAD0(0);
    H_WRITE0(0);
    H_LOAD0(1);
    { const int k2 = nk > 2 ? 2 : nk - 1; H_LOAD1(k2); }
    __syncthreads();
    for (int kt = 0; kt < nk; kt += 2) {
        H_COMPUTE(0);
        H_WRITE0(1);
        { const int k3 = kt + 3 < nk ? kt + 3 : nk - 1; H_LOAD0(k3); }
        __syncthreads();
        H_COMPUTE(1);
        H_WRITE1(0);
        { const int k4 = kt + 4 < nk ? kt + 4 : nk - 1; H_LOAD1(k4); }
        __syncthreads();
    }
#undef H_LOAD0
#undef H_LOAD1
#undef H_WRITE0
#undef H_WRITE1
#undef H_COMPUTE
}
__device__ __forceinline__ void gemm2_stage(const Acc2& C, int half, char* smem) {
    const int tid = opaque_tid(), lane = tid & 63, wid = tid >> 6;
    const int wm = wid >> 1, wn = wid & 1, l31 = lane & 31, hi = lane >> 5;
    float* cs = (float*)smem;
    if (wm == half) {
#pragma unroll
        for (int i = 0; i < 4; ++i)
#pragma unroll
            for (int j = 0; j < 2; ++j)
#pragma unroll
                for (int r = 0; r < 16; ++r)
                    cs[(i * 32 + 8 * (r >> 2) + 4 * hi + (r & 3)) * 132 + wn * 64 + j * 32 + l31] = C.a[i][j][r];
    }
    __syncthreads();
}

__device__ __forceinline__ void epi_copy_bf16(const float* cs, bf16_t* dst, int ld, int row0, int col0, float sc) {
    const int tid = opaque_tid(), c4 = (tid & 31) * 4, r0 = tid >> 5;
#pragma unroll 4
    for (int i = 0; i < 16; ++i) {
        const int r = r0 + 8 * i;
        const f32x4 v = *(const f32x4*)(cs + r * 132 + c4);
        uint2 w; w.x = pack2(v[0] * sc, v[1] * sc); w.y = pack2(v[2] * sc, v[3] * sc);
        *(uint2*)(dst + (size_t)(row0 + r) * ld + col0 + c4) = w;
    }
}
__device__ __forceinline__ void epi_store_T(const float* cs, int cbase, int ndcols, bf16_t* dstbase  , const float* rs) {
    const int tid = opaque_tid();
    const int items = ndcols * 16;
    for (int it = tid; it < items; it += 256) {
        const int c = it % ndcols, rg = it / ndcols;
        float v[8];
#pragma unroll
        for (int j = 0; j < 8; ++j) { v[j] = cs[(rg * 8 + j) * 132 + cbase + c]; if (rs) v[j] *= rs[rg * 8 + j]; }
        uint4 w; w.x = pack2(v[0], v[1]); w.y = pack2(v[2], v[3]); w.z = pack2(v[4], v[5]); w.w = pack2(v[6], v[7]);
        *(uint4*)(dstbase + (size_t)c * NKEY + rg * 8) = w;
    }
}
__device__ __forceinline__ void rope32(float (&v)[32], int n, const float* rope) {
#pragma unroll
    for (int a = 0; a < 2; ++a) {
        const int pos = a == 0 ? (n >> 6) : (n & 63);
#pragma unroll
        for (int f = 0; f < 8; ++f) {
            const float cs_ = rope[(pos * 8 + f) * 2], sn = rope[(pos * 8 + f) * 2 + 1];
            const float x1 = v[a * 16 + f], x2 = v[a * 16 + 8 + f];
            v[a * 16 + f] = x1 * cs_ - x2 * sn;
            v[a * 16 + 8 + f] = x2 * cs_ + x1 * sn;
        }
    }
}
__device__ __forceinline__ float wave_max(float v) {
#pragma unroll
    for (int o = 32; o >= 1; o >>= 1) v = fmaxf(v, __shfl_xor(v, o));
    return v;
}
__device__ __forceinline__ void store32_bf16(bf16_t* dst, const float (&v)[32], float sc) {
#pragma unroll
    for (int q = 0; q < 4; ++q) {
        uint4 w; w.x = pack2(v[q * 8 + 0] * sc, v[q * 8 + 1] * sc); w.y = pack2(v[q * 8 + 2] * sc, v[q * 8 + 3] * sc);
        w.z = pack2(v[q * 8 + 4] * sc, v[q * 8 + 5] * sc); w.w = pack2(v[q * 8 + 6] * sc, v[q * 8 + 7] * sc);
        *(uint4*)(dst + q * 8) = w;
    }
}

__device__ void epi_inproj(const Params& p, int l, int m0, int tn, const float* cs) {
    const int tid = opaque_tid();
    int b, key0; bool lat; row_bk(m0, b, key0, lat);
    const float* rope = (const float*)(p.ws + WS_ROPE);
    if (tn < 6 || tn == 28) {
        const int r = tid & 127, half = tid >> 7;
        const int row = m0 + r, key = key0 + r;
        const int ngrp = (tn == 28) ? 1 : 4;
        for (int gi = half; gi < ngrp; gi += 2) {
            float v[32];
#pragma unroll
            for (int q = 0; q < 8; ++q) { const f32x4 t = *(const f32x4*)(cs + r * 132 + gi * 32 + q * 4); v[q * 4] = t[0]; v[q * 4 + 1] = t[1]; v[q * 4 + 2] = t[2]; v[q * 4 + 3] = t[3]; }
            if (lat) rope32(v, row & 8191, rope);
            if (tn < 3) {
                bf16_t* dst = (bf16_t*)(p.ws + WS_QDA) + ((size_t)(b * 12 + tn * 4 + gi) * NKEY + key) * 32;
                store32_bf16(dst, v, 0.17677669529663687f * LOG2E);
            } else if (tn < 6) {
                const int hc = (tn - 3) * 4 + gi;
                bf16_t* dst = (bf16_t*)(p.ws + WS_KDA) + ((size_t)(b * 12 + hc) * NKEY + key) * 32;
                store32_bf16(dst, v, 1.0f);
                float n2 = 0.f;
#pragma unroll
                for (int q = 0; q < 32; ++q) n2 += v[q] * v[q];
                n2 = wave_max(n2);
                if ((tid & 63) == 0) atomicMax((unsigned*)(p.ws + WS_KMAX) + (l * 4 + b) * 32 + hc, __float_as_uint(n2));
            } else {
                bf16_t* dst = (bf16_t*)(p.ws + WS_KR) + (size_t)row * 32;
                store32_bf16(dst, v, 1.0f);
            }
        }
    } else if (tn < 9) {
        const int h0 = (tn - 6) * 2;
        bf16_t* dst = (bf16_t*)(p.ws + WS_VDAT) + ((size_t)(b * 6 + h0) * 64) * NKEY + key0;
        epi_store_T(cs, 0, 128, dst, nullptr);
    } else if (tn < 12) {
        if (tn < 11) epi_copy_bf16(cs, (bf16_t*)(p.ws + WS_CQ), 256, m0, (tn - 9) * 128, 1.0f);
        else epi_copy_bf16(cs, (bf16_t*)(p.ws + WS_CKV), 128, m0, 0, 1.0f);
        if (tid < 128) {
            float ssq = 0.f;
#pragma unroll 8
            for (int q = 0; q < 32; ++q) { const f32x4 t = *(const f32x4*)(cs + tid * 132 + q * 4); ssq += t[0] * t[0] + t[1] * t[1] + t[2] * t[2] + t[3] * t[3]; }
            ((float*)(p.ws + WS_SSQ))[(size_t)(m0 + tid) * 4 + (tn - 9)] = ssq;
        }
    } else {
        epi_copy_bf16(cs, (bf16_t*)(p.ws + WS_HG), 2048, m0, (tn - 12) * 128, 1.0f);
    }
}

__device__ __forceinline__ void row_rstd(const Params& p, int which  , int m0, float* rs) {
    const int tid = opaque_tid();
    if (tid < 128) {
        const float* q = (const float*)(p.ws + WS_SSQ) + (size_t)(m0 + tid) * 4;
        rs[tid] = which == 0 ? rsqrtf((q[0] + q[1]) * (1.0f / 256.0f) + EPS) : rsqrtf(q[2] * (1.0f / 128.0f) + EPS);
    }
}
__device__ void epi_uq(const Params& p, int m0, int h, const float* cs, const float* rs) {
    const int tid = opaque_tid(), r = tid & 127, half = tid >> 7;
    int b, key0; bool lat; row_bk(m0, b, key0, lat);
    const int row = m0 + r, key = key0 + r;
    const float sc = rs[r] * 0.10206207261596575f * LOG2E;
    bf16_t* dst = (bf16_t*)(p.ws + WS_QMLA) + ((size_t)(b * 6 + h) * NKEY + key) * 96;
    if (half == 0) {
        float v[32];
#pragma unroll
        for (int q = 0; q < 8; ++q) { const f32x4 t = *(const f32x4*)(cs + r * 132 + q * 4); v[q * 4] = t[0]; v[q * 4 + 1] = t[1]; v[q * 4 + 2] = t[2]; v[q * 4 + 3] = t[3]; }
        store32_bf16(dst, v, sc);
#pragma unroll
        for (int q = 0; q < 4; ++q) { const f32x4 t = *(const f32x4*)(cs + r * 132 + 32 + q * 4); v[q * 4] = t[0]; v[q * 4 + 1] = t[1]; v[q * 4 + 2] = t[2]; v[q * 4 + 3] = t[3]; }
#pragma unroll
        for (int q = 0; q < 2; ++q) {
            uint4 w; w.x = pack2(v[q * 8 + 0] * sc, v[q * 8 + 1] * sc); w.y = pack2(v[q * 8 + 2] * sc, v[q * 8 + 3] * sc);
            w.z = pack2(v[q * 8 + 4] * sc, v[q * 8 + 5] * sc); w.w = pack2(v[q * 8 + 6] * sc, v[q * 8 + 7] * sc);
            *(uint4*)(dst + 32 + q * 8) = w;
        }
    } else {
        float v[32];
#pragma unroll
        for (int q = 0; q < 4; ++q) { const f32x4 t = *(const f32x4*)(cs + r * 132 + 48 + q * 4); v[q * 4] = t[0]; v[q * 4 + 1] = t[1]; v[q * 4 + 2] = t[2]; v[q * 4 + 3] = t[3]; }
#pragma unroll
        for (int q = 0; q < 2; ++q) {
            uint4 w; w.x = pack2(v[q * 8 + 0] * sc, v[q * 8 + 1] * sc); w.y = pack2(v[q * 8 + 2] * sc, v[q * 8 + 3] * sc);
            w.z = pack2(v[q * 8 + 4] * sc, v[q * 8 + 5] * sc); w.w = pack2(v[q * 8 + 6] * sc, v[q * 8 + 7] * sc);
            *(uint4*)(dst + 48 + q * 8) = w;
        }
#pragma unroll
        for (int q = 0; q < 8; ++q) { const f32x4 t = *(const f32x4*)(cs + r * 132 + 64 + q * 4); v[q * 4] = t[0]; v[q * 4 + 1] = t[1]; v[q * 4 + 2] = t[2]; v[q * 4 + 3] = t[3]; }
        if (lat) rope32(v, row & 8191, (const float*)(p.ws + WS_ROPE));
        store32_bf16(dst + 64, v, sc);
    }
}
__device__ void epi_ukv(const Params& p, int l, int m0, int h, const float* cs, const float* rs) {
    const int tid = opaque_tid();
    int b, key0; bool lat; row_bk(m0, b, key0, lat);
    bf16_t* vdst = (bf16_t*)(p.ws + WS_VMLAT) + ((size_t)(b * 6 + h) * 64) * NKEY + key0;
    epi_store_T(cs, 64, 64, vdst, rs);
    if (tid < 128) {
        const int r = tid, row = m0 + r, key = key0 + r;
        const float sc = rs[r];
        bf16_t* dst = (bf16_t*)(p.ws + WS_KMLA) + ((size_t)(b * 6 + h) * NKEY + key) * 96;
        float n2 = 0.f;
        float v[32];
#pragma unroll
        for (int part = 0; part < 2; ++part) {
#pragma unroll
            for (int q = 0; q < 8; ++q) { const f32x4 t = *(const f32x4*)(cs + r * 132 + part * 32 + q * 4); v[q * 4] = t[0] * sc; v[q * 4 + 1] = t[1] * sc; v[q * 4 + 2] = t[2] * sc; v[q * 4 + 3] = t[3] * sc; }
#pragma unroll
            for (int q = 0; q < 32; ++q) n2 += v[q] * v[q];
            store32_bf16(dst + part * 32, v, 1.0f);
        }
        const bf16_t* kr = (const bf16_t*)(p.ws + WS_KR) + (size_t)row * 32;
#pragma unroll
        for (int q = 0; q < 4; ++q) {
            const uint4 w = *(const uint4*)(kr + q * 8);
            *(uint4*)(dst + 64 + q * 8) = w;
            const unsigned ww[4] = {w.x, w.y, w.z, w.w};
#pragma unroll
            for (int j = 0; j < 4; ++j) { const float f0 = __uint_as_float(ww[j] << 16), f1 = __uint_as_float(ww[j] & 0xffff0000u); n2 += f0 * f0 + f1 * f1; }
        }
        n2 = wave_max(n2);
        if ((tid & 63) == 0) atomicMax((unsigned*)(p.ws + WS_KMAX) + (l * 4 + b) * 32 + 12 + h, __float_as_uint(n2));
    }
}
__device__ __forceinline__ void epi_resid(const Params& p, int l, int m0, int n0, int goff, const float* cs) {
    const int tid = opaque_tid(), c4 = (tid & 31) * 4, r0 = tid >> 5;
    int b, key0; bool lat; row_bk(m0, b, key0, lat);
    const float* gate = (const float*)(p.ws + WS_MOD) + (size_t)(l * 5 + (lat ? b : 4)) * 6144 + goff + n0 + c4;
    const f32x4 g = *(const f32x4*)gate;
#pragma unroll 4
    for (int i = 0; i < 16; ++i) {
        const int r = r0 + 8 * i;
        const f32x4 v = *(const f32x4*)(cs + r * 132 + c4);
        float* xp = xrow(p, m0 + r) + n0 + c4;
        const float* xs = (l == 0 && goff == 2 * 1024) ? xrow_in(p, m0 + r) + n0 + c4 : xp;
        f32x4 x = *(const f32x4*)xs;
        x += g * v;
        *(f32x4*)xp = x;
    }
}
__device__ __forceinline__ void epi_ff1(const Params& p, int m0, int n0, const float* cs) {
    const int tid = opaque_tid(), c4 = (tid & 31) * 4, r0 = tid >> 5;
    bf16_t* dst = (bf16_t*)(p.ws + WS_H1);
#pragma unroll 4
    for (int i = 0; i < 16; ++i) {
        const int r = r0 + 8 * i;
        f32x4 v = *(const f32x4*)(cs + r * 132 + c4);
#pragma unroll
        for (int j = 0; j < 4; ++j) { const float t = fmaxf(v[j], 0.f); v[j] = t * t; }
        uint2 w; w.x = pack2(v[0], v[1]); w.y = pack2(v[2], v[3]);
        *(uint2*)(dst + (size_t)(m0 + r) * 4096 + n0 + c4) = w;
    }
}

template <int DQK>
__device__ __forceinline__ void attn_pass(const bf16_t* __restrict__ Qb, const bf16_t* __restrict__ Kb, const bf16_t* __restrict__ VTb,
                                          int q0, int nkt, float kmax, char* smem, f32x16& O0, f32x16& O1, float& lsum) {
    constexpr int KS = DQK * 2 + 16, VS = 136, STAGE = 64 * KS + 64 * VS, NKC = DQK / 32, CPR = DQK / 8;
    const int tid = opaque_tid(), lane = tid & 63, wid = tid >> 6, l31 = lane & 31, hi = lane >> 5;
    bf16x8 qf[DQK / 16];
    const bf16_t* qp = Qb + (size_t)(q0 + wid * 32 + l31) * DQK + hi * 8;
    float qn = 0.f;
#pragma unroll
    for (int ks = 0; ks < DQK / 16; ++ks) {
        qf[ks] = *(const bf16x8*)(qp + ks * 16);
#pragma unroll
        for (int j = 0; j < 8; ++j) { const float f = bf2f((bf16_t)qf[ks][j]); qn += f * f; }
    }
    qn += __shfl_xor(qn, 32);
    const float negm = -(sqrtf(qn) * kmax);
#pragma unroll
    for (int r = 0; r < 16; ++r) { O0[r] = 0.f; O1[r] = 0.f; }
    lsum = 0.f;
    const int kr0 = tid / CPR, kc0 = tid % CPR, kr1 = (tid + 256) / CPR, kc1 = (tid + 256) % CPR, kr2 = (tid + 512) / CPR, kc2 = (tid + 512) % CPR;
    const int vr0 = tid >> 3, vc0 = tid & 7;
    const bf16_t* vg = VTb + (size_t)vr0 * NKEY + vc0 * 8;
    uint4 a0, a1, a2, a3, a4;
#define AT_LOADA(KT) { const bf16_t* kp_ = Kb + (size_t)(KT) * 64 * DQK; a0 = *(const uint4*)(kp_ + (size_t)tid * 8); \
        if constexpr (NKC > 1) { a1 = *(const uint4*)(kp_ + (size_t)(tid + 256) * 8); a2 = *(const uint4*)(kp_ + (size_t)(tid + 512) * 8); } \
        a3 = *(const uint4*)(vg + (KT) * 64); a4 = *(const uint4*)(vg + (size_t)32 * NKEY + (KT) * 64); }
#define AT_WRITE(X0, X1, X2, X3, X4, BUF) { char* sk_ = smem + (BUF) * STAGE; char* sv_ = sk_ + 64 * KS; \
        *(uint4*)(sk_ + kr0 * KS + kc0 * 16) = X0; \
        if constexpr (NKC > 1) { *(uint4*)(sk_ + kr1 * KS + kc1 * 16) = X1; *(uint4*)(sk_ + kr2 * KS + kc2 * 16) = X2; } \
        { uint2* d_ = (uint2*)(sv_ + vr0 * VS + vc0 * 16); d_[0] = make_uint2(X3.x, X3.y); d_[1] = make_uint2(X3.z, X3.w); } \
        { uint2* d_ = (uint2*)(sv_ + (vr0 + 32) * VS + vc0 * 16); d_[0] = make_uint2(X4.x, X4.y); d_[1] = make_uint2(X4.z, X4.w); } }
    f32x16 NEG;
#pragma unroll
    for (int r = 0; r < 16; ++r) NEG[r] = negm;
    auto compute = [&](int buf) {
        const char* sk = smem + buf * STAGE; const char* sv = sk + 64 * KS;
        constexpr int NKS = DQK / 16;
        bf16x8 k0[NKS], k1[NKS], v0[4], v1[4];
#pragma unroll
        for (int ks = 0; ks < NKS; ++ks) k0[ks] = *(const bf16x8*)(sk + (l31)*KS + ks * 32 + hi * 16);
#pragma unroll
        for (int ks = 0; ks < NKS; ++ks) k1[ks] = *(const bf16x8*)(sk + (32 + l31) * KS + ks * 32 + hi * 16);
#pragma unroll
        for (int u = 0; u < 2; ++u)
#pragma unroll
            for (int db = 0; db < 2; ++db) {
                const char* vp = sv + (db * 32 + l31) * VS + (16 * u + 4 * hi) * 2;
                const uint2 x0 = *(const uint2*)vp, x1 = *(const uint2*)(vp + 16);
                v0[u * 2 + db] = MK8(x0.x, x0.y, x1.x, x1.y);
            }
        __builtin_amdgcn_sched_barrier(0);
        f32x16 S0, S1;
#pragma unroll
        for (int ks = 0; ks < NKS; ++ks) S0 = __builtin_amdgcn_mfma_f32_32x32x16_bf16(k0[ks], qf[ks], ks == 0 ? NEG : S0, 0, 0, 0);
#pragma unroll
        for (int ks = 0; ks < NKS; ++ks) S1 = __builtin_amdgcn_mfma_f32_32x32x16_bf16(k1[ks], qf[ks], ks == 0 ? NEG : S1, 0, 0, 0);
        __builtin_amdgcn_sched_barrier(0);
#pragma unroll
        for (int u = 0; u < 2; ++u)
#pragma unroll
            for (int db = 0; db < 2; ++db) {
                const char* vp = sv + (db * 32 + l31) * VS + (32 + 16 * u + 4 * hi) * 2;
                const uint2 x0 = *(const uint2*)vp, x1 = *(const uint2*)(vp + 16);
                v1[u * 2 + db] = MK8(x0.x, x0.y, x1.x, x1.y);
            }
        unsigned pk0[8], pk1[8];
#pragma unroll
        for (int r = 0; r < 16; r += 2) { const float e0 = fexp2(S0[r]), e1 = fexp2(S0[r + 1]); lsum += e0 + e1; pk0[r >> 1] = cvt_pk(e0, e1); }
        __builtin_amdgcn_sched_barrier(0);
#pragma unroll
        for (int u = 0; u < 2; ++u) {
            const bf16x8 pbv = MK8(pk0[4 * u], pk0[4 * u + 1], pk0[4 * u + 2], pk0[4 * u + 3]);
            O0 = __builtin_amdgcn_mfma_f32_32x32x16_bf16(v0[u * 2 + 0], pbv, O0, 0, 0, 0);
            O1 = __builtin_amdgcn_mfma_f32_32x32x16_bf16(v0[u * 2 + 1], pbv, O1, 0, 0, 0);
        }
#pragma unroll
        for (int r = 0; r < 16; r += 2) { const float e0 = fexp2(S1[r]), e1 = fexp2(S1[r + 1]); lsum += e0 + e1; pk1[r >> 1] = cvt_pk(e0, e1); }
        __builtin_amdgcn_sched_barrier(0);
#pragma unroll
        for (int u = 0; u < 2; ++u) {
            const bf16x8 pbv = MK8(pk1[4 * u], pk1[4 * u + 1], pk1[4 * u + 2], pk1[4 * u + 3]);
            O0 = __builtin_amdgcn_mfma_f32_32x32x16_bf16(v1[u * 2 + 0], pbv, O0, 0, 0, 0);
            O1 = __builtin_amdgcn_mfma_f32_32x32x16_bf16(v1[u * 2 + 1], pbv, O1, 0, 0, 0);
        }
    };
    a1 = a2 = make_uint4(0u, 0u, 0u, 0u);
    AT_LOADA(0);
    AT_WRITE(a0, a1, a2, a3, a4, 0);
    AT_LOADA(1);
    __syncthreads();
    for (int kt = 0; kt < nkt; kt += 2) {
        compute(0);
        AT_WRITE(a0, a1, a2, a3, a4, 1);
        { const int k2 = kt + 2 < nkt ? kt + 2 : nkt - 1; AT_LOADA(k2); }
        __syncthreads();
        compute(1);
        AT_WRITE(a0, a1, a2, a3, a4, 0);
        { const int k3 = kt + 3 < nkt ? kt + 3 : nkt - 1; AT_LOADA(k3); }
        __syncthreads();
    }
#undef AT_LOADA
#undef AT_WRITE
    lsum += __shfl_xor(lsum, 32);
}

__device__ void attn_unit(const Params& p, int l, int b, int hh, int qbi, char* smem) {
    const int q0 = qbi < 64 ? 256 + qbi * 128 : (qbi - 64) * 128;
    const int nkt = qbi < 64 ? 132 : 4;
    const int tid = opaque_tid(), lane = tid & 63, wid = tid >> 6, l31 = lane & 31, hi = lane >> 5;
    const int qkey = q0 + wid * 32 + l31;
    const int row = qkey < 256 ? T_LAT + b * 256 + qkey : b * 8192 + qkey - 256;
    const float* kmx = (const float*)(p.ws + WS_KMAX) + (l * 4 + b) * 32;
    bf16_t* Y = (bf16_t*)(p.ws + WS_H);
    if (hh < 6) {
        const int h = hh;
        const bf16_t* VT = (const bf16_t*)(p.ws + WS_VDAT) + ((size_t)(b * 6 + h) * 64) * NKEY;
        f32x16 A0, A1, B0, B1; float la, lb;
        {
            const size_t off = (size_t)(b * 12 + 2 * h) * NKEY * 32;
            attn_pass<32>((const bf16_t*)(p.ws + WS_QDA) + off, (const bf16_t*)(p.ws + WS_KDA) + off, VT, q0, nkt, sqrtf(ld_coh(kmx + 2 * h)), smem, A0, A1, la);
        }
        {
            const size_t off = (size_t)(b * 12 + 2 * h + 1) * NKEY * 32;
            attn_pass<32>((const bf16_t*)(p.ws + WS_QDA) + off, (const bf16_t*)(p.ws + WS_KDA) + off, VT, q0, nkt, sqrtf(ld_coh(kmx + 2 * h + 1)), smem, B0, B1, lb);
        }
        const float lam = ((const float*)(p.ws + WS_LAM))[l];
        const float lam_init = 0.8f - 0.6f * expf(-0.3f * (float)l);
        const float ia = 1.0f / la, ib = lam / lb;
        float ss = 0.f;
#pragma unroll
        for (int r = 0; r < 16; ++r) { A0[r] = A0[r] * ia - B0[r] * ib; A1[r] = A1[r] * ia - B1[r] * ib; ss += A0[r] * A0[r] + A1[r] * A1[r]; }
        ss += __shfl_xor(ss, 32);
        const float rinv = rsqrtf(ss * (1.0f / 64.0f) + EPS) * (1.0f - lam_init);
        const float* g = p.da_subln_g + l * 64;
        bf16_t* yp = Y + (size_t)row * 1024 + h * 64;
#pragma unroll
        for (int q = 0; q < 4; ++q) {
            const int d = 8 * q + 4 * hi;
            const f32x4 g0 = *(const f32x4*)(g + d), g1 = *(const f32x4*)(g + 32 + d);
            uint2 w0, w1;
            w0.x = pack2(A0[4 * q] * rinv * g0[0], A0[4 * q + 1] * rinv * g0[1]); w0.y = pack2(A0[4 * q + 2] * rinv * g0[2], A0[4 * q + 3] * rinv * g0[3]);
            w1.x = pack2(A1[4 * q] * rinv * g1[0], A1[4 * q + 1] * rinv * g1[1]); w1.y = pack2(A1[4 * q + 2] * rinv * g1[2], A1[4 * q + 3] * rinv * g1[3]);
            *(uint2*)(yp + d) = w0; *(uint2*)(yp + 32 + d) = w1;
        }
    } else {
        const int h = hh - 6;
        const bf16_t* VT = (const bf16_t*)(p.ws + WS_VMLAT) + ((size_t)(b * 6 + h) * 64) * NKEY;
        const size_t off = (size_t)(b * 6 + h) * NKEY * 96;
        f32x16 A0, A1; float la;
        attn_pass<96>((const bf16_t*)(p.ws + WS_QMLA) + off, (const bf16_t*)(p.ws + WS_KMLA) + off, VT, q0, nkt, sqrtf(ld_coh(kmx + 12 + h)), smem, A0, A1, la);
        const float ia = 1.0f / la;
        bf16_t* yp = Y + (size_t)row * 1024 + 384 + h * 64;
#pragma unroll
        for (int q = 0; q < 4; ++q) {
            const int d = 8 * q + 4 * hi;
            uint2 w0, w1;
            w0.x = pack2(A0[4 * q] * ia, A0[4 * q + 1] * ia); w0.y = pack2(A0[4 * q + 2] * ia, A0[4 * q + 3] * ia);
            w1.x = pack2(A1[4 * q] * ia, A1[4 * q + 1] * ia); w1.y = pack2(A1[4 * q + 2] * ia, A1[4 * q + 3] * ia);
            *(uint2*)(yp + d) = w0; *(uint2*)(yp + 32 + d) = w1;
        }
    }
}

constexpr int HG_QT = 0, HG_KT = 4352, HG_KH = 8704, HG_VT = 13824, HG_DD = 16384, HG_OSEG = 17408;
template <int MODE>
__device__ void hgrn_pass(const Params& p, int l, int dir, int b, int h, int g, char* smem) {
    const int tid = opaque_tid(), lane = tid & 63, wid = tid >> 6, c = lane & 15, gq = lane >> 4;
    int r0, sgn;
    if (dir == 0) { r0 = g == 0 ? T_LAT + b * 256 : b * 8192 + (g - 1) * 256; sgn = 1; }
    else { r0 = g == 0 ? T_LAT + b * 256 + 255 : b * 8192 + 8191 - (g - 1) * 256; sgn = -1; }
    const bf16_t* HG = (const bf16_t*)(p.ws + WS_HG);
    const int k = tid >> 1, hf = tid & 1;
    const float lbv = ((const float*)(p.ws + WS_LB))[(dir * 4 + l) * 512 + h * 128 + k];
    const float omlb = 1.0f - lbv;
    const int zoff = 512 + dir * 512 + h * 128 + k, qoff = h * 128 + k;
    bf16_t* QT = (bf16_t*)(smem + HG_QT); bf16_t* KT = (bf16_t*)(smem + HG_KT); bf16_t* KH = (bf16_t*)(smem + HG_KH); bf16_t* VT = (bf16_t*)(smem + HG_VT);
    float* DD = (float*)(smem + HG_DD); bf16_t* OSEG = (bf16_t*)(smem + HG_OSEG);
    const int chain = (dir * 4 + b) * 4 + h;
    float* sst = (float*)(p.ws + WS_SST) + (size_t)(chain * 33 + g) * 8192;
    f32x4 S[8];
#pragma unroll
    for (int kb = 0; kb < 8; ++kb)
#pragma unroll
        for (int r = 0; r < 4; ++r) S[kb][r] = (MODE == 0) ? 0.f : sst[(16 * kb + 4 * gq + r) * 64 + 16 * wid + c];
    float btot = 0.f;
    bf16_t zr0, zr1, zr2, zr3, zr4, zr5, zr6, zr7, qr0 = 0, qr1 = 0, qr2 = 0, qr3 = 0, qr4 = 0, qr5 = 0, qr6 = 0, qr7 = 0; uint2 vv;
    const int vt_t = tid >> 4, vt_v4 = (tid & 15) * 4;
#define HG_ROW(SC, T) ((size_t)(r0 + sgn * ((SC) * 16 + (T))) * 2048)
#define HG_PREFETCH(SC) { const bf16_t* zb_ = HG + zoff; \
        zr0 = zb_[HG_ROW(SC, hf * 8 + 0)]; zr1 = zb_[HG_ROW(SC, hf * 8 + 1)]; zr2 = zb_[HG_ROW(SC, hf * 8 + 2)]; zr3 = zb_[HG_ROW(SC, hf * 8 + 3)]; \
        zr4 = zb_[HG_ROW(SC, hf * 8 + 4)]; zr5 = zb_[HG_ROW(SC, hf * 8 + 5)]; zr6 = zb_[HG_ROW(SC, hf * 8 + 6)]; zr7 = zb_[HG_ROW(SC, hf * 8 + 7)]; \
        if (MODE != 0) { const bf16_t* qb_ = HG + qoff; \
        qr0 = qb_[HG_ROW(SC, hf * 8 + 0)]; qr1 = qb_[HG_ROW(SC, hf * 8 + 1)]; qr2 = qb_[HG_ROW(SC, hf * 8 + 2)]; qr3 = qb_[HG_ROW(SC, hf * 8 + 3)]; \
        qr4 = qb_[HG_ROW(SC, hf * 8 + 4)]; qr5 = qb_[HG_ROW(SC, hf * 8 + 5)]; qr6 = qb_[HG_ROW(SC, hf * 8 + 6)]; qr7 = qb_[HG_ROW(SC, hf * 8 + 7)]; } \
        vv = *(const uint2*)(HG + HG_ROW(SC, vt_t) + 1536 + h * 64 + vt_v4); }
    HG_PREFETCH(0);
    for (int sc = 0; sc < 16; ++sc) {
        float bt[8], ky[8], qv[8];
        {
            const bf16_t zz[8] = {zr0, zr1, zr2, zr3, zr4, zr5, zr6, zr7};
            const bf16_t qq[8] = {qr0, qr1, qr2, qr3, qr4, qr5, qr6, qr7};
            float cum = 0.f;
#pragma unroll
            for (int i = 0; i < 8; ++i) {
                const float z = bf2f(zz[i]);
                const float e = fexp(-z);
                const float sg = __builtin_amdgcn_rcpf(1.0f + e);
                const float f = lbv + omlb * sg;
                cum += __builtin_amdgcn_logf(fmaxf(f, 1e-30f)) * 0.6931471805599453f;
                bt[i] = cum; ky[i] = omlb * (1.0f - sg); qv[i] = bf2f(qq[i]);
            }
            const float other = __shfl_xor(cum, 1);
            const float blast = cum + other;
            const float add = hf ? other : 0.f;
#pragma unroll
            for (int i = 0; i < 8; ++i) {
                const int t = hf * 8 + i;
                const float b_ = bt[i] + add;
                if (MODE != 0) {
                    QT[t * 136 + k] = f2bf(qv[i] * fexp(b_));
                    KT[t * 136 + k] = f2bf(ky[i] * fexp(fminf(-b_, 80.f)));
                }
                KH[k * 20 + t] = f2bf(ky[i] * fexp(blast - b_));
            }
            if (hf == 0) DD[k] = fexp(blast);
            btot += blast;
            VT[(vt_v4 + 0) * 20 + vt_t] = (bf16_t)(vv.x & 0xffff); VT[(vt_v4 + 1) * 20 + vt_t] = (bf16_t)(vv.x >> 16);
            VT[(vt_v4 + 2) * 20 + vt_t] = (bf16_t)(vv.y & 0xffff); VT[(vt_v4 + 3) * 20 + vt_t] = (bf16_t)(vv.y >> 16);
        }
        __syncthreads();
        { const int scn = sc < 15 ? sc + 1 : 15; HG_PREFETCH(scn); }
        const uint2 vtu = *(const uint2*)(VT + (16 * wid + c) * 20 + 4 * gq);
        const bf16x8 vtf = MK8(vtu.x, vtu.y, 0u, 0u);
        if (MODE != 0) {
            f32x4 AT = {0.f, 0.f, 0.f, 0.f};
#pragma unroll
            for (int ks = 0; ks < 4; ++ks) {
                const bf16x8 a = *(const bf16x8*)(KT + c * 136 + ks * 32 + gq * 8);
                const bf16x8 bq = *(const bf16x8*)(QT + c * 136 + ks * 32 + gq * 8);
                AT = __builtin_amdgcn_mfma_f32_16x16x32_bf16(a, bq, AT, 0, 0, 0);
            }
#pragma unroll
            for (int r = 0; r < 4; ++r) if (4 * gq + r > c) AT[r] = 0.f;
            const bf16x8 pfv = MK8(pack2(AT[0], AT[1]), pack2(AT[2], AT[3]), 0u, 0u);
            f32x4 oT = {0.f, 0.f, 0.f, 0.f};
            oT = __builtin_amdgcn_mfma_f32_16x16x32_bf16(vtf, pfv, oT, 0, 0, 0);
#pragma unroll
            for (int u = 0; u < 4; ++u) {
                const bf16x8 sfv = MK8(pack2(S[2 * u][0], S[2 * u][1]), pack2(S[2 * u][2], S[2 * u][3]), pack2(S[2 * u + 1][0], S[2 * u + 1][1]), pack2(S[2 * u + 1][2], S[2 * u + 1][3]));
                const uint2 q0 = *(const uint2*)(QT + c * 136 + 32 * u + 4 * gq), q1 = *(const uint2*)(QT + c * 136 + 32 * u + 16 + 4 * gq);
                const bf16x8 qpv = MK8(q0.x, q0.y, q1.x, q1.y);
                oT = __builtin_amdgcn_mfma_f32_16x16x32_bf16(sfv, qpv, oT, 0, 0, 0);
            }
            const int pos = sc * 16 + c;
            const int ti = (MODE == 1) ? pos : 255 - pos;
            bf16_t* op = OSEG + ti * 68 + 16 * wid + 4 * gq;
            if (MODE == 2) {
                const uint2 old = *(const uint2*)op;
                oT[0] += __uint_as_float(old.x << 16); oT[1] += __uint_as_float(old.x & 0xffff0000u);
                oT[2] += __uint_as_float(old.y << 16); oT[3] += __uint_as_float(old.y & 0xffff0000u);
            }
            uint2 w; w.x = pack2(oT[0], oT[1]); w.y = pack2(oT[2], oT[3]);
            *(uint2*)op = w;
        }
#pragma unroll
        for (int kb = 0; kb < 8; ++kb) {
            const uint2 khu = *(const uint2*)(KH + (16 * kb + c) * 20 + 4 * gq);
            const bf16x8 kh = MK8(khu.x, khu.y, 0u, 0u);
            const f32x4 d4 = *(const f32x4*)(DD + 16 * kb + 4 * gq);
            S[kb] = __builtin_amdgcn_mfma_f32_16x16x32_bf16(kh, vtf, S[kb] * d4, 0, 0, 0);
        }
        __syncthreads();
    }
    if (MODE == 0) {
#pragma unroll
        for (int kb = 0; kb < 8; ++kb)
#pragma unroll
            for (int r = 0; r < 4; ++r) sst[(16 * kb + 4 * gq + r) * 64 + 16 * wid + c] = S[kb][r];
        if (hf == 0) ((float*)(p.ws + WS_DSEG))[(size_t)(chain * 33 + g) * 128 + k] = fexp(btot);
    }
#undef HG_ROW
#undef HG_PREFETCH
}

struct H1Pre { bf16_t z0, z1, z2, z3, z4, z5, z6, z7; uint2 vv; };
struct H1Ctx { int r0, sgn, zoff, hv, chain, g; float lbv, omlb, btot; f32x4 S[8]; };
__device__ void hgrn_h1_pair(const Params& p, int l, int b, int h, int g, char* smem) {
    const int tid = opaque_tid(), lane = tid & 63, wid = tid >> 6, c = lane & 15, gq = lane >> 4;
    const int k = tid >> 1, hf = tid & 1, vt_t = tid >> 4, vt_v4 = (tid & 15) * 4;
    const bf16_t* HG = (const bf16_t*)(p.ws + WS_HG);
    auto init = [&](H1Ctx& X, int dir) {
        if (dir == 0) { X.r0 = g == 0 ? T_LAT + b * 256 : b * 8192 + (g - 1) * 256; X.sgn = 1; }
        else { X.r0 = g == 0 ? T_LAT + b * 256 + 255 : b * 8192 + 8191 - (g - 1) * 256; X.sgn = -1; }
        X.lbv = ((const float*)(p.ws + WS_LB))[(dir * 4 + l) * 512 + h * 128 + k]; X.omlb = 1.0f - X.lbv;
        X.zoff = 512 + dir * 512 + h * 128 + k; X.hv = 1536 + h * 64 + vt_v4; X.chain = (dir * 4 + b) * 4 + h; X.g = g; X.btot = 0.f;
#pragma unroll
        for (int kb = 0; kb < 8; ++kb) X.S[kb] = (f32x4){0.f, 0.f, 0.f, 0.f};
    };
    auto prefetch = [&](const H1Ctx& X, H1Pre& R, int sc) {
        const bf16_t* zb = HG + X.zoff;
#define H1_ROW(T) ((size_t)(X.r0 + X.sgn * (sc * 16 + (T))) * 2048)
        R.z0 = zb[H1_ROW(hf * 8 + 0)]; R.z1 = zb[H1_ROW(hf * 8 + 1)]; R.z2 = zb[H1_ROW(hf * 8 + 2)]; R.z3 = zb[H1_ROW(hf * 8 + 3)];
        R.z4 = zb[H1_ROW(hf * 8 + 4)]; R.z5 = zb[H1_ROW(hf * 8 + 5)]; R.z6 = zb[H1_ROW(hf * 8 + 6)]; R.z7 = zb[H1_ROW(hf * 8 + 7)];
        R.vv = *(const uint2*)(HG + H1_ROW(vt_t) + X.hv);
#undef H1_ROW
    };
    auto elem = [&](H1Ctx& X, const H1Pre& R, char* sm) {
        bf16_t* KH = (bf16_t*)(sm + HG_KH); bf16_t* VT = (bf16_t*)(sm + HG_VT); float* DD = (float*)(sm + HG_DD);
        const bf16_t zz[8] = {R.z0, R.z1, R.z2, R.z3, R.z4, R.z5, R.z6, R.z7};
        float bt[8], ky[8]; float cum = 0.f;
#pragma unroll
        for (int i = 0; i < 8; ++i) {
            const float e = fexp(-bf2f(zz[i]));
            const float sg = __builtin_amdgcn_rcpf(1.0f + e);
            cum += __builtin_amdgcn_logf(fmaxf(X.lbv + X.omlb * sg, 1e-30f)) * 0.6931471805599453f;
            bt[i] = cum; ky[i] = X.omlb * (1.0f - sg);
        }
        const float other = __shfl_xor(cum, 1);
        const float blast = cum + other, add = hf ? other : 0.f;
#pragma unroll
        for (int i = 0; i < 8; ++i) KH[k * 20 + hf * 8 + i] = f2bf(ky[i] * fexp(blast - (bt[i] + add)));
        if (hf == 0) DD[k] = fexp(blast);
        X.btot += blast;
        VT[(vt_v4 + 0) * 20 + vt_t] = (bf16_t)(R.vv.x & 0xffff); VT[(vt_v4 + 1) * 20 + vt_t] = (bf16_t)(R.vv.x >> 16);
        VT[(vt_v4 + 2) * 20 + vt_t] = (bf16_t)(R.vv.y & 0xffff); VT[(vt_v4 + 3) * 20 + vt_t] = (bf16_t)(R.vv.y >> 16);
    };
    auto update = [&](H1Ctx& X, const char* sm) {
        const bf16_t* KH = (const bf16_t*)(sm + HG_KH); const bf16_t* VT = (const bf16_t*)(sm + HG_VT); const float* DD = (const float*)(sm + HG_DD);
        const uint2 vtu = *(const uint2*)(VT + (16 * wid + c) * 20 + 4 * gq);
        const bf16x8 vtf = MK8(vtu.x, vtu.y, 0u, 0u);
#pragma unroll
        for (int kb = 0; kb < 8; ++kb) {
            const uint2 khu = *(const uint2*)(KH + (16 * kb + c) * 20 + 4 * gq);
            const f32x4 d4 = *(const f32x4*)(DD + 16 * kb + 4 * gq);
            X.S[kb] = __builtin_amdgcn_mfma_f32_16x16x32_bf16(MK8(khu.x, khu.y, 0u, 0u), vtf, X.S[kb] * d4, 0, 0, 0);
        }
    };
    auto store = [&](H1Ctx& X) {
        float* sst = (float*)(p.ws + WS_SST) + (size_t)(X.chain * 33 + X.g) * 8192;
#pragma unroll
        for (int kb = 0; kb < 8; ++kb)
#pragma unroll
            for (int r = 0; r < 4; ++r) sst[(16 * kb + 4 * gq + r) * 64 + 16 * wid + c] = X.S[kb][r];
        if (hf == 0) ((float*)(p.ws + WS_DSEG))[(size_t)(X.chain * 33 + X.g) * 128 + k] = fexp(X.btot);
    };
    H1Ctx A, B; H1Pre A0, A1, B0, B1;
    init(A, 0); init(B, 1);
    prefetch(A, A0, 0); prefetch(B, B0, 0); prefetch(A, A1, 1); prefetch(B, B1, 1);
    for (int sc = 0; sc < 16; sc += 2) {
        elem(A, A0, smem); elem(B, B0, smem + 17408);
        __syncthreads();
        { const int scn = sc + 2 < 16 ? sc + 2 : 15; prefetch(A, A0, scn); prefetch(B, B0, scn); }
        update(A, smem); update(B, smem + 17408);
        __syncthreads();
        elem(A, A1, smem); elem(B, B1, smem + 17408);
        __syncthreads();
        { const int scn = sc + 3 < 16 ? sc + 3 : 15; prefetch(A, A1, scn); prefetch(B, B1, scn); }
        update(A, smem); update(B, smem + 17408);
        __syncthreads();
    }
    store(A); store(B);
}
__device__ void hgrn3_unit(const Params& p, int l, int u, char* smem) {
    const int tb = u % 33, bh = u / 33, h = bh & 3, b = bh >> 2;
    hgrn_pass<1>(p, l, 0, b, h, tb, smem);
    hgrn_pass<2>(p, l, 1, b, h, tb == 0 ? 0 : 33 - tb, smem);
    const int ti = opaque_tid();
    const int row = tb == 0 ? T_LAT + b * 256 + ti : b * 8192 + (tb - 1) * 256 + ti;
    const bf16_t* OSEG = (const bf16_t*)(smem + HG_OSEG) + ti * 68;
    const bf16_t* gp = (const bf16_t*)(p.ws + WS_HG) + (size_t)row * 2048 + 1792 + h * 64;
    const float* gn = p.hg_norm_g + l * 64;
    bf16_t* yp = (bf16_t*)(p.ws + WS_H) + (size_t)row * 1024 + 768 + h * 64;
    float ss = 0.f;
#pragma unroll
    for (int q = 0; q < 16; ++q) {
        const uint2 w = *(const uint2*)(OSEG + q * 4);
        const float a0 = __uint_as_float(w.x << 16), a1 = __uint_as_float(w.x & 0xffff0000u), a2 = __uint_as_float(w.y << 16), a3 = __uint_as_float(w.y & 0xffff0000u);
        ss += a0 * a0 + a1 * a1 + a2 * a2 + a3 * a3;
    }
    const float rinv = rsqrtf(ss * (1.0f / 64.0f) + EPS);
#pragma unroll
    for (int q = 0; q < 16; ++q) {
        const uint2 w = *(const uint2*)(OSEG + q * 4);
        const uint2 gw = *(const uint2*)(gp + q * 4);
        float o[4] = {__uint_as_float(w.x << 16), __uint_as_float(w.x & 0xffff0000u), __uint_as_float(w.y << 16), __uint_as_float(w.y & 0xffff0000u)};
        const float gt[4] = {__uint_as_float(gw.x << 16), __uint_as_float(gw.x & 0xffff0000u), __uint_as_float(gw.y << 16), __uint_as_float(gw.y & 0xffff0000u)};
#pragma unroll
        for (int j = 0; j < 4; ++j) { const float sl = gt[j] / (1.0f + fexp(-gt[j])); o[j] = o[j] * rinv * gn[q * 4 + j] * sl; }
        uint2 ow; ow.x = pack2(o[0], o[1]); ow.y = pack2(o[2], o[3]);
        *(uint2*)(yp + q * 4) = ow;
    }
    __syncthreads();
}

__device__ void convert_T(const float* in, int K, int Nin, bf16_t* out, int Nout, int mode, const float* gs, size_t gtid, size_t gthreads) {
    const size_t total = (size_t)Nout * (K / 8);
    for (size_t idx = gtid; idx < total; idx += gthreads) {
        const int n = (int)(idx % Nout), k8 = (int)(idx / Nout);
        int src = n;
        if (mode == 1) {
            if (n < 1536) src = n; else if (n < 3584) src = n + 32; else if (n < 3616) src = n - 3584 + 1536; else src = -1;
        } else if (mode == 2) {
            const int hh = n >> 7, d = n & 127; src = d < 96 ? hh * 96 + d : -1;
        }
        float v[8];
#pragma unroll
        for (int j = 0; j < 8; ++j) {
            const int k = k8 * 8 + j;
            v[j] = src >= 0 ? in[(size_t)k * Nin + src] * (gs ? gs[k] : 1.0f) : 0.f;
        }
        uint4 w; w.x = pack2(v[0], v[1]); w.y = pack2(v[2], v[3]); w.z = pack2(v[4], v[5]); w.w = pack2(v[6], v[7]);
        *(uint4*)(out + (size_t)n * K + k8 * 8) = w;
    }
}
__device__ void convert_layer(const Params& p, int l, size_t gtid, size_t gthreads) {
    convert_T(p.w_in + (size_t)l * 1024 * 3616, 1024, 3616, (bf16_t*)(p.ws + WS_WIN), NIN, 1, nullptr, gtid, gthreads);
    convert_T(p.w_out + (size_t)l * 1024 * 1024, 1024, 1024, (bf16_t*)(p.ws + WS_WOUT), 1024, 0, nullptr, gtid, gthreads);
    convert_T(p.w_ff1 + (size_t)l * 1024 * 4096, 1024, 4096, (bf16_t*)(p.ws + WS_WFF1), 4096, 0, nullptr, gtid, gthreads);
    convert_T(p.w_ff2 + (size_t)l * 4096 * 1024, 4096, 1024, (bf16_t*)(p.ws + WS_WFF2), 1024, 0, nullptr, gtid, gthreads);
    convert_T(p.w_uq + (size_t)l * 256 * 576, 256, 576, (bf16_t*)(p.ws + WS_WUQ), 768, 2, p.g_cq + l * 256, gtid, gthreads);
    convert_T(p.w_ukv + (size_t)l * 128 * 768, 128, 768, (bf16_t*)(p.ws + WS_WUKV), 768, 0, p.g_ckv + l * 128, gtid, gthreads);
}
__device__ void adaln_phase(const Params& p, int l, const float* g, int shift_off, int scale_off, int nrows) {
    const int lane = opaque_tid() & 63;
    const int gw = blockIdx.x * 4 + (threadIdx.x >> 6), nw = gridDim.x * 4;
    bf16_t* H = (bf16_t*)(p.ws + WS_H);
    for (int row = gw; row < nrows; row += nw) {
        const float* xp = (l == 0 && shift_off == 0) ? xrow_in(p, row) : xrow(p, row);
        int b, key; bool lat; row_bk(row, b, key, lat);
        const float* md = (const float*)(p.ws + WS_MOD) + (size_t)(l * 5 + (lat ? b : 4)) * 6144;
        f32x4 v[4]; float ss = 0.f;
#pragma unroll
        for (int i = 0; i < 4; ++i) { v[i] = *(const f32x4*)(xp + i * 256 + lane * 4); ss += v[i][0] * v[i][0] + v[i][1] * v[i][1] + v[i][2] * v[i][2] + v[i][3] * v[i][3]; }
#pragma unroll
        for (int o = 32; o >= 1; o >>= 1) ss += __shfl_xor(ss, o);
        const float rinv = rsqrtf(ss * (1.0f / 1024.0f) + EPS);
#pragma unroll
        for (int i = 0; i < 4; ++i) {
            const int d = i * 256 + lane * 4;
            const f32x4 gg = *(const f32x4*)(g + d), sh = *(const f32x4*)(md + shift_off + d), sc = *(const f32x4*)(md + scale_off + d);
            float o[4];
#pragma unroll
            for (int j = 0; j < 4; ++j) o[j] = v[i][j] * rinv * gg[j] * (1.0f + sc[j]) + sh[j];
            uint2 w; w.x = pack2(o[0], o[1]); w.y = pack2(o[2], o[3]);
            *(uint2*)(H + (size_t)row * 1024 + d) = w;
        }
    }
}
__device__ void phase0(const Params& p, char* smem) {
    const size_t gtid = (size_t)blockIdx.x * 256 + threadIdx.x, gthreads = (size_t)gridDim.x * 256;
    const int tid = opaque_tid();
    if (gtid < 2 * 512) {
        const int dir = (int)gtid >> 9, cidx = (int)gtid & 511;
        float e[4], mx = -1e30f, s = 0.f;
#pragma unroll
        for (int l = 0; l < 4; ++l) { e[l] = p.hg_lb[(dir * 4 + l) * 512 + cidx]; mx = fmaxf(mx, e[l]); }
#pragma unroll
        for (int l = 0; l < 4; ++l) { e[l] = expf(e[l] - mx); s += e[l]; }
        float cum = 0.f;
#pragma unroll
        for (int l = 0; l < 4; ++l) { if (l > 0) cum += e[l] / s; ((float*)(p.ws + WS_LB))[(dir * 4 + l) * 512 + cidx] = cum; }
    }
    if (gtid >= 1024 && gtid < 1024 + 1024) {
        const int i = (int)gtid - 1024, pos = i >> 3, f = i & 7;
        const float inv = powf(10000.0f, -(float)f / 8.0f);
        const float ang = (float)pos * inv;
        ((float*)(p.ws + WS_ROPE))[i * 2] = cosf(ang); ((float*)(p.ws + WS_ROPE))[i * 2 + 1] = sinf(ang);
    }
    if (gtid >= 2048 && gtid < 2048 + 4) {
        const int l = (int)gtid - 2048;
        float s1 = 0.f, s2 = 0.f;
        for (int i = 0; i < 32; ++i) { s1 += p.da_lambda[(l * 4 + 0) * 32 + i] * p.da_lambda[(l * 4 + 1) * 32 + i]; s2 += p.da_lambda[(l * 4 + 2) * 32 + i] * p.da_lambda[(l * 4 + 3) * 32 + i]; }
        ((float*)(p.ws + WS_LAM))[l] = expf(s1) - expf(s2) + (0.8f - 0.6f * expf(-0.3f * (float)l));
    }
    if (gtid >= 4096 && gtid < 4096 + 512) ((unsigned*)(p.ws + WS_KMAX))[gtid - 4096] = 0u;
    float* sl = (float*)smem;
    float* red = sl + 5 * 1024;
    for (int i = tid; i < 5 * 1024; i += 256) {
        const int r = i >> 10, d = i & 1023;
        const float cv = r < 4 ? p.c[r * 1024 + d] : p.c_ctx[d];
        sl[i] = cv / (1.0f + expf(-cv));
    }
    __syncthreads();
    for (int u = blockIdx.x; u < 4 * 96; u += gridDim.x) {
        const int l = u / 96, cb = u % 96, col = tid & 63, kg = tid >> 6;
        const float* w = p.w_mod + (size_t)l * 1024 * 6144 + cb * 64 + col;
        float a[5] = {0.f, 0.f, 0.f, 0.f, 0.f};
        for (int d = kg * 256; d < kg * 256 + 256; ++d) {
            const float wv = w[(size_t)d * 6144];
#pragma unroll
            for (int r = 0; r < 5; ++r) a[r] += sl[r * 1024 + d] * wv;
        }
#pragma unroll
        for (int r = 0; r < 5; ++r) red[(kg * 5 + r) * 64 + col] = a[r];
        __syncthreads();
        if (tid < 64) {
#pragma unroll
            for (int r = 0; r < 5; ++r) {
                const float s = red[(0 * 5 + r) * 64 + tid] + red[(1 * 5 + r) * 64 + tid] + red[(2 * 5 + r) * 64 + tid] + red[(3 * 5 + r) * 64 + tid];
                ((float*)(p.ws + WS_MOD))[(size_t)(l * 5 + r) * 6144 + cb * 64 + tid] = s + p.b_mod[l * 6144 + cb * 64 + tid];
            }
        }
        __syncthreads();
    }
}
__device__ void hgrn_scan(const Params& p) {
    const size_t gtid = (size_t)blockIdx.x * 256 + opaque_tid(), gthreads = (size_t)gridDim.x * 256;
    float* sstb = (float*)(p.ws + WS_SST);
    const float* dseg = (const float*)(p.ws + WS_DSEG);
    for (size_t i = gtid; i < (size_t)32 * 8192; i += gthreads) {
        const int chain = (int)(i >> 13), e = (int)(i & 8191), k = e >> 6;
        float S = 0.f;
        float* sp = sstb + (size_t)chain * 33 * 8192 + e;
        const float* dp = dseg + (size_t)chain * 33 * 128 + k;
#pragma unroll 1
        for (int g0 = 0; g0 < 33; g0 += 11) {
            float t[11], d[11];
#pragma unroll
            for (int q = 0; q < 11; ++q) { t[q] = sp[(size_t)(g0 + q) * 8192]; d[q] = dp[(g0 + q) * 128]; }
#pragma unroll
            for (int q = 0; q < 11; ++q) { sp[(size_t)(g0 + q) * 8192] = S; S = d[q] * S + t[q]; }
        }
    }
}
__device__ void final_norm(const Params& p) {
    const int lane = opaque_tid() & 63;
    const int gw = blockIdx.x * 4 + (threadIdx.x >> 6), nw = gridDim.x * 4;
    for (int row = gw; row < T_LAT; row += nw) {
        float* xp = p.out + (size_t)row * 1024;
        f32x4 v[4]; float ss = 0.f;
#pragma unroll
        for (int i = 0; i < 4; ++i) { v[i] = *(const f32x4*)(xp + i * 256 + lane * 4); ss += v[i][0] * v[i][0] + v[i][1] * v[i][1] + v[i][2] * v[i][2] + v[i][3] * v[i][3]; }
#pragma unroll
        for (int o = 32; o >= 1; o >>= 1) ss += __shfl_xor(ss, o);
        const float rinv = rsqrtf(ss * (1.0f / 1024.0f) + EPS);
#pragma unroll
        for (int i = 0; i < 4; ++i) {
            const f32x4 gg = *(const f32x4*)(p.g_final + i * 256 + lane * 4);
            f32x4 o;
#pragma unroll
            for (int j = 0; j < 4; ++j) o[j] = v[i][j] * rinv * gg[j];
            *(f32x4*)(xp + i * 256 + lane * 4) = o;
        }
    }
}


#define XB_TMO      128
#define XB_XCNT(j)  (256  + 64 * (j))
#define XB_XSUB(j)  (1280 + 64 * (j))
#define XB_XGEN(j)  (2304 + 64 * (j))
#define XB_TOP      3328
#define XB_TOPGEN   3392
#define XCD_BAR_WORDS 3456
#define XB_SPIN_CAP (1u << 22)
__device__ __forceinline__ unsigned xb_ld(unsigned* p)              { return __hip_atomic_load(p, __ATOMIC_RELAXED, __HIP_MEMORY_SCOPE_AGENT); }
__device__ __forceinline__ unsigned xb_add(unsigned* p, unsigned v) { return __hip_atomic_fetch_add(p, v, __ATOMIC_RELAXED, __HIP_MEMORY_SCOPE_AGENT); }
__device__ __forceinline__ unsigned xb_xcc_id() { return (unsigned)__builtin_amdgcn_s_getreg((3 << 11) | 20) & 0xFu; }
#define XB_SPIN(cond, bar) do { unsigned _sp = 0; while (cond) { __builtin_amdgcn_s_sleep(1); \
    if ((++_sp & 255u) == 0u) { if (xb_ld(&(bar)[XB_TMO])) break; if (_sp > XB_SPIN_CAP) { atomicAdd(&(bar)[XB_TMO], 1u); break; } } } } while (0)
__device__ __forceinline__ void xcd_barrier_complete(unsigned* bar, unsigned x, unsigned& nloc, unsigned& nx) {
    const unsigned G = gridDim.x;
    unsigned sum, cnt, mine, sp = 0u;
    for (;;) {
        sum = 0u; cnt = 0u; mine = 0u;
#pragma unroll
        for (unsigned j = 0; j < 16; ++j) { const unsigned c = xb_ld(&bar[XB_XCNT(j)]); sum += c; cnt += (c > 0u) ? 1u : 0u; mine = (j == x) ? c : mine; }
        if (sum == G) break;
        __builtin_amdgcn_s_sleep(1);
        if ((++sp & 255u) == 0u) { if (xb_ld(&bar[XB_TMO])) break; if (sp > XB_SPIN_CAP) { atomicAdd(&bar[XB_TMO], 1u); break; } }
    }
    nloc = mine > 0u ? mine : 1u; nx = cnt > 0u ? cnt : 1u;
}
__device__ __forceinline__ void gsync(char* ws, unsigned& epoch) {
    asm volatile("s_waitcnt vmcnt(0) lgkmcnt(0)" ::: "memory");
    __syncthreads();
    ++epoch;
    if (threadIdx.x == 0) {
        extern __shared__ __attribute__((aligned(16))) char smem_[];
        volatile unsigned* st = (volatile unsigned*)(smem_ + 73728 + 768);
        unsigned* bar = (unsigned*)(ws + WS_XBAR);
        const unsigned x = xb_xcc_id();
        __builtin_amdgcn_s_waitcnt(0);
        unsigned nloc = st[0], nx = st[1];
        if (nloc == 0u) { xcd_barrier_complete(bar, x, nloc, nx); st[0] = nloc; st[1] = nx; }
        const unsigned old = xb_add(&bar[XB_XSUB(x)], 1u);
        const unsigned gen = old / nloc;
        if (old + 1u == (gen + 1u) * nloc) {
            __builtin_amdgcn_fence(__ATOMIC_RELEASE, "agent");
            asm volatile("s_waitcnt vmcnt(0)" ::: "memory");
            const unsigned og = xb_add(&bar[XB_TOP], 1u);
            const unsigned tg = og / nx;
            if (og + 1u == (tg + 1u) * nx) xb_add(&bar[XB_TOPGEN], 1u);
            else XB_SPIN(xb_ld(&bar[XB_TOPGEN]) == tg, bar);
            __builtin_amdgcn_fence(__ATOMIC_ACQUIRE, "agent");
            xb_add(&bar[XB_XGEN(x)], 1u);
            asm volatile("s_waitcnt vmcnt(0)" ::: "memory");
        } else {
            XB_SPIN(xb_ld(&bar[XB_XGEN(x)]) == gen, bar);
            __builtin_amdgcn_fence(__ATOMIC_ACQUIRE, "agent");
            asm volatile("s_waitcnt vmcnt(0)" ::: "memory");
        }
    }
    __syncthreads();
}

__device__ __forceinline__ int next_unit(char* ws, int qidx, char* smem) {
    int* sh = (int*)(smem + 73728 + 512);
    __syncthreads();
    if (threadIdx.x == 0) *sh = (int)__hip_atomic_fetch_add((unsigned*)(ws + WS_BAR + 32) + qidx, 1u, __ATOMIC_RELAXED, __HIP_MEMORY_SCOPE_AGENT);
    __syncthreads();
    return *sh;
}

__device__ __forceinline__ bool tile_of(int r, int nt, int total, int& tm, int& tn, int G = 8) {
    const int bx = blockIdx.x, nx = gridDim.x >> 3;
    const int L = (r * 8 + (bx & 7)) * nx + (bx >> 3);
    if (L >= total || nx != 64) { if (nx == 64) return false; const int u = bx + r * gridDim.x; if (u >= total) return false; tm = u / nt; tn = u % nt; return true; }
    const int mg = L / (nt * G), rem = L % (nt * G);
    tn = rem / G; tm = mg * G + (rem % G);
    return true;
}
__device__ __forceinline__ Params launder(const Params& p) {
    Params q = p;
    GAS char* w = (GAS char*)p.ws; GAS float* o = (GAS float*)p.out;
    asm volatile("" : "+s"(w), "+s"(o));
    q.ws = (char*)w; q.out = (float*)o;
    return q;
}
__global__ void __launch_bounds__(256, 2) fwd_megakernel(Params p0) {
    extern __shared__ __attribute__((aligned(16))) char smem[];
    cg::grid_group grid = cg::this_grid();
    const size_t gtid = (size_t)blockIdx.x * 256 + threadIdx.x, gthreads = (size_t)gridDim.x * 256;
    float* rs = (float*)(smem + 73728);
    unsigned epoch = 0;
    if (threadIdx.x == 0) { volatile unsigned* st = (volatile unsigned*)(smem + 73728 + 768); st[0] = 0u; st[1] = 0u; (void)xb_add((unsigned*)(p0.ws + WS_XBAR) + XB_XCNT(xb_xcc_id()), 1u); }
    __syncthreads();
    grid.sync();

#ifndef OPK
#define OPK 1024
#define OPK0 0
#endif
#ifndef REP_SKIP_ATT
#define REP_SKIP_ATT 0
#endif
#ifndef REP_B
#define REP_B 1
#endif
#ifndef REP_D
#define REP_D 1
#endif
#ifndef REP_E
#define REP_E 1
#endif
#ifndef REP_H
#define REP_H 1
#endif
#ifndef PM
#define PM 0xffff
#endif
    { const Params p = launder(p0); if (PM & 1) phase0(p, smem); }
    { const Params p = launder(p0); if (PM & 2) convert_layer(p, 0, gtid, gthreads); }
    gsync(p0.ws, epoch);

    for (int l = 0; l < 4; ++l) {
        const bool last = (l == 3);
        { const Params p = launder(p0); if (PM & 4) adaln_phase(p, l, p.g_mix + l * 1024, 0, 1024, T_ALL); }
        { const Params p = launder(p0); if ((PM & 2) && l > 0) convert_layer(p, l, gtid, gthreads); }
        gsync(p0.ws, epoch);
        if (PM & 8) for (int rr = 0;; ++rr) {
            int tm, tn; if (!tile_of(rr, 29, 132 * 29, tm, tn, 4)) break;
            const Params p = launder(p0);
            Acc2 C;
            gemm_tile_core2((const bf16_t*)(p.ws + WS_H) + (size_t)tm * 256 * 1024, 1024, (const bf16_t*)(p.ws + WS_WIN) + (size_t)tn * 128 * 1024, 1024, 1024, smem, C);
            gemm2_stage(C, 0, smem);
            epi_inproj(p, l, tm * 256, tn, (const float*)smem);
            __syncthreads();
            gemm2_stage(C, 1, smem);
            epi_inproj(p, l, tm * 256 + 128, tn, (const float*)smem);
            __syncthreads();
        }
        gsync(p0.ws, epoch);
        for (int rep = 0; rep < REP_D; ++rep) { if (rep) gsync(p0.ws, epoch);
        for (;;) {
            const int u = next_unit(p0.ws, l * 2 + 0 + rep * 8, smem);
            if (u >= 528 + 2 * 1584) break;
            const Params p = launder(p0);
            if (u < 528) { if (PM & 16) {
                const int g = u % 33, ch = u / 33, h = ch & 3, b = (ch >> 2) & 3;
                hgrn_h1_pair(p, l, b, h, g, smem); }
            } else if (!(PM & 32)) {} else if (u < 528 + 1584) {
                const int v = u - 528, tm = v / 6, h = v % 6;
                row_rstd(p, 0, tm * 128, rs);
                gemm_tile_core((const bf16_t*)(p.ws + WS_CQ) + (size_t)tm * 128 * 256, 256, (const bf16_t*)(p.ws + WS_WUQ) + (size_t)h * 128 * 256, 256, 256, smem);
                epi_uq(p, tm * 128, h, (const float*)smem, rs);
                __syncthreads();
            } else {
                const int v = u - 528 - 1584, tm = v / 6, h = v % 6;
                row_rstd(p, 1, tm * 128, rs);
                gemm_tile_core((const bf16_t*)(p.ws + WS_CKV) + (size_t)tm * 128 * 128, 128, (const bf16_t*)(p.ws + WS_WUKV) + (size_t)h * 128 * 128, 128, 128, smem);
                epi_ukv(p, l, tm * 128, h, (const float*)smem, rs);
                __syncthreads();
            }
        } }
        gsync(p0.ws, epoch);
        { const Params p = launder(p0); if (PM & 64) hgrn_scan(p); }
        gsync(p0.ws, epoch);
        {
            { int* st2 = (int*)(smem + 73728 + 520); __syncthreads(); if (threadIdx.x == 0) { st2[0] = 0; } }
            for (;;) {
                    int* sh = (int*)(smem + 73728 + 512);
                    __syncthreads();
                    if (threadIdx.x == 0) {
                        const int qlen_ = 450 + (l == 3 ? 0 : 12);
                        const unsigned xq_ = xb_xcc_id() & 7u;
                        int dq_ = sh[2], got = -1, qq = 0;
                        while (dq_ < 8) {
                            qq = (int)((xq_ + dq_) & 7u);
                            const int v = (int)__hip_atomic_fetch_add((unsigned*)(p0.ws + WS_XBAR) + l * 8 + qq, 1u, __ATOMIC_RELAXED, __HIP_MEMORY_SCOPE_AGENT);
                            if (v < qlen_) { got = v; break; }
                            ++dq_;
                        }
                        sh[2] = dq_; sh[0] = got; sh[1] = qq;
                    }
                    __syncthreads();
                    const int i = __builtin_amdgcn_readfirstlane(sh[0]), q = __builtin_amdgcn_readfirstlane(sh[1]);
                    if (i < 0) break;
                    const Params p = launder(p0);
                    const int nh3 = (i + 2) / 3 < 66 ? (i + 2) / 3 : 66;
                    if (i < 450 && i % 3 == 0 && i / 3 < 66) { if (PM & 256) hgrn3_unit(p, l, q * 66 + i / 3, smem); }
                    else {
                        int b, hh, qbi;
                        if (i < 450) { const int a = i - nh3; const int bh = q + 8 * (a >> 6); qbi = a & 63; b = (bh / 6) & 3; hh = (bh >= 24 ? 6 : 0) + bh % 6; }
                        else { const int cidx = q * 12 + (i - 450); qbi = 64 + (cidx & 1); const int bh = cidx >> 1; hh = bh % 12; b = bh / 12; }
                        if (PM & 128) attn_unit(p, l, b, hh, qbi, smem);
                    }
            }
        }
        gsync(p0.ws, epoch);
        const int ntm = last ? 256 : 264;
        if (PM & 512) for (int rr = 0;; ++rr) {
            int tm, tn; if (!tile_of(rr, 8, ntm * 8, tm, tn)) break;
            const Params p = launder(p0);
            gemm_tile_core((const bf16_t*)(p.ws + WS_H) + (size_t)tm * 128 * 1024 + OPK0, 1024, (const bf16_t*)(p.ws + WS_WOUT) + (size_t)tn * 128 * 1024 + OPK0, 1024, OPK, smem);
            epi_resid(p, l, tm * 128, tn * 128, 2 * 1024, (const float*)smem);
            __syncthreads();
        }
        gsync(p0.ws, epoch);
        { const Params p = launder(p0); adaln_phase(p, l, p.g_mlp + l * 1024, 3 * 1024, 4 * 1024, ntm * 128); }
        gsync(p0.ws, epoch);
        if (PM & 1024) for (int rr = 0;; ++rr) {
            int tm, tn; if (!tile_of(rr, 32, (ntm / 2) * 32, tm, tn, 4)) break;
            const Params p = launder(p0);
            Acc2 C;
            gemm_tile_core2((const bf16_t*)(p.ws + WS_H) + (size_t)tm * 256 * 1024, 1024, (const bf16_t*)(p.ws + WS_WFF1) + (size_t)tn * 128 * 1024, 1024, 1024, smem, C);
            gemm2_stage(C, 0, smem);
            epi_ff1(p, tm * 256, tn * 128, (const float*)smem);
            __syncthreads();
            gemm2_stage(C, 1, smem);
            epi_ff1(p, tm * 256 + 128, tn * 128, (const float*)smem);
            __syncthreads();
        }
        gsync(p0.ws, epoch);
        if (PM & 2048) for (int rr = 0;; ++rr) {
            int tm, tn; if (!tile_of(rr, 8, ntm * 8, tm, tn)) break;
            const Params p = launder(p0);
            gemm_tile_core((const bf16_t*)(p.ws + WS_H1) + (size_t)tm * 128 * 4096, 4096, (const bf16_t*)(p.ws + WS_WFF2) + (size_t)tn * 128 * 4096, 4096, 4096, smem);
            epi_resid(p, l, tm * 128, tn * 128, 5 * 1024, (const float*)smem);
            __syncthreads();
        }
        gsync(p0.ws, epoch);
    }
    { const Params p = launder(p0); final_norm(p); }
}

extern "C" void kernel_launch(void* const* d_in, const int* in_sizes, int n_in, void* d_out, int out_size, void* d_ws, size_t ws_size, hipStream_t stream) {
    static int grid_blocks = 0;
    if (!grid_blocks) {
        int dev = 0, cus = 0, per_cu = 0;
        hipGetDevice(&dev);
        hipDeviceGetAttribute(&cus, hipDeviceAttributeMultiprocessorCount, dev);
        hipFuncSetAttribute((const void*)fwd_megakernel, hipFuncAttributeMaxDynamicSharedMemorySize, SMEM_BYTES);
        hipOccupancyMaxActiveBlocksPerMultiprocessor(&per_cu, (const void*)fwd_megakernel, 256, SMEM_BYTES);
        if (per_cu < 1) per_cu = 1;
        if (per_cu > 2) per_cu = 2;
        grid_blocks = cus * per_cu;
        if (ws_size < WS_END2) fprintf(stderr, "workspace too small: %zu < %zu\n", ws_size, (size_t)WS_END2);
    }
    hipMemsetAsync((char*)d_ws + WS_BAR, 0, 128, stream);
    hipMemsetAsync((char*)d_ws + WS_XBAR, 0, XCD_BAR_WORDS * 4, stream);
    Params p{};
    const float** pp = (const float**)&p;
    for (int i = 0; i < 21; ++i) pp[i] = (const float*)d_in[i];
    p.out = (float*)d_out; p.ws = (char*)d_ws;
    void* args[] = {&p};
    hipError_t e = hipLaunchCooperativeKernel((const void*)fwd_megakernel, dim3(grid_blocks), dim3(256), args, SMEM_BYTES, stream);
    if (e != hipSuccess) fprintf(stderr, "cooperative launch failed: %s (grid %d)\n", hipGetErrorString(e), grid_blocks);
}
```

```cpp
#include <hip/hip_runtime.h>
#include <hip/hip_cooperative_groups.h>
#include <stdint.h>
#include <cstdio>
namespace cg = cooperative_groups;

#define GAS __attribute__((address_space(1)))
typedef unsigned short bf16_t;
typedef short bf16x8 __attribute__((ext_vector_type(8)));
typedef short bf16x4 __attribute__((ext_vector_type(4)));
typedef float f32x16 __attribute__((ext_vector_type(16)));
typedef float f32x4 __attribute__((ext_vector_type(4)));
typedef unsigned u32x4 __attribute__((ext_vector_type(4)));
typedef unsigned u32x2 __attribute__((ext_vector_type(2)));
#define MK8(a,b,c,d) __builtin_bit_cast(bf16x8, (u32x4){(a),(b),(c),(d)})
#define MK4(a,b) __builtin_bit_cast(bf16x4, (u32x2){(a),(b)})

constexpr int T_LAT = 32768, T_CTX = 1024, T_ALL = 33792, NKEY = 8448, DM = 1024, NIN = 3712, DFF = 4096;
constexpr float EPS = 1e-6f;
constexpr float LOG2E = 1.4426950408889634f;

constexpr size_t WS_WIN = 0;
constexpr size_t WS_WOUT = WS_WIN + (size_t)NIN * 1024 * 2;
constexpr size_t WS_WFF1 = WS_WOUT + (size_t)1024 * 1024 * 2;
constexpr size_t WS_WFF2 = WS_WFF1 + (size_t)4096 * 1024 * 2;
constexpr size_t WS_WUQ = WS_WFF2 + (size_t)4096 * 1024 * 2;
constexpr size_t WS_WUKV = WS_WUQ + (size_t)768 * 256 * 2;
constexpr size_t WS_XC = WS_WUKV + (size_t)768 * 128 * 2;
constexpr size_t WS_MOD = WS_XC + (size_t)1024 * 1024 * 4;
constexpr size_t WS_LB = WS_MOD + (size_t)4 * 5 * 6144 * 4;
constexpr size_t WS_LAM = WS_LB + (size_t)2 * 4 * 512 * 4;
constexpr size_t WS_ROPE = WS_LAM + 256;
constexpr size_t WS_KMAX = WS_ROPE + 8192;
constexpr size_t WS_DSEG = WS_KMAX + 2048;
constexpr size_t WS_H = WS_DSEG + (size_t)32 * 33 * 128 * 4;
constexpr size_t WS_R = WS_H + (size_t)T_ALL * 1024 * 2;
constexpr size_t WS_QDA = WS_R;
constexpr size_t WS_KDA = WS_QDA + (size_t)T_ALL * 384 * 2;
constexpr size_t WS_VDAT = WS_KDA + (size_t)T_ALL * 384 * 2;
constexpr size_t WS_QMLA = WS_VDAT + (size_t)T_ALL * 384 * 2;
constexpr size_t WS_KMLA = WS_QMLA + (size_t)T_ALL * 576 * 2;
constexpr size_t WS_VMLAT = WS_KMLA + (size_t)T_ALL * 576 * 2;
constexpr size_t WS_CQ = WS_VMLAT + (size_t)T_ALL * 384 * 2;
constexpr size_t WS_CKV = WS_CQ + (size_t)T_ALL * 256 * 2;
constexpr size_t WS_KR = WS_CKV + (size_t)T_ALL * 128 * 2;
constexpr size_t WS_HG = WS_KR + (size_t)T_ALL * 32 * 2;
constexpr size_t WS_SST = WS_HG + (size_t)T_ALL * 2048 * 2;
constexpr size_t WS_END = WS_SST + (size_t)32 * 33 * 8192 * 4;
constexpr size_t WS_XBAR = WS_END;
constexpr size_t WS_SSQ = WS_XBAR + 16384;
constexpr size_t WS_END2 = WS_SSQ + (size_t)T_ALL * 4 * 4;
constexpr size_t WS_H1 = WS_R;
constexpr size_t WS_BAR = WS_LAM + 128;
static_assert(WS_R + (size_t)T_ALL * 4096 * 2 <= WS_END + (64u << 20), "h1 overlay");
static_assert(WS_END2 <= 536870912ull, "workspace too large");
static_assert(WS_R + (size_t)T_ALL * 4096 * 2 <= 536870912ull, "workspace too large (h1)");

constexpr int SMEM_BYTES = 73728 + 1024;

struct Params {
    const float *x, *c, *ctx, *c_ctx, *w_mod, *b_mod, *g_mix, *g_mlp, *w_in, *w_out, *da_lambda, *da_subln_g, *g_cq, *g_ckv, *w_uq, *w_ukv, *hg_lb, *hg_norm_g, *w_ff1, *w_ff2, *g_final;
    float* out;
    char* ws;
};

__device__ __forceinline__ int opaque_tid() { int t = threadIdx.x; asm volatile("" : "+v"(t)); return t; }
__device__ __forceinline__ bf16_t f2bf(float f) { unsigned u = __float_as_uint(f); u += 0x7fffu + ((u >> 16) & 1u); return (bf16_t)(u >> 16); }
__device__ __forceinline__ float bf2f(bf16_t h) { return __uint_as_float(((unsigned)h) << 16); }
typedef __bf16 bf16v2_t __attribute__((ext_vector_type(2)));
typedef float f32v2_t __attribute__((ext_vector_type(2)));
__device__ __forceinline__ unsigned pack2(float a, float b) { const f32v2_t f = {a, b}; const bf16v2_t r = __builtin_convertvector(f, bf16v2_t); return __builtin_bit_cast(unsigned, r); }
__device__ __forceinline__ unsigned cvt_pk(float lo, float hi) { return pack2(lo, hi); }
__device__ __forceinline__ float ld_coh(const float* p) { return __hip_atomic_load(p, __ATOMIC_RELAXED, __HIP_MEMORY_SCOPE_AGENT); }
__device__ __forceinline__ float fexp2(float x) { return __builtin_amdgcn_exp2f(x); }
__device__ __forceinline__ float fexp(float x) { return __builtin_amdgcn_exp2f(x * LOG2E); }

__device__ __forceinline__ void row_bk(int row, int& b, int& key, bool& lat) {
    if (row < T_LAT) { b = row >> 13; key = 256 + (row & 8191); lat = true; }
    else { int r = row - T_LAT; b = r >> 8; key = r & 255; lat = false; }
}
__device__ __forceinline__ const float* xrow_in(const Params& p, int row) {
    return row < T_LAT ? p.x + (size_t)row * 1024 : p.ctx + (size_t)(row - T_LAT) * 1024;
}
__device__ __forceinline__ float* xrow(const Params& p, int row) {
    return row < T_LAT ? p.out + (size_t)row * 1024 : (float*)(p.ws + WS_XC) + (size_t)(row - T_LAT) * 1024;
}

__device__ __forceinline__ void gemm_tile_core(const bf16_t* __restrict__ A, int lda, const bf16_t* __restrict__ Bt, int ldb, int K, char* smem) {
    const int tid = opaque_tid(), lane = tid & 63, wid = tid >> 6;
    const int wm = wid >> 1, wn = wid & 1, l31 = lane & 31, hi = lane >> 5;
    f32x16 acc[2][2];
#pragma unroll
    for (int i = 0; i < 2; ++i)
#pragma unroll
        for (int j = 0; j < 2; ++j)
#pragma unroll
            for (int r = 0; r < 16; ++r) acc[i][j][r] = 0.f;
    const int lrow = tid >> 3, lkc = tid & 7;
    const bf16_t* ap = A + (size_t)lrow * lda + lkc * 8;
    const bf16_t* bp = Bt + (size_t)lrow * ldb + lkc * 8;
    uint4 p0, p1, p2, p3, p4, p5, p6, p7, q0, q1, q2, q3, q4, q5, q6, q7;
    const int nk = K >> 6;
    const size_t sA = (size_t)32 * lda, sB = (size_t)32 * ldb;
#define G_LOAD0(KT) { const bf16_t* a_ = ap + (KT) * 64; const bf16_t* b_ = bp + (KT) * 64; p0 = *(const uint4*)(a_); p1 = *(const uint4*)(a_ + sA); p2 = *(const uint4*)(a_ + 2 * sA); p3 = *(const uint4*)(a_ + 3 * sA); \
        p4 = *(const uint4*)(b_); p5 = *(const uint4*)(b_ + sB); p6 = *(const uint4*)(b_ + 2 * sB); p7 = *(const uint4*)(b_ + 3 * sB); }
#define G_LOAD1(KT) { const bf16_t* a_ = ap + (KT) * 64; const bf16_t* b_ = bp + (KT) * 64; q0 = *(const uint4*)(a_); q1 = *(const uint4*)(a_ + sA); q2 = *(const uint4*)(a_ + 2 * sA); q3 = *(const uint4*)(a_ + 3 * sA); \
        q4 = *(const uint4*)(b_); q5 = *(const uint4*)(b_ + sB); q6 = *(const uint4*)(b_ + 2 * sB); q7 = *(const uint4*)(b_ + 3 * sB); }
#define G_WRITE0(BUF) { char* wa_ = smem + (BUF) * 36864 + lrow * 144 + lkc * 16; char* wb_ = wa_ + 18432; *(uint4*)(wa_) = p0; *(uint4*)(wa_ + 4608) = p1; *(uint4*)(wa_ + 9216) = p2; *(uint4*)(wa_ + 13824) = p3; \
        *(uint4*)(wb_) = p4; *(uint4*)(wb_ + 4608) = p5; *(uint4*)(wb_ + 9216) = p6; *(uint4*)(wb_ + 13824) = p7; }
#define G_WRITE1(BUF) { char* wa_ = smem + (BUF) * 36864 + lrow * 144 + lkc * 16; char* wb_ = wa_ + 18432; *(uint4*)(wa_) = q0; *(uint4*)(wa_ + 4608) = q1; *(uint4*)(wa_ + 9216) = q2; *(uint4*)(wa_ + 13824) = q3; \
        *(uint4*)(wb_) = q4; *(uint4*)(wb_ + 4608) = q5; *(uint4*)(wb_ + 9216) = q6; *(uint4*)(wb_ + 13824) = q7; }
#define G_COMPUTE(BUF) { const char* sa = smem + (BUF) * 36864; const char* sb = sa + 18432; \
        _Pragma("unroll") for (int ks = 0; ks < 4; ++ks) { bf16x8 af[2], bfr[2]; \
            _Pragma("unroll") for (int i = 0; i < 2; ++i) af[i] = *(const bf16x8*)(sa + (wm * 64 + i * 32 + l31) * 144 + ks * 32 + hi * 16); \
            _Pragma("unroll") for (int j = 0; j < 2; ++j) bfr[j] = *(const bf16x8*)(sb + (wn * 64 + j * 32 + l31) * 144 + ks * 32 + hi * 16); \
            _Pragma("unroll") for (int i = 0; i < 2; ++i) _Pragma("unroll") for (int j = 0; j < 2; ++j) acc[i][j] = __builtin_amdgcn_mfma_f32_32x32x16_bf16(af[i], bfr[j], acc[i][j], 0, 0, 0); } }
    G_LOAD0(0);
    G_WRITE0(0);
    G_LOAD0(1);
    { const int k2 = nk > 2 ? 2 : nk - 1; G_LOAD1(k2); }
    __syncthreads();
    for (int kt = 0; kt < nk; kt += 2) {
        G_COMPUTE(0);
        G_WRITE0(1);
        { const int k3 = kt + 3 < nk ? kt + 3 : nk - 1; G_LOAD0(k3); }
        __syncthreads();
        G_COMPUTE(1);
        G_WRITE1(0);
        { const int k4 = kt + 4 < nk ? kt + 4 : nk - 1; G_LOAD1(k4); }
        __syncthreads();
    }
#undef G_LOAD0
#undef G_LOAD1
#undef G_WRITE0
#undef G_WRITE1
#undef G_COMPUTE
    float* cs = (float*)smem;
#pragma unroll
    for (int i = 0; i < 2; ++i)
#pragma unroll
        for (int j = 0; j < 2; ++j)
#pragma unroll
            for (int r = 0; r < 16; ++r)
                cs[(wm * 64 + i * 32 + 8 * (r >> 2) + 4 * hi + (r & 3)) * 132 + wn * 64 + j * 32 + l31] = acc[i][j][r];
    __syncthreads();
}


struct Acc2 { f32x16 a[4][2]; };
__device__ __forceinline__ void gemm_tile_core2(const bf16_t* __restrict__ A, int lda, const bf16_t* __restrict__ Bt, int ldb, int K, char* smem, Acc2& C) {
    const int tid = opaque_tid(), lane = tid & 63, wid = tid >> 6;
    const int wm = wid >> 1, wn = wid & 1, l31 = lane & 31, hi = lane >> 5;
#pragma unroll
    for (int i = 0; i < 4; ++i)
#pragma unroll
        for (int j = 0; j < 2; ++j)
#pragma unroll
            for (int r = 0; r < 16; ++r) C.a[i][j][r] = 0.f;
    const int lrow = tid >> 2, lkc = tid & 3;
    const bf16_t* ap = A + (size_t)lrow * lda + lkc * 8;
    const bf16_t* bp = Bt + (size_t)lrow * ldb + lkc * 8;
    const size_t sA = (size_t)64 * lda, sB = (size_t)64 * ldb;
    uint4 p0, p1, p2, p3, p4, p5, q0, q1, q2, q3, q4, q5;
    const int nk = K >> 5;
    constexpr int STG = 30720, BOFF = 20480;
#define H_LOAD0(KT) { const bf16_t* a_ = ap + (KT) * 32; const bf16_t* b_ = bp + (KT) * 32; p0 = *(const uint4*)(a_); p1 = *(const uint4*)(a_ + sA); p2 = *(const uint4*)(a_ + 2 * sA); p3 = *(const uint4*)(a_ + 3 * sA); \
        p4 = *(const uint4*)(b_); p5 = *(const uint4*)(b_ + sB); }
#define H_LOAD1(KT) { const bf16_t* a_ = ap + (KT) * 32; const bf16_t* b_ = bp + (KT) * 32; q0 = *(const uint4*)(a_); q1 = *(const uint4*)(a_ + sA); q2 = *(const uint4*)(a_ + 2 * sA); q3 = *(const uint4*)(a_ + 3 * sA); \
        q4 = *(const uint4*)(b_); q5 = *(const uint4*)(b_ + sB); }
#define H_WRITE0(BUF) { char* wa_ = smem + (BUF) * STG + lrow * 80 + lkc * 16; char* wb_ = wa_ + BOFF; *(uint4*)(wa_) = p0; *(uint4*)(wa_ + 5120) = p1; *(uint4*)(wa_ + 10240) = p2; *(uint4*)(wa_ + 15360) = p3; \
        *(uint4*)(wb_) = p4; *(uint4*)(wb_ + 5120) = p5; }
#define H_WRITE1(BUF) { char* wa_ = smem + (BUF) * STG + lrow * 80 + lkc * 16; char* wb_ = wa_ + BOFF; *(uint4*)(wa_) = q0; *(uint4*)(wa_ + 5120) = q1; *(uint4*)(wa_ + 10240) = q2; *(uint4*)(wa_ + 15360) = q3; \
        *(uint4*)(wb_) = q4; *(uint4*)(wb_ + 5120) = q5; }
#define H_COMPUTE(BUF) { const char* sa = smem + (BUF) * STG; const char* sb = sa + BOFF; \
        _Pragma("unroll") for (int ks = 0; ks < 2; ++ks) { bf16x8 af[4], bfr[2]; \
            _Pragma("unroll") for (int i = 0; i < 4; ++i) af[i] = *(const bf16x8*)(sa + (wm * 128 + i * 32 + l31) * 80 + ks * 32 + hi * 16); \
            _Pragma("unroll") for (int j = 0; j < 2; ++j) bfr[j] = *(const bf16x8*)(sb + (wn * 64 + j * 32 + l31) * 80 + ks * 32 + hi * 16); \
            _Pragma("unroll") for (int i = 0; i < 4; ++i) _Pragma("unroll") for (int j = 0; j < 2; ++j) C.a[i][j] = __builtin_amdgcn_mfma_f32_32x32x16_bf16(af[i], bfr[j], C.a[i][j], 0, 0, 0); } }
    H_LOAD0(0);
    H_WRITE0(0);
    H_LOAD0(1);
    { const int k2 = nk > 2 ? 2 : nk - 1; H_LOAD1(k2); }
    __syncthreads();
    for (int kt = 0; kt < nk; kt += 2) {
        H_COMPUTE(0);
        H_WRITE0(1);
        { const int k3 = kt + 3 < nk ? kt + 3 : nk - 1; H_LOAD0(k3); }
        __syncthreads();
        H_COMPUTE(1);
        H_WRITE1(0);
        { const int k4 = kt + 4 < nk ? kt + 4 : nk - 1; H_LOAD1(k4); }
        __syncthreads();
    }
#undef H_LOAD0
#undef H_LOAD1
#undef H_WRITE0
#undef H_WRITE1
#undef H_COMPUTE
}
__device__ __forceinline__ void gemm2_stage(const Acc2& C, int half, char* smem) {
    const int tid = opaque_tid(), lane = tid & 63, wid = tid >> 6;
    const int wm = wid >> 1, wn = wid & 1, l31 = lane & 31, hi = lane >> 5;
    float* cs = (float*)smem;
    if (wm == half) {
#pragma unroll
        for (int i = 0; i < 4; ++i)
#pragma unroll
            for (int j = 0; j < 2; ++j)
#pragma unroll
                for (int r = 0; r < 16; ++r)
                    cs[(i * 32 + 8 * (r >> 2) + 4 * hi + (r & 3)) * 132 + wn * 64 + j * 32 + l31] = C.a[i][j][r];
    }
    __syncthreads();
}

__device__ __forceinline__ void epi_copy_bf16(const float* cs, bf16_t* dst, int ld, int row0, int col0, float sc) {
    const int tid = opaque_tid(), c4 = (tid & 31) * 4, r0 = tid >> 5;
#pragma unroll 4
    for (int i = 0; i < 16; ++i) {
        const int r = r0 + 8 * i;
        const f32x4 v = *(const f32x4*)(cs + r * 132 + c4);
        uint2 w; w.x = pack2(v[0] * sc, v[1] * sc); w.y = pack2(v[2] * sc, v[3] * sc);
        *(uint2*)(dst + (size_t)(row0 + r) * ld + col0 + c4) = w;
    }
}
__device__ __forceinline__ void epi_store_T(const float* cs, int cbase, int ndcols, bf16_t* dstbase  , const float* rs) {
    const int tid = opaque_tid();
    const int items = ndcols * 16;
    for (int it = tid; it < items; it += 256) {
        const int c = it % ndcols, rg = it / ndcols;
        float v[8];
#pragma unroll
        for (int j = 0; j < 8; ++j) { v[j] = cs[(rg * 8 + j) * 132 + cbase + c]; if (rs) v[j] *= rs[rg * 8 + j]; }
        uint4 w; w.x = pack2(v[0], v[1]); w.y = pack2(v[2], v[3]); w.z = pack2(v[4], v[5]); w.w = pack2(v[6], v[7]);
        *(uint4*)(dstbase + (size_t)c * NKEY + rg * 8) = w;
    }
}
__device__ __forceinline__ void rope32(float (&v)[32], int n, const float* rope) {
#pragma unroll
    for (int a = 0; a < 2; ++a) {
        const int pos = a == 0 ? (n >> 6) : (n & 63);
#pragma unroll
        for (int f = 0; f < 8; ++f) {
            const float cs_ = rope[(pos * 8 + f) * 2], sn = rope[(pos * 8 + f) * 2 + 1];
            const float x1 = v[a * 16 + f], x2 = v[a * 16 + 8 + f];
            v[a * 16 + f] = x1 * cs_ - x2 * sn;
            v[a * 16 + 8 + f] = x2 * cs_ + x1 * sn;
        }
    }
}
__device__ __forceinline__ float wave_max(float v) {
#pragma unroll
    for (int o = 32; o >= 1; o >>= 1) v = fmaxf(v, __shfl_xor(v, o));
    return v;
}
__device__ __forceinline__ void store32_bf16(bf16_t* dst, const float (&v)[32], float sc) {
#pragma unroll
    for (int q = 0; q < 4; ++q) {
        uint4 w; w.x = pack2(v[q * 8 + 0] * sc, v[q * 8 + 1] * sc); w.y = pack2(v[q * 8 + 2] * sc, v[q * 8 + 3] * sc);
        w.z = pack2(v[q * 8 + 4] * sc, v[q * 8 + 5] * sc); w.w = pack2(v[q * 8 + 6] * sc, v[q * 8 + 7] * sc);
        *(uint4*)(dst + q * 8) = w;
    }
}

__device__ void epi_inproj(const Params& p, int l, int m0, int tn, const float* cs) {
    const int tid = opaque_tid();
    int b, key0; bool lat; row_bk(m0, b, key0, lat);
    const float* rope = (const float*)(p.ws + WS_ROPE);
    if (tn < 6 || tn == 28) {
        const int r = tid & 127, half = tid >> 7;
        const int row = m0 + r, key = key0 + r;
        const int ngrp = (tn == 28) ? 1 : 4;
        for (int gi = half; gi < ngrp; gi += 2) {
            float v[32];
#pragma unroll
            for (int q = 0; q < 8; ++q) { const f32x4 t = *(const f32x4*)(cs + r * 132 + gi * 32 + q * 4); v[q * 4] = t[0]; v[q * 4 + 1] = t[1]; v[q * 4 + 2] = t[2]; v[q * 4 + 3] = t[3]; }
            if (lat) rope32(v, row & 8191, rope);
            if (tn < 3) {
                bf16_t* dst = (bf16_t*)(p.ws + WS_QDA) + ((size_t)(b * 12 + tn * 4 + gi) * NKEY + key) * 32;
                store32_bf16(dst, v, 0.17677669529663687f * LOG2E);
            } else if (tn < 6) {
                const int hc = (tn - 3) * 4 + gi;
                bf16_t* dst = (bf16_t*)(p.ws + WS_KDA) + ((size_t)(b * 12 + hc) * NKEY + key) * 32;
                store32_bf16(dst, v, 1.0f);
                float n2 = 0.f;
#pragma unroll
                for (int q = 0; q < 32; ++q) n2 += v[q] * v[q];
                n2 = wave_max(n2);
                if ((tid & 63) == 0) atomicMax((unsigned*)(p.ws + WS_KMAX) + (l * 4 + b) * 32 + hc, __float_as_uint(n2));
            } else {
                bf16_t* dst = (bf16_t*)(p.ws + WS_KR) + (size_t)row * 32;
                store32_bf16(dst, v, 1.0f);
            }
        }
    } else if (tn < 9) {
        const int h0 = (tn - 6) * 2;
        bf16_t* dst = (bf16_t*)(p.ws + WS_VDAT) + ((size_t)(b * 6 + h0) * 64) * NKEY + key0;
        epi_store_T(cs, 0, 128, dst, nullptr);
    } else if (tn < 12) {
        if (tn < 11) epi_copy_bf16(cs, (bf16_t*)(p.ws + WS_CQ), 256, m0, (tn - 9) * 128, 1.0f);
        else epi_copy_bf16(cs, (bf16_t*)(p.ws + WS_CKV), 128, m0, 0, 1.0f);
        if (tid < 128) {
            float ssq = 0.f;
#pragma unroll 8
            for (int q = 0; q < 32; ++q) { const f32x4 t = *(const f32x4*)(cs + tid * 132 + q * 4); ssq += t[0] * t[0] + t[1] * t[1] + t[2] * t[2] + t[3] * t[3]; }
            ((float*)(p.ws + WS_SSQ))[(size_t)(m0 + tid) * 4 + (tn - 9)] = ssq;
        }
    } else {
        epi_copy_bf16(cs, (bf16_t*)(p.ws + WS_HG), 2048, m0, (tn - 12) * 128, 1.0f);
    }
}

__device__ __forceinline__ void row_rstd(const Params& p, int which  , int m0, float* rs) {
    const int tid = opaque_tid();
    if (tid < 128) {
        const float* q = (const float*)(p.ws + WS_SSQ) + (size_t)(m0 + tid) * 4;
        rs[tid] = which == 0 ? rsqrtf((q[0] + q[1]) * (1.0f / 256.0f) + EPS) : rsqrtf(q[2] * (1.0f / 128.0f) + EPS);
    }
}
__device__ void epi_uq(const Params& p, int m0, int h, const float* cs, const float* rs) {
    const int tid = opaque_tid(), r = tid & 127, half = tid >> 7;
    int b, key0; bool lat; row_bk(m0, b, key0, lat);
    const int row = m0 + r, key = key0 + r;
    const float sc = rs[r] * 0.10206207261596575f * LOG2E;
    bf16_t* dst = (bf16_t*)(p.ws + WS_QMLA) + ((size_t)(b * 6 + h) * NKEY + key) * 96;
    if (half == 0) {
        float v[32];
#pragma unroll
        for (int q = 0; q < 8; ++q) { const f32x4 t = *(const f32x4*)(cs + r * 132 + q * 4); v[q * 4] = t[0]; v[q * 4 + 1] = t[1]; v[q * 4 + 2] = t[2]; v[q * 4 + 3] = t[3]; }
        store32_bf16(dst, v, sc);
#pragma unroll
        for (int q = 0; q < 4; ++q) { const f32x4 t = *(const f32x4*)(cs + r * 132 + 32 + q * 4); v[q * 4] = t[0]; v[q * 4 + 1] = t[1]; v[q * 4 + 2] = t[2]; v[q * 4 + 3] = t[3]; }
#pragma unroll
        for (int q = 0; q < 2; ++q) {
            uint4 w; w.x = pack2(v[q * 8 + 0] * sc, v[q * 8 + 1] * sc); w.y = pack2(v[q * 8 + 2] * sc, v[q * 8 + 3] * sc);
            w.z = pack2(v[q * 8 + 4] * sc, v[q * 8 + 5] * sc); w.w = pack2(v[q * 8 + 6] * sc, v[q * 8 + 7] * sc);
            *(uint4*)(dst + 32 + q * 8) = w;
        }
    } else {
        float v[32];
#pragma unroll
        for (int q = 0; q < 4; ++q) { const f32x4 t = *(const f32x4*)(cs + r * 132 + 48 + q * 4); v[q * 4] = t[0]; v[q * 4 + 1] = t[1]; v[q * 4 + 2] = t[2]; v[q * 4 + 3] = t[3]; }
#pragma unroll
        for (int q = 0; q < 2; ++q) {
            uint4 w; w.x = pack2(v[q * 8 + 0] * sc, v[q * 8 + 1] * sc); w.y = pack2(v[q * 8 + 2] * sc, v[q * 8 + 3] * sc);
            w.z = pack2(v[q * 8 + 4] * sc, v[q * 8 + 5] * sc); w.w = pack2(v[q * 8 + 6] * sc, v[q * 8 + 7] * sc);
            *(uint4*)(dst + 48 + q * 8) = w;
        }
#pragma unroll
        for (int q = 0; q < 8; ++q) { const f32x4 t = *(const f32x4*)(cs + r * 132 + 64 + q * 4); v[q * 4] = t[0]; v[q * 4 + 1] = t[1]; v[q * 4 + 2] = t[2]; v[q * 4 + 3] = t[3]; }
        if (lat) rope32(v, row & 8191, (const float*)(p.ws + WS_ROPE));
        store32_bf16(dst + 64, v, sc);
    }
}
__device__ void epi_ukv(const Params& p, int l, int m0, int h, const float* cs, const float* rs) {
    const int tid = opaque_tid();
    int b, key0; bool lat; row_bk(m0, b, key0, lat);
    bf16_t* vdst = (bf16_t*)(p.ws + WS_VMLAT) + ((size_t)(b * 6 + h) * 64) * NKEY + key0;
    epi_store_T(cs, 64, 64, vdst, rs);
    if (tid < 128) {
        const int r = tid, row = m0 + r, key = key0 + r;
        const float sc = rs[r];
        bf16_t* dst = (bf16_t*)(p.ws + WS_KMLA) + ((size_t)(b * 6 + h) * NKEY + key) * 96;
        float n2 = 0.f;
        float v[32];
#pragma unroll
        for (int part = 0; part < 2; ++part) {
#pragma unroll
            for (int q = 0; q < 8; ++q) { const f32x4 t = *(const f32x4*)(cs + r * 132 + part * 32 + q * 4); v[q * 4] = t[0] * sc; v[q * 4 + 1] = t[1] * sc; v[q * 4 + 2] = t[2] * sc; v[q * 4 + 3] = t[3] * sc; }
#pragma unroll
            for (int q = 0; q < 32; ++q) n2 += v[q] * v[q];
            store32_bf16(dst + part * 32, v, 1.0f);
        }
        const bf16_t* kr = (const bf16_t*)(p.ws + WS_KR) + (size_t)row * 32;
#pragma unroll
        for (int q = 0; q < 4; ++q) {
            const uint4 w = *(const uint4*)(kr + q * 8);
            *(uint4*)(dst + 64 + q * 8) = w;
            const unsigned ww[4] = {w.x, w.y, w.z, w.w};
#pragma unroll
            for (int j = 0; j < 4; ++j) { const float f0 = __uint_as_float(ww[j] << 16), f1 = __uint_as_float(ww[j] & 0xffff0000u); n2 += f0 * f0 + f1 * f1; }
        }
        n2 = wave_max(n2);
        if ((tid & 63) == 0) atomicMax((unsigned*)(p.ws + WS_KMAX) + (l * 4 + b) * 32 + 12 + h, __float_as_uint(n2));
    }
}
__device__ __forceinline__ void epi_resid(const Params& p, int l, int m0, int n0, int goff, const float* cs) {
    const int tid = opaque_tid(), c4 = (tid & 31) * 4, r0 = tid >> 5;
    int b, key0; bool lat; row_bk(m0, b, key0, lat);
    const float* gate = (const float*)(p.ws + WS_MOD) + (size_t)(l * 5 + (lat ? b : 4)) * 6144 + goff + n0 + c4;
    const f32x4 g = *(const f32x4*)gate;
#pragma unroll 4
    for (int i = 0; i < 16; ++i) {
        const int r = r0 + 8 * i;
        const f32x4 v = *(const f32x4*)(cs + r * 132 + c4);
        float* xp = xrow(p, m0 + r) + n0 + c4;
        const float* xs = (l == 0 && goff == 2 * 1024) ? xrow_in(p, m0 + r) + n0 + c4 : xp;
        f32x4 x = *(const f32x4*)xs;
        x += g * v;
        *(f32x4*)xp = x;
    }
}
__device__ __forceinline__ void epi_ff1(const Params& p, int m0, int n0, const float* cs) {
    const int tid = opaque_tid(), c4 = (tid & 31) * 4, r0 = tid >> 5;
    bf16_t* dst = (bf16_t*)(p.ws + WS_H1);
#pragma unroll 4
    for (int i = 0; i < 16; ++i) {
        const int r = r0 + 8 * i;
        f32x4 v = *(const f32x4*)(cs + r * 132 + c4);
#pragma unroll
        for (int j = 0; j < 4; ++j) { const float t = fmaxf(v[j], 0.f); v[j] = t * t; }
        uint2 w; w.x = pack2(v[0], v[1]); w.y = pack2(v[2], v[3]);
        *(uint2*)(dst + (size_t)(m0 + r) * 4096 + n0 + c4) = w;
    }
}

template <int DQK>
__device__ __forceinline__ void attn_pass(const bf16_t* __restrict__ Qb, const bf16_t* __restrict__ Kb, const bf16_t* __restrict__ VTb,
                                          int q0, int nkt, float kmax, char* smem, f32x16& O0, f32x16& O1, float& lsum) {
    constexpr int KS = DQK * 2 + 16, VS = 136, STAGE = 64 * KS + 64 * VS, NKC = DQK / 32, CPR = DQK / 8;
    const int tid = opaque_tid(), lane = tid & 63, wid = tid >> 6, l31 = lane & 31, hi = lane >> 5;
    bf16x8 qf[DQK / 16];
    const bf16_t* qp = Qb + (size_t)(q0 + wid * 32 + l31) * DQK + hi * 8;
    float qn = 0.f;
#pragma unroll
    for (int ks = 0; ks < DQK / 16; ++ks) {
        qf[ks] = *(const bf16x8*)(qp + ks * 16);
#pragma unroll
        for (int j = 0; j < 8; ++j) { const float f = bf2f((bf16_t)qf[ks][j]); qn += f * f; }
    }
    qn += __shfl_xor(qn, 32);
    const float negm = -(sqrtf(qn) * kmax);
#pragma unroll
    for (int r = 0; r < 16; ++r) { O0[r] = 0.f; O1[r] = 0.f; }
    lsum = 0.f;
    const int kr0 = tid / CPR, kc0 = tid % CPR, kr1 = (tid + 256) / CPR, kc1 = (tid + 256) % CPR, kr2 = (tid + 512) / CPR, kc2 = (tid + 512) % CPR;
    const int vr0 = tid >> 3, vc0 = tid & 7;
    const bf16_t* vg = VTb + (size_t)vr0 * NKEY + vc0 * 8;
    uint4 a0, a1, a2, a3, a4;
#define AT_LOADA(KT) { const bf16_t* kp_ = Kb + (size_t)(KT) * 64 * DQK; a0 = *(const uint4*)(kp_ + (size_t)tid * 8); \
        if constexpr (NKC > 1) { a1 = *(const uint4*)(kp_ + (size_t)(tid + 256) * 8); a2 = *(const uint4*)(kp_ + (size_t)(tid + 512) * 8); } \
        a3 = *(const uint4*)(vg + (KT) * 64); a4 = *(const uint4*)(vg + (size_t)32 * NKEY + (KT) * 64); }
#define AT_WRITE(X0, X1, X2, X3, X4, BUF) { char* sk_ = smem + (BUF) * STAGE; char* sv_ = sk_ + 64 * KS; \
        *(uint4*)(sk_ + kr0 * KS + kc0 * 16) = X0; \
        if constexpr (NKC > 1) { *(uint4*)(sk_ + kr1 * KS + kc1 * 16) = X1; *(uint4*)(sk_ + kr2 * KS + kc2 * 16) = X2; } \
        { uint2* d_ = (uint2*)(sv_ + vr0 * VS + vc0 * 16); d_[0] = make_uint2(X3.x, X3.y); d_[1] = make_uint2(X3.z, X3.w); } \
        { uint2* d_ = (uint2*)(sv_ + (vr0 + 32) * VS + vc0 * 16); d_[0] = make_uint2(X4.x, X4.y); d_[1] = make_uint2(X4.z, X4.w); } }
    f32x16 NEG;
#pragma unroll
    for (int r = 0; r < 16; ++r) NEG[r] = negm;
    auto compute = [&](int buf) {
        const char* sk = smem + buf * STAGE; const char* sv = sk + 64 * KS;
        constexpr int NKS = DQK / 16;
        bf16x8 k0[NKS], k1[NKS], v0[4], v1[4];
#pragma unroll
        for (int ks = 0; ks < NKS; ++ks) k0[ks] = *(const bf16x8*)(sk + (l31)*KS + ks * 32 + hi * 16);
#pragma unroll
        for (int ks = 0; ks < NKS; ++ks) k1[ks] = *(const bf16x8*)(sk + (32 + l31) * KS + ks * 32 + hi * 16);
#pragma unroll
        for (int u = 0; u < 2; ++u)
#pragma unroll
            for (int db = 0; db < 2; ++db) {
                const char* vp = sv + (db * 32 + l31) * VS + (16 * u + 4 * hi) * 2;
                const uint2 x0 = *(const uint2*)vp, x1 = *(const uint2*)(vp + 16);
                v0[u * 2 + db] = MK8(x0.x, x0.y, x1.x, x1.y);
            }
        __builtin_amdgcn_sched_barrier(0);
        f32x16 S0, S1;
#pragma unroll
        for (int ks = 0; ks < NKS; ++ks) S0 = __builtin_amdgcn_mfma_f32_32x32x16_bf16(k0[ks], qf[ks], ks == 0 ? NEG : S0, 0, 0, 0);
#pragma unroll
        for (int ks = 0; ks < NKS; ++ks) S1 = __builtin_amdgcn_mfma_f32_32x32x16_bf16(k1[ks], qf[ks], ks == 0 ? NEG : S1, 0, 0, 0);
        __builtin_amdgcn_sched_barrier(0);
#pragma unroll
        for (int u = 0; u < 2; ++u)
#pragma unroll
            for (int db = 0; db < 2; ++db) {
                const char* vp = sv + (db * 32 + l31) * VS + (32 + 16 * u + 4 * hi) * 2;
                const uint2 x0 = *(const uint2*)vp, x1 = *(const uint2*)(vp + 16);
                v1[u * 2 + db] = MK8(x0.x, x0.y, x1.x, x1.y);
            }
        unsigned pk0[8], pk1[8];
#pragma unroll
        for (int r = 0; r < 16; r += 2) { const float e0 = fexp2(S0[r]), e1 = fexp2(S0[r + 1]); lsum += e0 + e1; pk0[r >> 1] = cvt_pk(e0, e1); }
        __builtin_amdgcn_sched_barrier(0);
#pragma unroll
        for (int u = 0; u < 2; ++u) {
            const bf16x8 pbv = MK8(pk0[4 * u], pk0[4 * u + 1], pk0[4 * u + 2], pk0[4 * u + 3]);
            O0 = __builtin_amdgcn_mfma_f32_32x32x16_bf16(v0[u * 2 + 0], pbv, O0, 0, 0, 0);
            O1 = __builtin_amdgcn_mfma_f32_32x32x16_bf16(v0[u * 2 + 1], pbv, O1, 0, 0, 0);
        }
#pragma unroll
        for (int r = 0; r < 16; r += 2) { const float e0 = fexp2(S1[r]), e1 = fexp2(S1[r + 1]); lsum += e0 + e1; pk1[r >> 1] = cvt_pk(e0, e1); }
        __builtin_amdgcn_sched_barrier(0);
#pragma unroll
        for (int u = 0; u < 2; ++u) {
            const bf16x8 pbv = MK8(pk1[4 * u], pk1[4 * u + 1], pk1[4 * u + 2], pk1[4 * u + 3]);
            O0 = __builtin_amdgcn_mfma_f32_32x32x16_bf16(v1[u * 2 + 0], pbv, O0, 0, 0, 0);
            O1 = __builtin_amdgcn_mfma_f32_32x32x16_bf16(v1[u * 2 + 1], pbv, O1, 0, 0, 0);
        }
    };
    a1 = a2 = make_uint4(0u, 0u, 0u, 0u);
    AT_LOADA(0);
    AT_WRITE(a0, a1, a2, a3, a4, 0);
    AT_LOADA(1);
    __syncthreads();
    for (int kt = 0; kt < nkt; kt += 2) {
        compute(0);
        AT_WRITE(a0, a1, a2, a3, a4, 1);
        { const int k2 = kt + 2 < nkt ? kt + 2 : nkt - 1; AT_LOADA(k2); }
        __syncthreads();
        compute(1);
        AT_WRITE(a0, a1, a2, a3, a4, 0);
        { const int k3 = kt + 3 < nkt ? kt + 3 : nkt - 1; AT_LOADA(k3); }
        __syncthreads();
    }
#undef AT_LOADA
#undef AT_WRITE
    lsum += __shfl_xor(lsum, 32);
}

__device__ void attn_unit(const Params& p, int l, int b, int hh, int qbi, char* smem) {
    const int q0 = qbi < 64 ? 256 + qbi * 128 : (qbi - 64) * 128;
    const int nkt = qbi < 64 ? 132 : 4;
    const int tid = opaque_tid(), lane = tid & 63, wid = tid >> 6, l31 = lane & 31, hi = lane >> 5;
    const int qkey = q0 + wid * 32 + l31;
    const int row = qkey < 256 ? T_LAT + b * 256 + qkey : b * 8192 + qkey - 256;
    const float* kmx = (const float*)(p.ws + WS_KMAX) + (l * 4 + b) * 32;
    bf16_t* Y = (bf16_t*)(p.ws + WS_H);
    if (hh < 6) {
        const int h = hh;
        const bf16_t* VT = (const bf16_t*)(p.ws + WS_VDAT) + ((size_t)(b * 6 + h) * 64) * NKEY;
        f32x16 A0, A1, B0, B1; float la, lb;
        {
            const size_t off = (size_t)(b * 12 + 2 * h) * NKEY * 32;
            attn_pass<32>((const bf16_t*)(p.ws + WS_QDA) + off, (const bf16_t*)(p.ws + WS_KDA) + off, VT, q0, nkt, sqrtf(ld_coh(kmx + 2 * h)), smem, A0, A1, la);
        }
        {
            const size_t off = (size_t)(b * 12 + 2 * h + 1) * NKEY * 32;
            attn_pass<32>((const bf16_t*)(p.ws + WS_QDA) + off, (const bf16_t*)(p.ws + WS_KDA) + off, VT, q0, nkt, sqrtf(ld_coh(kmx + 2 * h + 1)), smem, B0, B1, lb);
        }
        const float lam = ((const float*)(p.ws + WS_LAM))[l];
        const float lam_init = 0.8f - 0.6f * expf(-0.3f * (float)l);
        const float ia = 1.0f / la, ib = lam / lb;
        float ss = 0.f;
#pragma unroll
        for (int r = 0; r < 16; ++r) { A0[r] = A0[r] * ia - B0[r] * ib; A1[r] = A1[r] * ia - B1[r] * ib; ss += A0[r] * A0[r] + A1[r] * A1[r]; }
        ss += __shfl_xor(ss, 32);
        const float rinv = rsqrtf(ss * (1.0f / 64.0f) + EPS) * (1.0f - lam_init);
        const float* g = p.da_subln_g + l * 64;
        bf16_t* yp = Y + (size_t)row * 1024 + h * 64;
#pragma unroll
        for (int q = 0; q < 4; ++q) {
            const int d = 8 * q + 4 * hi;
            const f32x4 g0 = *(const f32x4*)(g + d), g1 = *(const f32x4*)(g + 32 + d);
            uint2 w0, w1;
            w0.x = pack2(A0[4 * q] * rinv * g0[0], A0[4 * q + 1] * rinv * g0[1]); w0.y = pack2(A0[4 * q + 2] * rinv * g0[2], A0[4 * q + 3] * rinv * g0[3]);
            w1.x = pack2(A1[4 * q] * rinv * g1[0], A1[4 * q + 1] * rinv * g1[1]); w1.y = pack2(A1[4 * q + 2] * rinv * g1[2], A1[4 * q + 3] * rinv * g1[3]);
            *(uint2*)(yp + d) = w0; *(uint2*)(yp + 32 + d) = w1;
        }
    } else {
        const int h = hh - 6;
        const bf16_t* VT = (const bf16_t*)(p.ws + WS_VMLAT) + ((size_t)(b * 6 + h) * 64) * NKEY;
        const size_t off = (size_t)(b * 6 + h) * NKEY * 96;
        f32x16 A0, A1; float la;
        attn_pass<96>((const bf16_t*)(p.ws + WS_QMLA) + off, (const bf16_t*)(p.ws + WS_KMLA) + off, VT, q0, nkt, sqrtf(ld_coh(kmx + 12 + h)), smem, A0, A1, la);
        const float ia = 1.0f / la;
        bf16_t* yp = Y + (size_t)row * 1024 + 384 + h * 64;
#pragma unroll
        for (int q = 0; q < 4; ++q) {
            const int d = 8 * q + 4 * hi;
            uint2 w0, w1;
            w0.x = pack2(A0[4 * q] * ia, A0[4 * q + 1] * ia); w0.y = pack2(A0[4 * q + 2] * ia, A0[4 * q + 3] * ia);
            w1.x = pack2(A1[4 * q] * ia, A1[4 * q + 1] * ia); w1.y = pack2(A1[4 * q + 2] * ia, A1[4 * q + 3] * ia);
            *(uint2*)(yp + d) = w0; *(uint2*)(yp + 32 + d) = w1;
        }
    }
}

constexpr int HG_QT = 0, HG_KT = 4352, HG_KH = 8704, HG_VT = 13824, HG_DD = 16384, HG_OSEG = 17408;
template <int MODE>
__device__ void hgrn_pass(const Params& p, int l, int dir, int b, int h, int g, char* smem) {
    const int tid = opaque_tid(), lane = tid & 63, wid = tid >> 6, c = lane & 15, gq = lane >> 4;
    int r0, sgn;
    if (dir == 0) { r0 = g == 0 ? T_LAT + b * 256 : b * 8192 + (g - 1) * 256; sgn = 1; }
    else { r0 = g == 0 ? T_LAT + b * 256 + 255 : b * 8192 + 8191 - (g - 1) * 256; sgn = -1; }
    const bf16_t* HG = (const bf16_t*)(p.ws + WS_HG);
    const int k = tid >> 1, hf = tid & 1;
    const float lbv = ((const float*)(p.ws + WS_LB))[(dir * 4 + l) * 512 + h * 128 + k];
    const float omlb = 1.0f - lbv;
    const int zoff = 512 + dir * 512 + h * 128 + k, qoff = h * 128 + k;
    bf16_t* QT = (bf16_t*)(smem + HG_QT); bf16_t* KT = (bf16_t*)(smem + HG_KT); bf16_t* KH = (bf16_t*)(smem + HG_KH); bf16_t* VT = (bf16_t*)(smem + HG_VT);
    float* DD = (float*)(smem + HG_DD); bf16_t* OSEG = (bf16_t*)(smem + HG_OSEG);
    const int chain = (dir * 4 + b) * 4 + h;
    float* sst = (float*)(p.ws + WS_SST) + (size_t)(chain * 33 + g) * 8192;
    f32x4 S[8];
#pragma unroll
    for (int kb = 0; kb < 8; ++kb)
#pragma unroll
        for (int r = 0; r < 4; ++r) S[kb][r] = (MODE == 0) ? 0.f : sst[(16 * kb + 4 * gq + r) * 64 + 16 * wid + c];
    float btot = 0.f;
    bf16_t zr0, zr1, zr2, zr3, zr4, zr5, zr6, zr7, qr0 = 0, qr1 = 0, qr2 = 0, qr3 = 0, qr4 = 0, qr5 = 0, qr6 = 0, qr7 = 0; uint2 vv;
    const int vt_t = tid >> 4, vt_v4 = (tid & 15) * 4;
#define HG_ROW(SC, T) ((size_t)(r0 + sgn * ((SC) * 16 + (T))) * 2048)
#define HG_PREFETCH(SC) { const bf16_t* zb_ = HG + zoff; \
        zr0 = zb_[HG_ROW(SC, hf * 8 + 0)]; zr1 = zb_[HG_ROW(SC, hf * 8 + 1)]; zr2 = zb_[HG_ROW(SC, hf * 8 + 2)]; zr3 = zb_[HG_ROW(SC, hf * 8 + 3)]; \
        zr4 = zb_[HG_ROW(SC, hf * 8 + 4)]; zr5 = zb_[HG_ROW(SC, hf * 8 + 5)]; zr6 = zb_[HG_ROW(SC, hf * 8 + 6)]; zr7 = zb_[HG_ROW(SC, hf * 8 + 7)]; \
        if (MODE != 0) { const bf16_t* qb_ = HG + qoff; \
        qr0 = qb_[HG_ROW(SC, hf * 8 + 0)]; qr1 = qb_[HG_ROW(SC, hf * 8 + 1)]; qr2 = qb_[HG_ROW(SC, hf * 8 + 2)]; qr3 = qb_[HG_ROW(SC, hf * 8 + 3)]; \
        qr4 = qb_[HG_ROW(SC, hf * 8 + 4)]; qr5 = qb_[HG_ROW(SC, hf * 8 + 5)]; qr6 = qb_[HG_ROW(SC, hf * 8 + 6)]; qr7 = qb_[HG_ROW(SC, hf * 8 + 7)]; } \
        vv = *(const uint2*)(HG + HG_ROW(SC, vt_t) + 1536 + h * 64 + vt_v4); }
    HG_PREFETCH(0);
    for (int sc = 0; sc < 16; ++sc) {
        float bt[8], ky[8], qv[8];
        {
            const bf16_t zz[8] = {zr0, zr1, zr2, zr3, zr4, zr5, zr6, zr7};
            const bf16_t qq[8] = {qr0, qr1, qr2, qr3, qr4, qr5, qr6, qr7};
            float cum = 0.f;
#pragma unroll
            for (int i = 0; i < 8; ++i) {
                const float z = bf2f(zz[i]);
                const float e = fexp(-z);
                const float sg = __builtin_amdgcn_rcpf(1.0f + e);
                const float f = lbv + omlb * sg;
                cum += __builtin_amdgcn_logf(fmaxf(f, 1e-30f)) * 0.6931471805599453f;
                bt[i] = cum; ky[i] = omlb * (1.0f - sg); qv[i] = bf2f(qq[i]);
            }
            const float other = __shfl_xor(cum, 1);
            const float blast = cum + other;
            const float add = hf ? other : 0.f;
#pragma unroll
            for (int i = 0; i < 8; ++i) {
                const int t = hf * 8 + i;
                const float b_ = bt[i] + add;
                if (MODE != 0) {
                    QT[t * 136 + k] = f2bf(qv[i] * fexp(b_));
                    KT[t * 136 + k] = f2bf(ky[i] * fexp(fminf(-b_, 80.f)));
                }
                KH[k * 20 + t] = f2bf(ky[i] * fexp(blast - b_));
            }
            if (hf == 0) DD[k] = fexp(blast);
            btot += blast;
            VT[(vt_v4 + 0) * 20 + vt_t] = (bf16_t)(vv.x & 0xffff); VT[(vt_v4 + 1) * 20 + vt_t] = (bf16_t)(vv.x >> 16);
            VT[(vt_v4 + 2) * 20 + vt_t] = (bf16_t)(vv.y & 0xffff); VT[(vt_v4 + 3) * 20 + vt_t] = (bf16_t)(vv.y >> 16);
        }
        __syncthreads();
        { const int scn = sc < 15 ? sc + 1 : 15; HG_PREFETCH(scn); }
        const uint2 vtu = *(const uint2*)(VT + (16 * wid + c) * 20 + 4 * gq);
        const bf16x8 vtf = MK8(vtu.x, vtu.y, 0u, 0u);
        if (MODE != 0) {
            f32x4 AT = {0.f, 0.f, 0.f, 0.f};
#pragma unroll
            for (int ks = 0; ks < 4; ++ks) {
                const bf16x8 a = *(const bf16x8*)(KT + c * 136 + ks * 32 + gq * 8);
                const bf16x8 bq = *(const bf16x8*)(QT + c * 136 + ks * 32 + gq * 8);
                AT = __builtin_amdgcn_mfma_f32_16x16x32_bf16(a, bq, AT, 0, 0, 0);
            }
#pragma unroll
            for (int r = 0; r < 4; ++r) if (4 * gq + r > c) AT[r] = 0.f;
            const bf16x8 pfv = MK8(pack2(AT[0], AT[1]), pack2(AT[2], AT[3]), 0u, 0u);
            f32x4 oT = {0.f, 0.f, 0.f, 0.f};
            oT = __builtin_amdgcn_mfma_f32_16x16x32_bf16(vtf, pfv, oT, 0, 0, 0);
#pragma unroll
            for (int u = 0; u < 4; ++u) {
                const bf16x8 sfv = MK8(pack2(S[2 * u][0], S[2 * u][1]), pack2(S[2 * u][2], S[2 * u][3]), pack2(S[2 * u + 1][0], S[2 * u + 1][1]), pack2(S[2 * u + 1][2], S[2 * u + 1][3]));
                const uint2 q0 = *(const uint2*)(QT + c * 136 + 32 * u + 4 * gq), q1 = *(const uint2*)(QT + c * 136 + 32 * u + 16 + 4 * gq);
                const bf16x8 qpv = MK8(q0.x, q0.y, q1.x, q1.y);
                oT = __builtin_amdgcn_mfma_f32_16x16x32_bf16(sfv, qpv, oT, 0, 0, 0);
            }
            const int pos = sc * 16 + c;
            const int ti = (MODE == 1) ? pos : 255 - pos;
            bf16_t* op = OSEG + ti * 68 + 16 * wid + 4 * gq;
            if (MODE == 2) {
                const uint2 old = *(const uint2*)op;
                oT[0] += __uint_as_float(old.x << 16); oT[1] += __uint_as_float(old.x & 0xffff0000u);
                oT[2] += __uint_as_float(old.y << 16); oT[3] += __uint_as_float(old.y & 0xffff0000u);
            }
            uint2 w; w.x = pack2(oT[0], oT[1]); w.y = pack2(oT[2], oT[3]);
            *(uint2*)op = w;
        }
#pragma unroll
        for (int kb = 0; kb < 8; ++kb) {
            const uint2 khu = *(const uint2*)(KH + (16 * kb + c) * 20 + 4 * gq);
            const bf16x8 kh = MK8(khu.x, khu.y, 0u, 0u);
            const f32x4 d4 = *(const f32x4*)(DD + 16 * kb + 4 * gq);
            S[kb] = __builtin_amdgcn_mfma_f32_16x16x32_bf16(kh, vtf, S[kb] * d4, 0, 0, 0);
        }
        __syncthreads();
    }
    if (MODE == 0) {
#pragma unroll
        for (int kb = 0; kb < 8; ++kb)
#pragma unroll
            for (int r = 0; r < 4; ++r) sst[(16 * kb + 4 * gq + r) * 64 + 16 * wid + c] = S[kb][r];
        if (hf == 0) ((float*)(p.ws + WS_DSEG))[(size_t)(chain * 33 + g) * 128 + k] = fexp(btot);
    }
#undef HG_ROW
#undef HG_PREFETCH
}

struct H1Pre { bf16_t z0, z1, z2, z3, z4, z5, z6, z7; uint2 vv; };
struct H1Ctx { int r0, sgn, zoff, hv, chain, g; float lbv, omlb, btot; f32x4 S[8]; };
__device__ void hgrn_h1_pair(const Params& p, int l, int b, int h, int g, char* smem) {
    const int tid = opaque_tid(), lane = tid & 63, wid = tid >> 6, c = lane & 15, gq = lane >> 4;
    const int k = tid >> 1, hf = tid & 1, vt_t = tid >> 4, vt_v4 = (tid & 15) * 4;
    const bf16_t* HG = (const bf16_t*)(p.ws + WS_HG);
    auto init = [&](H1Ctx& X, int dir) {
        if (dir == 0) { X.r0 = g == 0 ? T_LAT + b * 256 : b * 8192 + (g - 1) * 256; X.sgn = 1; }
        else { X.r0 = g == 0 ? T_LAT + b * 256 + 255 : b * 8192 + 8191 - (g - 1) * 256; X.sgn = -1; }
        X.lbv = ((const float*)(p.ws + WS_LB))[(dir * 4 + l) * 512 + h * 128 + k]; X.omlb = 1.0f - X.lbv;
        X.zoff = 512 + dir * 512 + h * 128 + k; X.hv = 1536 + h * 64 + vt_v4; X.chain = (dir * 4 + b) * 4 + h; X.g = g; X.btot = 0.f;
#pragma unroll
        for (int kb = 0; kb < 8; ++kb) X.S[kb] = (f32x4){0.f, 0.f, 0.f, 0.f};
    };
    auto prefetch = [&](const H1Ctx& X, H1Pre& R, int sc) {
        const bf16_t* zb = HG + X.zoff;
#define H1_ROW(T) ((size_t)(X.r0 + X.sgn * (sc * 16 + (T))) * 2048)
        R.z0 = zb[H1_ROW(hf * 8 + 0)]; R.z1 = zb[H1_ROW(hf * 8 + 1)]; R.z2 = zb[H1_ROW(hf * 8 + 2)]; R.z3 = zb[H1_ROW(hf * 8 + 3)];
        R.z4 = zb[H1_ROW(hf * 8 + 4)]; R.z5 = zb[H1_ROW(hf * 8 + 5)]; R.z6 = zb[H1_ROW(hf * 8 + 6)]; R.z7 = zb[H1_ROW(hf * 8 + 7)];
        R.vv = *(const uint2*)(HG + H1_ROW(vt_t) + X.hv);
#undef H1_ROW
    };
    auto elem = [&](H1Ctx& X, const H1Pre& R, char* sm) {
        bf16_t* KH = (bf16_t*)(sm + HG_KH); bf16_t* VT = (bf16_t*)(sm + HG_VT); float* DD = (float*)(sm + HG_DD);
        const bf16_t zz[8] = {R.z0, R.z1, R.z2, R.z3, R.z4, R.z5, R.z6, R.z7};
        float bt[8], ky[8]; float cum = 0.f;
#pragma unroll
        for (int i = 0; i < 8; ++i) {
            const float e = fexp(-bf2f(zz[i]));
            const float sg = __builtin_amdgcn_rcpf(1.0f + e);
            cum += __builtin_amdgcn_logf(fmaxf(X.lbv + X.omlb * sg, 1e-30f)) * 0.6931471805599453f;
            bt[i] = cum; ky[i] = X.omlb * (1.0f - sg);
        }
        const float other = __shfl_xor(cum, 1);
        const float blast = cum + other, add = hf ? other : 0.f;
#pragma unroll
        for (int i = 0; i < 8; ++i) KH[k * 20 + hf * 8 + i] = f2bf(ky[i] * fexp(blast - (bt[i] + add)));
        if (hf == 0) DD[k] = fexp(blast);
        X.btot += blast;
        VT[(vt_v4 + 0) * 20 + vt_t] = (bf16_t)(R.vv.x & 0xffff); VT[(vt_v4 + 1) * 20 + vt_t] = (bf16_t)(R.vv.x >> 16);
        VT[(vt_v4 + 2) * 20 + vt_t] = (bf16_t)(R.vv.y & 0xffff); VT[(vt_v4 + 3) * 20 + vt_t] = (bf16_t)(R.vv.y >> 16);
    };
    auto update = [&](H1Ctx& X, const char* sm) {
        const bf16_t* KH = (const bf16_t*)(sm + HG_KH); const bf16_t* VT = (const bf16_t*)(sm + HG_VT); const float* DD = (const float*)(sm + HG_DD);
        const uint2 vtu = *(const uint2*)(VT + (16 * wid + c) * 20 + 4 * gq);
        const bf16x8 vtf = MK8(vtu.x, vtu.y, 0u, 0u);
#pragma unroll
        for (int kb = 0; kb < 8; ++kb) {
            const uint2 khu = *(const uint2*)(KH + (16 * kb + c) * 20 + 4 * gq);
            const f32x4 d4 = *(const f32x4*)(DD + 16 * kb + 4 * gq);
            X.S[kb] = __builtin_amdgcn_mfma_f32_16x16x32_bf16(MK8(khu.x, khu.y, 0u, 0u), vtf, X.S[kb] * d4, 0, 0, 0);
        }
    };
    auto store = [&](H1Ctx& X) {
        float* sst = (float*)(p.ws + WS_SST) + (size_t)(X.chain * 33 + X.g) * 8192;
#pragma unroll
        for (int kb = 0; kb < 8; ++kb)
#pragma unroll
            for (int r = 0; r < 4; ++r) sst[(16 * kb + 4 * gq + r) * 64 + 16 * wid + c] = X.S[kb][r];
        if (hf == 0) ((float*)(p.ws + WS_DSEG))[(size_t)(X.chain * 33 + X.g) * 128 + k] = fexp(X.btot);
    };
    H1Ctx A, B; H1Pre A0, A1, B0, B1;
    init(A, 0); init(B, 1);
    prefetch(A, A0, 0); prefetch(B, B0, 0); prefetch(A, A1, 1); prefetch(B, B1, 1);
    for (int sc = 0; sc < 16; sc += 2) {
        elem(A, A0, smem); elem(B, B0, smem + 17408);
        __syncthreads();
        { const int scn = sc + 2 < 16 ? sc + 2 : 15; prefetch(A, A0, scn); prefetch(B, B0, scn); }
        update(A, smem); update(B, smem + 17408);
        __syncthreads();
        elem(A, A1, smem); elem(B, B1, smem + 17408);
        __syncthreads();
        { const int scn = sc + 3 < 16 ? sc + 3 : 15; prefetch(A, A1, scn); prefetch(B, B1, scn); }
        update(A, smem); update(B, smem + 17408);
        __syncthreads();
    }
    store(A); store(B);
}
__device__ void hgrn3_unit(const Params& p, int l, int u, char* smem) {
    const int tb = u % 33, bh = u / 33, h = bh & 3, b = bh >> 2;
    hgrn_pass<1>(p, l, 0, b, h, tb, smem);
    hgrn_pass<2>(p, l, 1, b, h, tb == 0 ? 0 : 33 - tb, smem);
    const int ti = opaque_tid();
    const int row = tb == 0 ? T_LAT + b * 256 + ti : b * 8192 + (tb - 1) * 256 + ti;
    const bf16_t* OSEG = (const bf16_t*)(smem + HG_OSEG) + ti * 68;
    const bf16_t* gp = (const bf16_t*)(p.ws + WS_HG) + (size_t)row * 2048 + 1792 + h * 64;
    const float* gn = p.hg_norm_g + l * 64;
    bf16_t* yp = (bf16_t*)(p.ws + WS_H) + (size_t)row * 1024 + 768 + h * 64;
    float ss = 0.f;
#pragma unroll
    for (int q = 0; q < 16; ++q) {
        const uint2 w = *(const uint2*)(OSEG + q * 4);
        const float a0 = __uint_as_float(w.x << 16), a1 = __uint_as_float(w.x & 0xffff0000u), a2 = __uint_as_float(w.y << 16), a3 = __uint_as_float(w.y & 0xffff0000u);
        ss += a0 * a0 + a1 * a1 + a2 * a2 + a3 * a3;
    }
    const float rinv = rsqrtf(ss * (1.0f / 64.0f) + EPS);
#pragma unroll
    for (int q = 0; q < 16; ++q) {
        const uint2 w = *(const uint2*)(OSEG + q * 4);
        const uint2 gw = *(const uint2*)(gp + q * 4);
        float o[4] = {__uint_as_float(w.x << 16), __uint_as_float(w.x & 0xffff0000u), __uint_as_float(w.y << 16), __uint_as_float(w.y & 0xffff0000u)};
        const float gt[4] = {__uint_as_float(gw.x << 16), __uint_as_float(gw.x & 0xffff0000u), __uint_as_float(gw.y << 16), __uint_as_float(gw.y & 0xffff0000u)};
#pragma unroll
        for (int j = 0; j < 4; ++j) { const float sl = gt[j] / (1.0f + fexp(-gt[j])); o[j] = o[j] * rinv * gn[q * 4 + j] * sl; }
        uint2 ow; ow.x = pack2(o[0], o[1]); ow.y = pack2(o[2], o[3]);
        *(uint2*)(yp + q * 4) = ow;
    }
    __syncthreads();
}

__device__ void convert_T(const float* in, int K, int Nin, bf16_t* out, int Nout, int mode, const float* gs, size_t gtid, size_t gthreads) {
    const size_t total = (size_t)Nout * (K / 8);
    for (size_t idx = gtid; idx < total; idx += gthreads) {
        const int n = (int)(idx % Nout), k8 = (int)(idx / Nout);
        int src = n;
        if (mode == 1) {
            if (n < 1536) src = n; else if (n < 3584) src = n + 32; else if (n < 3616) src = n - 3584 + 1536; else src = -1;
        } else if (mode == 2) {
            const int hh = n >> 7, d = n & 127; src = d < 96 ? hh * 96 + d : -1;
        }
        float v[8];
#pragma unroll
        for (int j = 0; j < 8; ++j) {
            const int k = k8 * 8 + j;
            v[j] = src >= 0 ? in[(size_t)k * Nin + src] * (gs ? gs[k] : 1.0f) : 0.f;
        }
        uint4 w; w.x = pack2(v[0], v[1]); w.y = pack2(v[2], v[3]); w.z = pack2(v[4], v[5]); w.w = pack2(v[6], v[7]);
        *(uint4*)(out + (size_t)n * K + k8 * 8) = w;
    }
}
__device__ void convert_layer(const Params& p, int l, size_t gtid, size_t gthreads) {
    convert_T(p.w_in + (size_t)l * 1024 * 3616, 1024, 3616, (bf16_t*)(p.ws + WS_WIN), NIN, 1, nullptr, gtid, gthreads);
    convert_T(p.w_out + (size_t)l * 1024 * 1024, 1024, 1024, (bf16_t*)(p.ws + WS_WOUT), 1024, 0, nullptr, gtid, gthreads);
    convert_T(p.w_ff1 + (size_t)l * 1024 * 4096, 1024, 4096, (bf16_t*)(p.ws + WS_WFF1), 4096, 0, nullptr, gtid, gthreads);
    convert_T(p.w_ff2 + (size_t)l * 4096 * 1024, 4096, 1024, (bf16_t*)(p.ws + WS_WFF2), 1024, 0, nullptr, gtid, gthreads);
    convert_T(p.w_uq + (size_t)l * 256 * 576, 256, 576, (bf16_t*)(p.ws + WS_WUQ), 768, 2, p.g_cq + l * 256, gtid, gthreads);
    convert_T(p.w_ukv + (size_t)l * 128 * 768, 128, 768, (bf16_t*)(p.ws + WS_WUKV), 768, 0, p.g_ckv + l * 128, gtid, gthreads);
}
__device__ void adaln_phase(const Params& p, int l, const float* g, int shift_off, int scale_off, int nrows) {
    const int lane = opaque_tid() & 63;
    const int gw = blockIdx.x * 4 + (threadIdx.x >> 6), nw = gridDim.x * 4;
    bf16_t* H = (bf16_t*)(p.ws + WS_H);
    const bool from_input = (l == 0 && shift_off == 0);
    f32x4 v0, v1, v2, v3, n0, n1, n2, n3;
    v0 = v1 = v2 = v3 = n0 = n1 = n2 = n3 = (f32x4){0.f, 0.f, 0.f, 0.f};
    if (gw < nrows) { const float* xp = (from_input ? xrow_in(p, gw) : xrow(p, gw)) + lane * 4; v0 = *(const f32x4*)(xp); v1 = *(const f32x4*)(xp + 256); v2 = *(const f32x4*)(xp + 512); v3 = *(const f32x4*)(xp + 768); }
    for (int row = gw; row < nrows; row += nw) {
        const int nrow = row + nw;
        if (nrow < nrows) { const float* xp = (from_input ? xrow_in(p, nrow) : xrow(p, nrow)) + lane * 4; n0 = *(const f32x4*)(xp); n1 = *(const f32x4*)(xp + 256); n2 = *(const f32x4*)(xp + 512); n3 = *(const f32x4*)(xp + 768); }
        int b, key; bool lat; row_bk(row, b, key, lat);
        const float* md = (const float*)(p.ws + WS_MOD) + (size_t)(l * 5 + (lat ? b : 4)) * 6144;
        const f32x4 v[4] = {v0, v1, v2, v3};
        float ss = 0.f;
#pragma unroll
        for (int i = 0; i < 4; ++i) ss += v[i][0] * v[i][0] + v[i][1] * v[i][1] + v[i][2] * v[i][2] + v[i][3] * v[i][3];
#pragma unroll
        for (int o = 32; o >= 1; o >>= 1) ss += __shfl_xor(ss, o);
        const float rinv = rsqrtf(ss * (1.0f / 1024.0f) + EPS);
#pragma unroll
        for (int i = 0; i < 4; ++i) {
            const int d = i * 256 + lane * 4;
            const f32x4 gg = *(const f32x4*)(g + d), sh = *(const f32x4*)(md + shift_off + d), sc = *(const f32x4*)(md + scale_off + d);
            float o[4];
#pragma unroll
            for (int j = 0; j < 4; ++j) o[j] = v[i][j] * rinv * gg[j] * (1.0f + sc[j]) + sh[j];
            uint2 w; w.x = pack2(o[0], o[1]); w.y = pack2(o[2], o[3]);
            *(uint2*)(H + (size_t)row * 1024 + d) = w;
        }
        v0 = n0; v1 = n1; v2 = n2; v3 = n3;
    }
}
__device__ void phase0(const Params& p, char* smem) {
    const size_t gtid = (size_t)blockIdx.x * 256 + threadIdx.x, gthreads = (size_t)gridDim.x * 256;
    const int tid = opaque_tid();
    if (gtid < 2 * 512) {
        const int dir = (int)gtid >> 9, cidx = (int)gtid & 511;
        float e[4], mx = -1e30f, s = 0.f;
#pragma unroll
        for (int l = 0; l < 4; ++l) { e[l] = p.hg_lb[(dir * 4 + l) * 512 + cidx]; mx = fmaxf(mx, e[l]); }
#pragma unroll
        for (int l = 0; l < 4; ++l) { e[l] = expf(e[l] - mx); s += e[l]; }
        float cum = 0.f;
#pragma unroll
        for (int l = 0; l < 4; ++l) { if (l > 0) cum += e[l] / s; ((float*)(p.ws + WS_LB))[(dir * 4 + l) * 512 + cidx] = cum; }
    }
    if (gtid >= 1024 && gtid < 1024 + 1024) {
        const int i = (int)gtid - 1024, pos = i >> 3, f = i & 7;
        const float inv = powf(10000.0f, -(float)f / 8.0f);
        const float ang = (float)pos * inv;
        ((float*)(p.ws + WS_ROPE))[i * 2] = cosf(ang); ((float*)(p.ws + WS_ROPE))[i * 2 + 1] = sinf(ang);
    }
    if (gtid >= 2048 && gtid < 2048 + 4) {
        const int l = (int)gtid - 2048;
        float s1 = 0.f, s2 = 0.f;
        for (int i = 0; i < 32; ++i) { s1 += p.da_lambda[(l * 4 + 0) * 32 + i] * p.da_lambda[(l * 4 + 1) * 32 + i]; s2 += p.da_lambda[(l * 4 + 2) * 32 + i] * p.da_lambda[(l * 4 + 3) * 32 + i]; }
        ((float*)(p.ws + WS_LAM))[l] = expf(s1) - expf(s2) + (0.8f - 0.6f * expf(-0.3f * (float)l));
    }
    if (gtid >= 4096 && gtid < 4096 + 512) ((unsigned*)(p.ws + WS_KMAX))[gtid - 4096] = 0u;
    float* sl = (float*)smem;
    float* red = sl + 5 * 1024;
    for (int i = tid; i < 5 * 1024; i += 256) {
        const int r = i >> 10, d = i & 1023;
        const float cv = r < 4 ? p.c[r * 1024 + d] : p.c_ctx[d];
        sl[i] = cv / (1.0f + expf(-cv));
    }
    __syncthreads();
    for (int u = blockIdx.x; u < 4 * 96; u += gridDim.x) {
        const int l = u / 96, cb = u % 96, col = tid & 63, kg = tid >> 6;
        const float* w = p.w_mod + (size_t)l * 1024 * 6144 + cb * 64 + col;
        float a[5] = {0.f, 0.f, 0.f, 0.f, 0.f};
        for (int d = kg * 256; d < kg * 256 + 256; ++d) {
            const float wv = w[(size_t)d * 6144];
#pragma unroll
            for (int r = 0; r < 5; ++r) a[r] += sl[r * 1024 + d] * wv;
        }
#pragma unroll
        for (int r = 0; r < 5; ++r) red[(kg * 5 + r) * 64 + col] = a[r];
        __syncthreads();
        if (tid < 64) {
#pragma unroll
            for (int r = 0; r < 5; ++r) {
                const float s = red[(0 * 5 + r) * 64 + tid] + red[(1 * 5 + r) * 64 + tid] + red[(2 * 5 + r) * 64 + tid] + red[(3 * 5 + r) * 64 + tid];
                ((float*)(p.ws + WS_MOD))[(size_t)(l * 5 + r) * 6144 + cb * 64 + tid] = s + p.b_mod[l * 6144 + cb * 64 + tid];
            }
        }
        __syncthreads();
    }
}
__device__ void hgrn_scan(const Params& p) {
    const size_t gtid = (size_t)blockIdx.x * 256 + opaque_tid(), gthreads = (size_t)gridDim.x * 256;
    float* sstb = (float*)(p.ws + WS_SST);
    const float* dseg = (const float*)(p.ws + WS_DSEG);
    for (size_t i = gtid; i < (size_t)32 * 8192; i += gthreads) {
        const int chain = (int)(i >> 13), e = (int)(i & 8191), k = e >> 6;
        float S = 0.f;
        float* sp = sstb + (size_t)chain * 33 * 8192 + e;
        const float* dp = dseg + (size_t)chain * 33 * 128 + k;
#pragma unroll 1
        for (int g0 = 0; g0 < 33; g0 += 11) {
            float t[11], d[11];
#pragma unroll
            for (int q = 0; q < 11; ++q) { t[q] = sp[(size_t)(g0 + q) * 8192]; d[q] = dp[(g0 + q) * 128]; }
#pragma unroll
            for (int q = 0; q < 11; ++q) { sp[(size_t)(g0 + q) * 8192] = S; S = d[q] * S + t[q]; }
        }
    }
}
__device__ void final_norm(const Params& p) {
    const int lane = opaque_tid() & 63;
    const int gw = blockIdx.x * 4 + (threadIdx.x >> 6), nw = gridDim.x * 4;
    for (int row = gw; row < T_LAT; row += nw) {
        float* xp = p.out + (size_t)row * 1024;
        f32x4 v[4]; float ss = 0.f;
#pragma unroll
        for (int i = 0; i < 4; ++i) { v[i] = *(const f32x4*)(xp + i * 256 + lane * 4); ss += v[i][0] * v[i][0] + v[i][1] * v[i][1] + v[i][2] * v[i][2] + v[i][3] * v[i][3]; }
#pragma unroll
        for (int o = 32; o >= 1; o >>= 1) ss += __shfl_xor(ss, o);
        const float rinv = rsqrtf(ss * (1.0f / 1024.0f) + EPS);
#pragma unroll
        for (int i = 0; i < 4; ++i) {
            const f32x4 gg = *(const f32x4*)(p.g_final + i * 256 + lane * 4);
            f32x4 o;
#pragma unroll
            for (int j = 0; j < 4; ++j) o[j] = v[i][j] * rinv * gg[j];
            *(f32x4*)(xp + i * 256 + lane * 4) = o;
        }
    }
}


#define XB_TMO      128
#define XB_XCNT(j)  (256  + 64 * (j))
#define XB_XSUB(j)  (1280 + 64 * (j))
#define XB_XGEN(j)  (2304 + 64 * (j))
#define XB_TOP      3328
#define XB_TOPGEN   3392
#define XCD_BAR_WORDS 3456
#define XB_SPIN_CAP (1u << 22)
__device__ __forceinline__ unsigned xb_ld(unsigned* p)              { return __hip_atomic_load(p, __ATOMIC_RELAXED, __HIP_MEMORY_SCOPE_AGENT); }
__device__ __forceinline__ unsigned xb_add(unsigned* p, unsigned v) { return __hip_atomic_fetch_add(p, v, __ATOMIC_RELAXED, __HIP_MEMORY_SCOPE_AGENT); }
__device__ __forceinline__ unsigned xb_xcc_id() { return (unsigned)__builtin_amdgcn_s_getreg((3 << 11) | 20) & 0xFu; }
#define XB_SPIN(cond, bar) do { unsigned _sp = 0; while (cond) { __builtin_amdgcn_s_sleep(1); \
    if ((++_sp & 255u) == 0u) { if (xb_ld(&(bar)[XB_TMO])) break; if (_sp > XB_SPIN_CAP) { atomicAdd(&(bar)[XB_TMO], 1u); break; } } } } while (0)
__device__ __forceinline__ void xcd_barrier_complete(unsigned* bar, unsigned x, unsigned& nloc, unsigned& nx) {
    const unsigned G = gridDim.x;
    unsigned sum, cnt, mine, sp = 0u;
    for (;;) {
        sum = 0u; cnt = 0u; mine = 0u;
#pragma unroll
        for (unsigned j = 0; j < 16; ++j) { const unsigned c = xb_ld(&bar[XB_XCNT(j)]); sum += c; cnt += (c > 0u) ? 1u : 0u; mine = (j == x) ? c : mine; }
        if (sum == G) break;
        __builtin_amdgcn_s_sleep(1);
        if ((++sp & 255u) == 0u) { if (xb_ld(&bar[XB_TMO])) break; if (sp > XB_SPIN_CAP) { atomicAdd(&bar[XB_TMO], 1u); break; } }
    }
    nloc = mine > 0u ? mine : 1u; nx = cnt > 0u ? cnt : 1u;
}
__device__ __forceinline__ void gsync(char* ws, unsigned& epoch) {
    asm volatile("s_waitcnt vmcnt(0) lgkmcnt(0)" ::: "memory");
    __syncthreads();
    ++epoch;
    if (threadIdx.x == 0) {
        extern __shared__ __attribute__((aligned(16))) char smem_[];
        volatile unsigned* st = (volatile unsigned*)(smem_ + 73728 + 768);
        unsigned* bar = (unsigned*)(ws + WS_XBAR);
        const unsigned x = xb_xcc_id();
        __builtin_amdgcn_s_waitcnt(0);
        unsigned nloc = st[0], nx = st[1];
        if (nloc == 0u) { xcd_barrier_complete(bar, x, nloc, nx); st[0] = nloc; st[1] = nx; }
        const unsigned old = xb_add(&bar[XB_XSUB(x)], 1u);
        const unsigned gen = old / nloc;
        if (old + 1u == (gen + 1u) * nloc) {
            __builtin_amdgcn_fence(__ATOMIC_RELEASE, "agent");
            asm volatile("s_waitcnt vmcnt(0)" ::: "memory");
            const unsigned og = xb_add(&bar[XB_TOP], 1u);
            const unsigned tg = og / nx;
            if (og + 1u == (tg + 1u) * nx) xb_add(&bar[XB_TOPGEN], 1u);
            else XB_SPIN(xb_ld(&bar[XB_TOPGEN]) == tg, bar);
            __builtin_amdgcn_fence(__ATOMIC_ACQUIRE, "agent");
            xb_add(&bar[XB_XGEN(x)], 1u);
            asm volatile("s_waitcnt vmcnt(0)" ::: "memory");
        } else {
            XB_SPIN(xb_ld(&bar[XB_XGEN(x)]) == gen, bar);
            __builtin_amdgcn_fence(__ATOMIC_ACQUIRE, "agent");
            asm volatile("s_waitcnt vmcnt(0)" ::: "memory");
        }
    }
    __syncthreads();
}

__device__ __forceinline__ int next_unit(char* ws, int qidx, char* smem) {
    int* sh = (int*)(smem + 73728 + 512);
    __syncthreads();
    if (threadIdx.x == 0) *sh = (int)__hip_atomic_fetch_add((unsigned*)(ws + WS_BAR + 32) + qidx, 1u, __ATOMIC_RELAXED, __HIP_MEMORY_SCOPE_AGENT);
    __syncthreads();
    return *sh;
}

__device__ __forceinline__ bool tile_of(int r, int nt, int total, int& tm, int& tn, int G = 8) {
    const int bx = blockIdx.x, nx = gridDim.x >> 3;
    const int L = (r * 8 + (bx & 7)) * nx + (bx >> 3);
    if (L >= total || nx != 64) { if (nx == 64) return false; const int u = bx + r * gridDim.x; if (u >= total) return false; tm = u / nt; tn = u % nt; return true; }
    const int mg = L / (nt * G), rem = L % (nt * G);
    tn = rem / G; tm = mg * G + (rem % G);
    return true;
}
__device__ __forceinline__ Params launder(const Params& p) {
    Params q = p;
    GAS char* w = (GAS char*)p.ws; GAS float* o = (GAS float*)p.out;
    asm volatile("" : "+s"(w), "+s"(o));
    q.ws = (char*)w; q.out = (float*)o;
    return q;
}
__global__ void __launch_bounds__(256, 2) fwd_megakernel(Params p0) {
    extern __shared__ __attribute__((aligned(16))) char smem[];
    cg::grid_group grid = cg::this_grid();
    const size_t gtid = (size_t)blockIdx.x * 256 + threadIdx.x, gthreads = (size_t)gridDim.x * 256;
    float* rs = (float*)(smem + 73728);
    unsigned epoch = 0;
    if (threadIdx.x == 0) { volatile unsigned* st = (volatile unsigned*)(smem + 73728 + 768); st[0] = 0u; st[1] = 0u; (void)xb_add((unsigned*)(p0.ws + WS_XBAR) + XB_XCNT(xb_xcc_id()), 1u); }
    __syncthreads();
    grid.sync();

#ifndef OPK
#define OPK 1024
#define OPK0 0
#endif
#ifndef REP_SKIP_ATT
#define REP_SKIP_ATT 0
#endif
#ifndef REP_B
#define REP_B 1
#endif
#ifndef REP_D
#define REP_D 1
#endif
#ifndef REP_E
#define REP_E 1
#endif
#ifndef REP_H
#define REP_H 1
#endif
#ifndef PM
#define PM 0xffff
#endif
    { const Params p = launder(p0); if (PM & 1) phase0(p, smem); }
    { const Params p = launder(p0); if (PM & 2) convert_layer(p, 0, gtid, gthreads); }
    gsync(p0.ws, epoch);

    for (int l = 0; l < 4; ++l) {
        const bool last = (l == 3);
        { const Params p = launder(p0); if (PM & 4) adaln_phase(p, l, p.g_mix + l * 1024, 0, 1024, T_ALL); }
        { const Params p = launder(p0); if ((PM & 2) && l > 0) convert_layer(p, l, gtid, gthreads); }
        gsync(p0.ws, epoch);
        if (PM & 8) for (int rr = 0;; ++rr) {
            int tm, tn; if (!tile_of(rr, 29, 132 * 29, tm, tn, 4)) break;
            const Params p = launder(p0);
            Acc2 C;
            gemm_tile_core2((const bf16_t*)(p.ws + WS_H) + (size_t)tm * 256 * 1024, 1024, (const bf16_t*)(p.ws + WS_WIN) + (size_t)tn * 128 * 1024, 1024, 1024, smem, C);
            gemm2_stage(C, 0, smem);
            epi_inproj(p, l, tm * 256, tn, (const float*)smem);
            __syncthreads();
            gemm2_stage(C, 1, smem);
            epi_inproj(p, l, tm * 256 + 128, tn, (const float*)smem);
            __syncthreads();
        }
        gsync(p0.ws, epoch);
        for (int rep = 0; rep < REP_D; ++rep) { if (rep) gsync(p0.ws, epoch);
        for (;;) {
            const int u = next_unit(p0.ws, l * 2 + 0 + rep * 8, smem);
            if (u >= 528 + 2 * 1584) break;
            const Params p = launder(p0);
            if (u < 528) { if (PM & 16) {
                const int g = u % 33, ch = u / 33, h = ch & 3, b = (ch >> 2) & 3;
                hgrn_h1_pair(p, l, b, h, g, smem); }
            } else if (!(PM & 32)) {} else if (u < 528 + 1584) {
                const int v = u - 528, tm = v / 6, h = v % 6;
                row_rstd(p, 0, tm * 128, rs);
                gemm_tile_core((const bf16_t*)(p.ws + WS_CQ) + (size_t)tm * 128 * 256, 256, (const bf16_t*)(p.ws + WS_WUQ) + (size_t)h * 128 * 256, 256, 256, smem);
                epi_uq(p, tm * 128, h, (const float*)smem, rs);
                __syncthreads();
            } else {
                const int v = u - 528 - 1584, tm = v / 6, h = v % 6;
                row_rstd(p, 1, tm * 128, rs);
                gemm_tile_core((const bf16_t*)(p.ws + WS_CKV) + (size_t)tm * 128 * 128, 128, (const bf16_t*)(p.ws + WS_WUKV) + (size_t)h * 128 * 128, 128, 128, smem);
                epi_ukv(p, l, tm * 128, h, (const float*)smem, rs);
                __syncthreads();
            }
        } }
        gsync(p0.ws, epoch);
        { const Params p = launder(p0); if (PM & 64) hgrn_scan(p); }
        gsync(p0.ws, epoch);
        {
            { int* st2 = (int*)(smem + 73728 + 520); __syncthreads(); if (threadIdx.x == 0) { st2[0] = 0; } }
            for (;;) {
                    int* sh = (int*)(smem + 73728 + 512);
                    __syncthreads();
                    if (threadIdx.x == 0) {
                        const int qlen_ = 450 + (l == 3 ? 0 : 12);
                        const unsigned xq_ = xb_xcc_id() & 7u;
                        int dq_ = sh[2], got = -1, qq = 0;
                        while (dq_ < 8) {
                            qq = (int)((xq_ + dq_) & 7u);
                            const int v = (int)__hip_atomic_fetch_add((unsigned*)(p0.ws + WS_XBAR) + l * 8 + qq, 1u, __ATOMIC_RELAXED, __HIP_MEMORY_SCOPE_AGENT);
                            if (v < qlen_) { got = v; break; }
                            ++dq_;
                        }
                        sh[2] = dq_; sh[0] = got; sh[1] = qq;
                    }
                    __syncthreads();
                    const int i = __builtin_amdgcn_readfirstlane(sh[0]), q = __builtin_amdgcn_readfirstlane(sh[1]);
                    if (i < 0) break;
                    const Params p = launder(p0);
                    const int nh3 = (i + 2) / 3 < 66 ? (i + 2) / 3 : 66;
                    if (i < 450 && i % 3 == 0 && i / 3 < 66) { if (PM & 256) hgrn3_unit(p, l, q * 66 + i / 3, smem); }
                    else {
                        int b, hh, qbi;
                        if (i < 450) { const int a = i - nh3; const int bh = q + 8 * (a >> 6); qbi = a & 63; b = (bh / 6) & 3; hh = (bh >= 24 ? 6 : 0) + bh % 6; }
                        else { const int cidx = q * 12 + (i - 450); qbi = 64 + (cidx & 1); const int bh = cidx >> 1; hh = bh % 12; b = bh / 12; }
                        if (PM & 128) attn_unit(p, l, b, hh, qbi, smem);
                    }
            }
        }
        gsync(p0.ws, epoch);
        const int ntm = last ? 256 : 264;
        if (PM & 512) for (int rr = 0;; ++rr) {
            int tm, tn; if (!tile_of(rr, 8, ntm * 8, tm, tn)) break;
            const Params p = launder(p0);
            gemm_tile_core((const bf16_t*)(p.ws + WS_H) + (size_t)tm * 128 * 1024 + OPK0, 1024, (const bf16_t*)(p.ws + WS_WOUT) + (size_t)tn * 128 * 1024 + OPK0, 1024, OPK, smem);
            epi_resid(p, l, tm * 128, tn * 128, 2 * 1024, (const float*)smem);
            __syncthreads();
        }
        gsync(p0.ws, epoch);
        { const Params p = launder(p0); adaln_phase(p, l, p.g_mlp + l * 1024, 3 * 1024, 4 * 1024, ntm * 128); }
        gsync(p0.ws, epoch);
        if (PM & 1024) for (int rr = 0;; ++rr) {
            int tm, tn; if (!tile_of(rr, 32, (ntm / 2) * 32, tm, tn, 4)) break;
            const Params p = launder(p0);
            Acc2 C;
            gemm_tile_core2((const bf16_t*)(p.ws + WS_H) + (size_t)tm * 256 * 1024, 1024, (const bf16_t*)(p.ws + WS_WFF1) + (size_t)tn * 128 * 1024, 1024, 1024, smem, C);
            gemm2_stage(C, 0, smem);
            epi_ff1(p, tm * 256, tn * 128, (const float*)smem);
            __syncthreads();
            gemm2_stage(C, 1, smem);
            epi_ff1(p, tm * 256 + 128, tn * 128, (const float*)smem);
            __syncthreads();
        }
        gsync(p0.ws, epoch);
        if (PM & 2048) for (int rr = 0;; ++rr) {
            int tm, tn; if (!tile_of(rr, 8, ntm * 8, tm, tn)) break;
            const Params p = launder(p0);
            gemm_tile_core((const bf16_t*)(p.ws + WS_H1) + (size_t)tm * 128 * 4096, 4096, (const bf16_t*)(p.ws + WS_WFF2) + (size_t)tn * 128 * 4096, 4096, 4096, smem);
            epi_resid(p, l, tm * 128, tn * 128, 5 * 1024, (const float*)smem);
            __syncthreads();
        }
        gsync(p0.ws, epoch);
    }
    { const Params p = launder(p0); final_norm(p); }
}

extern "C" void kernel_launch(void* const* d_in, const int* in_sizes, int n_in, void* d_out, int out_size, void* d_ws, size_t ws_size, hipStream_t stream) {
    static int grid_blocks = 0;
    if (!grid_blocks) {
        int dev = 0, cus = 0, per_cu = 0;
        hipGetDevice(&dev);
        hipDeviceGetAttribute(&cus, hipDeviceAttributeMultiprocessorCount, dev);
        hipFuncSetAttribute((const void*)fwd_megakernel, hipFuncAttributeMaxDynamicSharedMemorySize, SMEM_BYTES);
        hipOccupancyMaxActiveBlocksPerMultiprocessor(&per_cu, (const void*)fwd_megakernel, 256, SMEM_BYTES);
        if (per_cu < 1) per_cu = 1;
        if (per_cu > 2) per_cu = 2;
        grid_blocks = cus * per_cu;
        if (ws_size < WS_END2) fprintf(stderr, "workspace too small: %zu < %zu\n", ws_size, (size_t)WS_END2);
    }
    hipMemsetAsync((char*)d_ws + WS_BAR, 0, 128, stream);
    hipMemsetAsync((char*)d_ws + WS_XBAR, 0, XCD_BAR_WORDS * 4, stream);
    Params p{};
    const float** pp = (const float**)&p;
    for (int i = 0; i < 21; ++i) pp[i] = (const float*)d_in[i];
    p.out = (float*)d_out; p.ws = (char*)d_ws;
    void* args[] = {&p};
    hipError_t e = hipLaunchCooperativeKernel((const void*)fwd_megakernel, dim3(grid_blocks), dim3(256), args, SMEM_BYTES, stream);
    if (e != hipSuccess) fprintf(stderr, "cooperative launch failed: %s (grid %d)\n", hipGetErrorString(e), grid_blocks);
}
```

```cpp
#include <hip/hip_runtime.h>
#include <hip/hip_cooperative_groups.h>
#include <stdint.h>
#include <cstdio>
namespace cg = cooperative_groups;

#define GAS __attribute__((address_space(1)))
typedef unsigned short bf16_t;
typedef short bf16x8 __attribute__((ext_vector_type(8)));
typedef short bf16x4 __attribute__((ext_vector_type(4)));
typedef float f32x16 __attribute__((ext_vector_type(16)));
typedef float f32x4 __attribute__((ext_vector_type(4)));
typedef unsigned u32x4 __attribute__((ext_vector_type(4)));
typedef unsigned u32x2 __attribute__((ext_vector_type(2)));
#define MK8(a,b,c,d) __builtin_bit_cast(bf16x8, (u32x4){(a),(b),(c),(d)})
#define MK4(a,b) __builtin_bit_cast(bf16x4, (u32x2){(a),(b)})

constexpr int T_LAT = 32768, T_CTX = 1024, T_ALL = 33792, NKEY = 8448, DM = 1024, NIN = 3712, DFF = 4096;
constexpr float EPS = 1e-6f;
constexpr float LOG2E = 1.4426950408889634f;

constexpr size_t WS_WIN = 0;
constexpr size_t WS_WOUT = WS_WIN + (size_t)NIN * 1024 * 2;
constexpr size_t WS_WFF1 = WS_WOUT + (size_t)1024 * 1024 * 2;
constexpr size_t WS_WFF2 = WS_WFF1 + (size_t)4096 * 1024 * 2;
constexpr size_t WS_WUQ = WS_WFF2 + (size_t)4096 * 1024 * 2;
constexpr size_t WS_WUKV = WS_WUQ + (size_t)768 * 256 * 2;
constexpr size_t WS_XC = WS_WUKV + (size_t)768 * 128 * 2;
constexpr size_t WS_MOD = WS_XC + (size_t)1024 * 1024 * 4;
constexpr size_t WS_LB = WS_MOD + (size_t)4 * 5 * 6144 * 4;
constexpr size_t WS_LAM = WS_LB + (size_t)2 * 4 * 512 * 4;
constexpr size_t WS_ROPE = WS_LAM + 256;
constexpr size_t WS_KMAX = WS_ROPE + 8192;
constexpr size_t WS_DSEG = WS_KMAX + 2048;
constexpr size_t WS_H = WS_DSEG + (size_t)32 * 33 * 128 * 4;
constexpr size_t WS_R = WS_H + (size_t)T_ALL * 1024 * 2;
constexpr size_t WS_QDA = WS_R;
constexpr size_t WS_KDA = WS_QDA + (size_t)T_ALL * 384 * 2;
constexpr size_t WS_VDAT = WS_KDA + (size_t)T_ALL * 384 * 2;
constexpr size_t WS_QMLA = WS_VDAT + (size_t)T_ALL * 384 * 2;
constexpr size_t WS_KMLA = WS_QMLA + (size_t)T_ALL * 576 * 2;
constexpr size_t WS_VMLAT = WS_KMLA + (size_t)T_ALL * 576 * 2;
constexpr size_t WS_CQ = WS_VMLAT + (size_t)T_ALL * 384 * 2;
constexpr size_t WS_CKV = WS_CQ + (size_t)T_ALL * 256 * 2;
constexpr size_t WS_KR = WS_CKV + (size_t)T_ALL * 128 * 2;
constexpr size_t WS_HG = WS_KR + (size_t)T_ALL * 32 * 2;
constexpr size_t WS_SST = WS_HG + (size_t)T_ALL * 2048 * 2;
constexpr size_t WS_END = WS_SST + (size_t)32 * 33 * 8192 * 4;
constexpr size_t WS_XBAR = WS_END;
constexpr size_t WS_SSQ = WS_XBAR + 16384;
constexpr size_t WS_END2 = WS_SSQ + (size_t)T_ALL * 4 * 4;
constexpr size_t WS_H1 = WS_R;
constexpr size_t WS_BAR = WS_LAM + 128;
static_assert(WS_R + (size_t)T_ALL * 4096 * 2 <= WS_END + (64u << 20), "h1 overlay");
static_assert(WS_END2 <= 536870912ull, "workspace too large");
static_assert(WS_R + (size_t)T_ALL * 4096 * 2 <= 536870912ull, "workspace too large (h1)");

constexpr int SMEM_BYTES = 73728 + 1024;

struct Params {
    const float *x, *c, *ctx, *c_ctx, *w_mod, *b_mod, *g_mix, *g_mlp, *w_in, *w_out, *da_lambda, *da_subln_g, *g_cq, *g_ckv, *w_uq, *w_ukv, *hg_lb, *hg_norm_g, *w_ff1, *w_ff2, *g_final;
    float* out;
    char* ws;
};

__device__ __forceinline__ int opaque_tid() { int t = threadIdx.x; asm volatile("" : "+v"(t)); return t; }
__device__ __forceinline__ bf16_t f2bf(float f) { unsigned u = __float_as_uint(f); u += 0x7fffu + ((u >> 16) & 1u); return (bf16_t)(u >> 16); }
__device__ __forceinline__ float bf2f(bf16_t h) { return __uint_as_float(((unsigned)h) << 16); }
typedef __bf16 bf16v2_t __attribute__((ext_vector_type(2)));
typedef float f32v2_t __attribute__((ext_vector_type(2)));
__device__ __forceinline__ unsigned pack2(float a, float b) { const f32v2_t f = {a, b}; const bf16v2_t r = __builtin_convertvector(f, bf16v2_t); return __builtin_bit_cast(unsigned, r); }
__device__ __forceinline__ unsigned cvt_pk(float lo, float hi) { return pack2(lo, hi); }
__device__ __forceinline__ float ld_coh(const float* p) { return __hip_atomic_load(p, __ATOMIC_RELAXED, __HIP_MEMORY_SCOPE_AGENT); }
__device__ __forceinline__ float fexp2(float x) { return __builtin_amdgcn_exp2f(x); }
__device__ __forceinline__ float fexp(float x) { return __builtin_amdgcn_exp2f(x * LOG2E); }

__device__ __forceinline__ void row_bk(int row, int& b, int& key, bool& lat) {
    if (row < T_LAT) { b = row >> 13; key = 256 + (row & 8191); lat = true; }
    else { int r = row - T_LAT; b = r >> 8; key = r & 255; lat = false; }
}
__device__ __forceinline__ const float* xrow_in(const Params& p, int row) {
    return row < T_LAT ? p.x + (size_t)row * 1024 : p.ctx + (size_t)(row - T_LAT) * 1024;
}
__device__ __forceinline__ float* xrow(const Params& p, int row) {
    return row < T_LAT ? p.out + (size_t)row * 1024 : (float*)(p.ws + WS_XC) + (size_t)(row - T_LAT) * 1024;
}

__device__ __forceinline__ void gemm_tile_core(const bf16_t* __restrict__ A, int lda, const bf16_t* __restrict__ Bt, int ldb, int K, char* smem) {
    const int tid = opaque_tid(), lane = tid & 63, wid = tid >> 6;
    const int wm = wid >> 1, wn = wid & 1, l31 = lane & 31, hi = lane >> 5;
    f32x16 acc[2][2];
#pragma unroll
    for (int i = 0; i < 2; ++i)
#pragma unroll
        for (int j = 0; j < 2; ++j)
#pragma unroll
            for (int r = 0; r < 16; ++r) acc[i][j][r] = 0.f;
    const int lrow = tid >> 3, lkc = tid & 7;
    const bf16_t* ap = A + (size_t)lrow * lda + lkc * 8;
    const bf16_t* bp = Bt + (size_t)lrow * ldb + lkc * 8;
    uint4 p0, p1, p2, p3, p4, p5, p6, p7, q0, q1, q2, q3, q4, q5, q6, q7;
    const int nk = K >> 6;
    const size_t sA = (size_t)32 * lda, sB = (size_t)32 * ldb;
#define G_LOAD0(KT) { const bf16_t* a_ = ap + (KT) * 64; const bf16_t* b_ = bp + (KT) * 64; p0 = *(const uint4*)(a_); p1 = *(const uint4*)(a_ + sA); p2 = *(const uint4*)(a_ + 2 * sA); p3 = *(const uint4*)(a_ + 3 * sA); \
        p4 = *(const uint4*)(b_); p5 = *(const uint4*)(b_ + sB); p6 = *(const uint4*)(b_ + 2 * sB); p7 = *(const uint4*)(b_ + 3 * sB); }
#define G_LOAD1(KT) { const bf16_t* a_ = ap + (KT) * 64; const bf16_t* b_ = bp + (KT) * 64; q0 = *(const uint4*)(a_); q1 = *(const uint4*)(a_ + sA); q2 = *(const uint4*)(a_ + 2 * sA); q3 = *(const uint4*)(a_ + 3 * sA); \
        q4 = *(const uint4*)(b_); q5 = *(const uint4*)(b_ + sB); q6 = *(const uint4*)(b_ + 2 * sB); q7 = *(const uint4*)(b_ + 3 * sB); }
#define G_WRITE0(BUF) { char* wa_ = smem + (BUF) * 36864 + lrow * 144 + lkc * 16; char* wb_ = wa_ + 18432; *(uint4*)(wa_) = p0; *(uint4*)(wa_ + 4608) = p1; *(uint4*)(wa_ + 9216) = p2; *(uint4*)(wa_ + 13824) = p3; \
        *(uint4*)(wb_) = p4; *(uint4*)(wb_ + 4608) = p5; *(uint4*)(wb_ + 9216) = p6; *(uint4*)(wb_ + 13824) = p7; }
#define G_WRITE1(BUF) { char* wa_ = smem + (BUF) * 36864 + lrow * 144 + lkc * 16; char* wb_ = wa_ + 18432; *(uint4*)(wa_) = q0; *(uint4*)(wa_ + 4608) = q1; *(uint4*)(wa_ + 9216) = q2; *(uint4*)(wa_ + 13824) = q3; \
        *(uint4*)(wb_) = q4; *(uint4*)(wb_ + 4608) = q5; *(uint4*)(wb_ + 9216) = q6; *(uint4*)(wb_ + 13824) = q7; }
#define G_COMPUTE(BUF) { const char* sa = smem + (BUF) * 36864; const char* sb = sa + 18432; \
        _Pragma("unroll") for (int ks = 0; ks < 4; ++ks) { bf16x8 af[2], bfr[2]; \
            _Pragma("unroll") for (int i = 0; i < 2; ++i) af[i] = *(const bf16x8*)(sa + (wm * 64 + i * 32 + l31) * 144 + ks * 32 + hi * 16); \
            _Pragma("unroll") for (int j = 0; j < 2; ++j) bfr[j] = *(const bf16x8*)(sb + (wn * 64 + j * 32 + l31) * 144 + ks * 32 + hi * 16); \
            _Pragma("unroll") for (int i = 0; i < 2; ++i) _Pragma("unroll") for (int j = 0; j < 2; ++j) acc[i][j] = __builtin_amdgcn_mfma_f32_32x32x16_bf16(af[i], bfr[j], acc[i][j], 0, 0, 0); } }
    G_LOAD0(0);
    G_WRITE0(0);
    G_LOAD0(1);
    { const int k2 = nk > 2 ? 2 : nk - 1; G_LOAD1(k2); }
    __syncthreads();
    for (int kt = 0; kt < nk; kt += 2) {
        G_COMPUTE(0);
        G_WRITE0(1);
        { const int k3 = kt + 3 < nk ? kt + 3 : nk - 1; G_LOAD0(k3); }
        __syncthreads();
        G_COMPUTE(1);
        G_WRITE1(0);
        { const int k4 = kt + 4 < nk ? kt + 4 : nk - 1; G_LOAD1(k4); }
        __syncthreads();
    }
#undef G_LOAD0
#undef G_LOAD1
#undef G_WRITE0
#undef G_WRITE1
#undef G_COMPUTE
    float* cs = (float*)smem;
#pragma unroll
    for (int i = 0; i < 2; ++i)
#pragma unroll
        for (int j = 0; j < 2; ++j)
#pragma unroll
            for (int r = 0; r < 16; ++r)
                cs[(wm * 64 + i * 32 + 8 * (r >> 2) + 4 * hi + (r & 3)) * 132 + wn * 64 + j * 32 + l31] = acc[i][j][r];
    __syncthreads();
}


struct Acc2 { f32x16 a[4][2]; };
__device__ __forceinline__ void gemm_tile_core2(const bf16_t* __restrict__ A, int lda, const bf16_t* __restrict__ Bt, int ldb, int K, char* smem, Acc2& C) {
    const int tid = opaque_tid(), lane = tid & 63, wid = tid >> 6;
    const int wm = wid >> 1, wn = wid & 1, l31 = lane & 31, hi = lane >> 5;
#pragma unroll
    for (int i = 0; i < 4; ++i)
#pragma unroll
        for (int j = 0; j < 2; ++j)
#pragma unroll
            for (int r = 0; r < 16; ++r) C.a[i][j][r] = 0.f;
    const int lrow = tid >> 2, lkc = tid & 3;
    const bf16_t* ap = A + (size_t)lrow * lda + lkc * 8;
    const bf16_t* bp = Bt + (size_t)lrow * ldb + lkc * 8;
    const size_t sA = (size_t)64 * lda, sB = (size_t)64 * ldb;
    uint4 p0, p1, p2, p3, p4, p5, q0, q1, q2, q3, q4, q5;
    const int nk = K >> 5;
    constexpr int STG = 30720, BOFF = 20480;
#define H_LOAD0(KT) { const bf16_t* a_ = ap + (KT) * 32; const bf16_t* b_ = bp + (KT) * 32; p0 = *(const uint4*)(a_); p1 = *(const uint4*)(a_ + sA); p2 = *(const uint4*)(a_ + 2 * sA); p3 = *(const uint4*)(a_ + 3 * sA); \
        p4 = *(const uint4*)(b_); p5 = *(const uint4*)(b_ + sB); }
#define H_LOAD1(KT) { const bf16_t* a_ = ap + (KT) * 32; const bf16_t* b_ = bp + (KT) * 32; q0 = *(const uint4*)(a_); q1 = *(const uint4*)(a_ + sA); q2 = *(const uint4*)(a_ + 2 * sA); q3 = *(const uint4*)(a_ + 3 * sA); \
        q4 = *(const uint4*)(b_); q5 = *(const uint4*)(b_ + sB); }
#define H_WRITE0(BUF) { char* wa_ = smem + (BUF) * STG + lrow * 80 + lkc * 16; char* wb_ = wa_ + BOFF; *(uint4*)(wa_) = p0; *(uint4*)(wa_ + 5120) = p1; *(uint4*)(wa_ + 10240) = p2; *(uint4*)(wa_ + 15360) = p3; \
        *(uint4*)(wb_) = p4; *(uint4*)(wb_ + 5120) = p5; }
#define H_WRITE1(BUF) { char* wa_ = smem + (BUF) * STG + lrow * 80 + lkc * 16; char* wb_ = wa_ + BOFF; *(uint4*)(wa_) = q0; *(uint4*)(wa_ + 5120) = q1; *(uint4*)(wa_ + 10240) = q2; *(uint4*)(wa_ + 15360) = q3; \
        *(uint4*)(wb_) = q4; *(uint4*)(wb_ + 5120) = q5; }
#define H_COMPUTE(BUF) { const char* sa = smem + (BUF) * STG; const char* sb = sa + BOFF; \
        _Pragma("unroll") for (int ks = 0; ks < 2; ++ks) { bf16x8 af[4], bfr[2]; \
            _Pragma("unroll") for (int i = 0; i < 4; ++i) af[i] = *(const bf16x8*)(sa + (wm * 128 + i * 32 + l31) * 80 + ks * 32 + hi * 16); \
            _Pragma("unroll") for (int j = 0; j < 2; ++j) bfr[j] = *(const bf16x8*)(sb + (wn * 64 + j * 32 + l31) * 80 + ks * 32 + hi * 16); \
            _Pragma("unroll") for (int i = 0; i < 4; ++i) _Pragma("unroll") for (int j = 0; j < 2; ++j) C.a[i][j] = __builtin_amdgcn_mfma_f32_32x32x16_bf16(af[i], bfr[j], C.a[i][j], 0, 0, 0); } }
    H_LOAD0(0);
    H_WRITE0(0);
    H_LOAD0(1);
    { const int k2 = nk > 2 ? 2 : nk - 1; H_LOAD1(k2); }
    __syncthreads();
    for (int kt = 0; kt < nk; kt += 2) {
        H_COMPUTE(0);
        H_WRITE0(1);
        { const int k3 = kt + 3 < nk ? kt + 3 : nk - 1; H_LOAD0(k3); }
        __syncthreads();
        H_COMPUTE(1);
        H_WRITE1(0);
        { const int k4 = kt + 4 < nk ? kt + 4 : nk - 1; H_LOAD1(k4); }
        __syncthreads();
    }
#undef H_LOAD0
#undef H_LOAD1
#undef H_WRITE0
#undef H_WRITE1
#undef H_COMPUTE
}
__device__ __forceinline__ void gemm2_stage(const Acc2& C, int half, char* smem) {
    const int tid = opaque_tid(), lane = tid & 63, wid = tid >> 6;
    const int wm = wid >> 1, wn = wid & 1, l31 = lane & 31, hi = lane >> 5;
    float* cs = (float*)smem;
    if (wm == half) {
#pragma unroll
        for (int i = 0; i < 4; ++i)
#pragma unroll
            for (int j = 0; j < 2; ++j)
#pragma unroll
                for (int r = 0; r < 16; ++r)
                    cs[(i * 32 + 8 * (r >> 2) + 4 * hi + (r & 3)) * 132 + wn * 64 + j * 32 + l31] = C.a[i][j][r];
    }
    __syncthreads();
}

__device__ __forceinline__ void epi_copy_bf16(const float* cs, bf16_t* dst, int ld, int row0, int col0, float sc) {
    const int tid = opaque_tid(), c4 = (tid & 31) * 4, r0 = tid >> 5;
#pragma unroll 4
    for (int i = 0; i < 16; ++i) {
        const int r = r0 + 8 * i;
        const f32x4 v = *(const f32x4*)(cs + r * 132 + c4);
        uint2 w; w.x = pack2(v[0] * sc, v[1] * sc); w.y = pack2(v[2] * sc, v[3] * sc);
        *(uint2*)(dst + (size_t)(row0 + r) * ld + col0 + c4) = w;
    }
}
__device__ __forceinline__ void epi_store_T(const float* cs, int cbase, int ndcols, bf16_t* dstbase  , const float* rs) {
    const int tid = opaque_tid();
    const int items = ndcols * 16;
    for (int it = tid; it < items; it += 256) {
        const int c = it % ndcols, rg = it / ndcols;
        float v[8];
#pragma unroll
        for (int j = 0; j < 8; ++j) { v[j] = cs[(rg * 8 + j) * 132 + cbase + c]; if (rs) v[j] *= rs[rg * 8 + j]; }
        uint4 w; w.x = pack2(v[0], v[1]); w.y = pack2(v[2], v[3]); w.z = pack2(v[4], v[5]); w.w = pack2(v[6], v[7]);
        *(uint4*)(dstbase + (size_t)c * NKEY + rg * 8) = w;
    }
}
__device__ __forceinline__ void rope32(float (&v)[32], int n, const float* rope) {
#pragma unroll
    for (int a = 0; a < 2; ++a) {
        const int pos = a == 0 ? (n >> 6) : (n & 63);
#pragma unroll
        for (int f = 0; f < 8; ++f) {
            const float cs_ = rope[(pos * 8 + f) * 2], sn = rope[(pos * 8 + f) * 2 + 1];
            const float x1 = v[a * 16 + f], x2 = v[a * 16 + 8 + f];
            v[a * 16 + f] = x1 * cs_ - x2 * sn;
            v[a * 16 + 8 + f] = x2 * cs_ + x1 * sn;
        }
    }
}
__device__ __forceinline__ float wave_max(float v) {
#pragma unroll
    for (int o = 32; o >= 1; o >>= 1) v = fmaxf(v, __shfl_xor(v, o));
    return v;
}
__device__ __forceinline__ void store32_bf16(bf16_t* dst, const float (&v)[32], float sc) {
#pragma unroll
    for (int q = 0; q < 4; ++q) {
        uint4 w; w.x = pack2(v[q * 8 + 0] * sc, v[q * 8 + 1] * sc); w.y = pack2(v[q * 8 + 2] * sc, v[q * 8 + 3] * sc);
        w.z = pack2(v[q * 8 + 4] * sc, v[q * 8 + 5] * sc); w.w = pack2(v[q * 8 + 6] * sc, v[q * 8 + 7] * sc);
        *(uint4*)(dst + q * 8) = w;
    }
}

__device__ void epi_inproj(const Params& p, int l, int m0, int tn, const float* cs) {
    const int tid = opaque_tid();
    int b, key0; bool lat; row_bk(m0, b, key0, lat);
    const float* rope = (const float*)(p.ws + WS_ROPE);
    if (tn < 6 || tn == 28) {
        const int r = tid & 127, half = tid >> 7;
        const int row = m0 + r, key = key0 + r;
        const int ngrp = (tn == 28) ? 1 : 4;
        for (int gi = half; gi < ngrp; gi += 2) {
            float v[32];
#pragma unroll
            for (int q = 0; q < 8; ++q) { const f32x4 t = *(const f32x4*)(cs + r * 132 + gi * 32 + q * 4); v[q * 4] = t[0]; v[q * 4 + 1] = t[1]; v[q * 4 + 2] = t[2]; v[q * 4 + 3] = t[3]; }
            if (lat) rope32(v, row & 8191, rope);
            if (tn < 3) {
                bf16_t* dst = (bf16_t*)(p.ws + WS_QDA) + ((size_t)(b * 12 + tn * 4 + gi) * NKEY + key) * 32;
                store32_bf16(dst, v, 0.17677669529663687f * LOG2E);
            } else if (tn < 6) {
                const int hc = (tn - 3) * 4 + gi;
                bf16_t* dst = (bf16_t*)(p.ws + WS_KDA) + ((size_t)(b * 12 + hc) * NKEY + key) * 32;
                store32_bf16(dst, v, 1.0f);
                float n2 = 0.f;
#pragma unroll
                for (int q = 0; q < 32; ++q) n2 += v[q] * v[q];
                n2 = wave_max(n2);
                if ((tid & 63) == 0) atomicMax((unsigned*)(p.ws + WS_KMAX) + (l * 4 + b) * 32 + hc, __float_as_uint(n2));
            } else {
                bf16_t* dst = (bf16_t*)(p.ws + WS_KR) + (size_t)row * 32;
                store32_bf16(dst, v, 1.0f);
            }
        }
    } else if (tn < 9) {
        const int h0 = (tn - 6) * 2;
        bf16_t* dst = (bf16_t*)(p.ws + WS_VDAT) + ((size_t)(b * 6 + h0) * 64) * NKEY + key0;
        epi_store_T(cs, 0, 128, dst, nullptr);
    } else if (tn < 12) {
        if (tn < 11) epi_copy_bf16(cs, (bf16_t*)(p.ws + WS_CQ), 256, m0, (tn - 9) * 128, 1.0f);
        else epi_copy_bf16(cs, (bf16_t*)(p.ws + WS_CKV), 128, m0, 0, 1.0f);
        if (tid < 128) {
            float ssq = 0.f;
#pragma unroll 8
            for (int q = 0; q < 32; ++q) { const f32x4 t = *(const f32x4*)(cs + tid * 132 + q * 4); ssq += t[0] * t[0] + t[1] * t[1] + t[2] * t[2] + t[3] * t[3]; }
            ((float*)(p.ws + WS_SSQ))[(size_t)(m0 + tid) * 4 + (tn - 9)] = ssq;
        }
    } else {
        epi_copy_bf16(cs, (bf16_t*)(p.ws + WS_HG), 2048, m0, (tn - 12) * 128, 1.0f);
    }
}

__device__ __forceinline__ void row_rstd(const Params& p, int which  , int m0, float* rs) {
    const int tid = opaque_tid();
    if (tid < 128) {
        const float* q = (const float*)(p.ws + WS_SSQ) + (size_t)(m0 + tid) * 4;
        rs[tid] = which == 0 ? rsqrtf((q[0] + q[1]) * (1.0f / 256.0f) + EPS) : rsqrtf(q[2] * (1.0f / 128.0f) + EPS);
    }
}
__device__ void epi_uq(const Params& p, int m0, int h, const float* cs, const float* rs) {
    const int tid = opaque_tid(), r = tid & 127, half = tid >> 7;
    int b, key0; bool lat; row_bk(m0, b, key0, lat);
    const int row = m0 + r, key = key0 + r;
    const float sc = rs[r] * 0.10206207261596575f * LOG2E;
    bf16_t* dst = (bf16_t*)(p.ws + WS_QMLA) + ((size_t)(b * 6 + h) * NKEY + key) * 96;
    if (half == 0) {
        float v[32];
#pragma unroll
        for (int q = 0; q < 8; ++q) { const f32x4 t = *(const f32x4*)(cs + r * 132 + q * 4); v[q * 4] = t[0]; v[q * 4 + 1] = t[1]; v[q * 4 + 2] = t[2]; v[q * 4 + 3] = t[3]; }
        store32_bf16(dst, v, sc);
#pragma unroll
        for (int q = 0; q < 4; ++q) { const f32x4 t = *(const f32x4*)(cs + r * 132 + 32 + q * 4); v[q * 4] = t[0]; v[q * 4 + 1] = t[1]; v[q * 4 + 2] = t[2]; v[q * 4 + 3] = t[3]; }
#pragma unroll
        for (int q = 0; q < 2; ++q) {
            uint4 w; w.x = pack2(v[q * 8 + 0] * sc, v[q * 8 + 1] * sc); w.y = pack2(v[q * 8 + 2] * sc, v[q * 8 + 3] * sc);
            w.z = pack2(v[q * 8 + 4] * sc, v[q * 8 + 5] * sc); w.w = pack2(v[q * 8 + 6] * sc, v[q * 8 + 7] * sc);
            *(uint4*)(dst + 32 + q * 8) = w;
        }
    } else {
        float v[32];
#pragma unroll
        for (int q = 0; q < 4; ++q) { const f32x4 t = *(const f32x4*)(cs + r * 132 + 48 + q * 4); v[q * 4] = t[0]; v[q * 4 + 1] = t[1]; v[q * 4 + 2] = t[2]; v[q * 4 + 3] = t[3]; }
#pragma unroll
        for (int q = 0; q < 2; ++q) {
            uint4 w; w.x = pack2(v[q * 8 + 0] * sc, v[q * 8 + 1] * sc); w.y = pack2(v[q * 8 + 2] * sc, v[q * 8 + 3] * sc);
            w.z = pack2(v[q * 8 + 4] * sc, v[q * 8 + 5] * sc); w.w = pack2(v[q * 8 + 6] * sc, v[q * 8 + 7] * sc);
            *(uint4*)(dst + 48 + q * 8) = w;
        }
#pragma unroll
        for (int q = 0; q < 8; ++q) { const f32x4 t = *(const f32x4*)(cs + r * 132 + 64 + q * 4); v[q * 4] = t[0]; v[q * 4 + 1] = t[1]; v[q * 4 + 2] = t[2]; v[q * 4 + 3] = t[3]; }
        if (lat) rope32(v, row & 8191, (const float*)(p.ws + WS_ROPE));
        store32_bf16(dst + 64, v, sc);
    }
}
__device__ void epi_ukv(const Params& p, int l, int m0, int h, const float* cs, const float* rs) {
    const int tid = opaque_tid();
    int b, key0; bool lat; row_bk(m0, b, key0, lat);
    bf16_t* vdst = (bf16_t*)(p.ws + WS_VMLAT) + ((size_t)(b * 6 + h) * 64) * NKEY + key0;
    epi_store_T(cs, 64, 64, vdst, rs);
    if (tid < 128) {
        const int r = tid, row = m0 + r, key = key0 + r;
        const float sc = rs[r];
        bf16_t* dst = (bf16_t*)(p.ws + WS_KMLA) + ((size_t)(b * 6 + h) * NKEY + key) * 96;
        float n2 = 0.f;
        float v[32];
#pragma unroll
        for (int part = 0; part < 2; ++part) {
#pragma unroll
            for (int q = 0; q < 8; ++q) { const f32x4 t = *(const f32x4*)(cs + r * 132 + part * 32 + q * 4); v[q * 4] = t[0] * sc; v[q * 4 + 1] = t[1] * sc; v[q * 4 + 2] = t[2] * sc; v[q * 4 + 3] = t[3] * sc; }
#pragma unroll
            for (int q = 0; q < 32; ++q) n2 += v[q] * v[q];
            store32_bf16(dst + part * 32, v, 1.0f);
        }
        const bf16_t* kr = (const bf16_t*)(p.ws + WS_KR) + (size_t)row * 32;
#pragma unroll
        for (int q = 0; q < 4; ++q) {
            const uint4 w = *(const uint4*)(kr + q * 8);
            *(uint4*)(dst + 64 + q * 8) = w;
            const unsigned ww[4] = {w.x, w.y, w.z, w.w};
#pragma unroll
            for (int j = 0; j < 4; ++j) { const float f0 = __uint_as_float(ww[j] << 16), f1 = __uint_as_float(ww[j] & 0xffff0000u); n2 += f0 * f0 + f1 * f1; }
        }
        n2 = wave_max(n2);
        if ((tid & 63) == 0) atomicMax((unsigned*)(p.ws + WS_KMAX) + (l * 4 + b) * 32 + 12 + h, __float_as_uint(n2));
    }
}
__device__ __forceinline__ void epi_resid(const Params& p, int l, int m0, int n0, int goff, const float* cs) {
    const int tid = opaque_tid(), c4 = (tid & 31) * 4, r0 = tid >> 5;
    int b, key0; bool lat; row_bk(m0, b, key0, lat);
    const float* gate = (const float*)(p.ws + WS_MOD) + (size_t)(l * 5 + (lat ? b : 4)) * 6144 + goff + n0 + c4;
    const f32x4 g = *(const f32x4*)gate;
#pragma unroll 4
    for (int i = 0; i < 16; ++i) {
        const int r = r0 + 8 * i;
        const f32x4 v = *(const f32x4*)(cs + r * 132 + c4);
        float* xp = xrow(p, m0 + r) + n0 + c4;
        const float* xs = (l == 0 && goff == 2 * 1024) ? xrow_in(p, m0 + r) + n0 + c4 : xp;
        f32x4 x = *(const f32x4*)xs;
        x += g * v;
        *(f32x4*)xp = x;
    }
}
__device__ __forceinline__ void epi_ff1(const Params& p, int m0, int n0, const float* cs) {
    const int tid = opaque_tid(), c4 = (tid & 31) * 4, r0 = tid >> 5;
    bf16_t* dst = (bf16_t*)(p.ws + WS_H1);
#pragma unroll 4
    for (int i = 0; i < 16; ++i) {
        const int r = r0 + 8 * i;
        f32x4 v = *(const f32x4*)(cs + r * 132 + c4);
#pragma unroll
        for (int j = 0; j < 4; ++j) { const float t = fmaxf(v[j], 0.f); v[j] = t * t; }
        uint2 w; w.x = pack2(v[0], v[1]); w.y = pack2(v[2], v[3]);
        *(uint2*)(dst + (size_t)(m0 + r) * 4096 + n0 + c4) = w;
    }
}

template <int DQK>
__device__ __forceinline__ void attn_pass(const bf16_t* __restrict__ Qb, const bf16_t* __restrict__ Kb, const bf16_t* __restrict__ VTb,
                                          int q0, int nkt, float kmax, char* smem, f32x16& O0, f32x16& O1, float& lsum) {
    constexpr int KS = DQK * 2 + 16, VS = 136, STAGE = 64 * KS + 64 * VS, NKC = DQK / 32, CPR = DQK / 8;
    const int tid = opaque_tid(), lane = tid & 63, wid = tid >> 6, l31 = lane & 31, hi = lane >> 5;
    bf16x8 qf[DQK / 16];
    const bf16_t* qp = Qb + (size_t)(q0 + wid * 32 + l31) * DQK + hi * 8;
    float qn = 0.f;
#pragma unroll
    for (int ks = 0; ks < DQK / 16; ++ks) {
        qf[ks] = *(const bf16x8*)(qp + ks * 16);
#pragma unroll
        for (int j = 0; j < 8; ++j) { const float f = bf2f((bf16_t)qf[ks][j]); qn += f * f; }
    }
    qn += __shfl_xor(qn, 32);
    const float negm = -(sqrtf(qn) * kmax);
#pragma unroll
    for (int r = 0; r < 16; ++r) { O0[r] = 0.f; O1[r] = 0.f; }
    lsum = 0.f;
    const int kr0 = tid / CPR, kc0 = tid % CPR, kr1 = (tid + 256) / CPR, kc1 = (tid + 256) % CPR, kr2 = (tid + 512) / CPR, kc2 = (tid + 512) % CPR;
    const int vr0 = tid >> 3, vc0 = tid & 7;
    const bf16_t* vg = VTb + (size_t)vr0 * NKEY + vc0 * 8;
    uint4 a0, a1, a2, a3, a4;
#define AT_LOADA(KT) { const bf16_t* kp_ = Kb + (size_t)(KT) * 64 * DQK; a0 = *(const uint4*)(kp_ + (size_t)tid * 8); \
        if constexpr (NKC > 1) { a1 = *(const uint4*)(kp_ + (size_t)(tid + 256) * 8); a2 = *(const uint4*)(kp_ + (size_t)(tid + 512) * 8); } \
        a3 = *(const uint4*)(vg + (KT) * 64); a4 = *(const uint4*)(vg + (size_t)32 * NKEY + (KT) * 64); }
#define AT_WRITE(X0, X1, X2, X3, X4, BUF) { char* sk_ = smem + (BUF) * STAGE; char* sv_ = sk_ + 64 * KS; \
        *(uint4*)(sk_ + kr0 * KS + kc0 * 16) = X0; \
        if constexpr (NKC > 1) { *(uint4*)(sk_ + kr1 * KS + kc1 * 16) = X1; *(uint4*)(sk_ + kr2 * KS + kc2 * 16) = X2; } \
        { uint2* d_ = (uint2*)(sv_ + vr0 * VS + vc0 * 16); d_[0] = make_uint2(X3.x, X3.y); d_[1] = make_uint2(X3.z, X3.w); } \
        { uint2* d_ = (uint2*)(sv_ + (vr0 + 32) * VS + vc0 * 16); d_[0] = make_uint2(X4.x, X4.y); d_[1] = make_uint2(X4.z, X4.w); } }
    f32x16 NEG;
#pragma unroll
    for (int r = 0; r < 16; ++r) NEG[r] = negm;
    auto compute = [&](int buf) {
        const char* sk = smem + buf * STAGE; const char* sv = sk + 64 * KS;
        constexpr int NKS = DQK / 16;
        bf16x8 k0[NKS], k1[NKS], v0[4], v1[4];
#pragma unroll
        for (int ks = 0; ks < NKS; ++ks) k0[ks] = *(const bf16x8*)(sk + (l31)*KS + ks * 32 + hi * 16);
#pragma unroll
        for (int ks = 0; ks < NKS; ++ks) k1[ks] = *(const bf16x8*)(sk + (32 + l31) * KS + ks * 32 + hi * 16);
#pragma unroll
        for (int u = 0; u < 2; ++u)
#pragma unroll
            for (int db = 0; db < 2; ++db) {
                const char* vp = sv + (db * 32 + l31) * VS + (16 * u + 4 * hi) * 2;
                const uint2 x0 = *(const uint2*)vp, x1 = *(const uint2*)(vp + 16);
                v0[u * 2 + db] = MK8(x0.x, x0.y, x1.x, x1.y);
            }
        __builtin_amdgcn_sched_barrier(0);
        f32x16 S0, S1;
#pragma unroll
        for (int ks = 0; ks < NKS; ++ks) S0 = __builtin_amdgcn_mfma_f32_32x32x16_bf16(k0[ks], qf[ks], ks == 0 ? NEG : S0, 0, 0, 0);
#pragma unroll
        for (int ks = 0; ks < NKS; ++ks) S1 = __builtin_amdgcn_mfma_f32_32x32x16_bf16(k1[ks], qf[ks], ks == 0 ? NEG : S1, 0, 0, 0);
        __builtin_amdgcn_sched_barrier(0);
#pragma unroll
        for (int u = 0; u < 2; ++u)
#pragma unroll
            for (int db = 0; db < 2; ++db) {
                const char* vp = sv + (db * 32 + l31) * VS + (32 + 16 * u + 4 * hi) * 2;
                const uint2 x0 = *(const uint2*)vp, x1 = *(const uint2*)(vp + 16);
                v1[u * 2 + db] = MK8(x0.x, x0.y, x1.x, x1.y);
            }
        unsigned pk0[8], pk1[8];
#pragma unroll
        for (int r = 0; r < 16; r += 2) { const float e0 = fexp2(S0[r]), e1 = fexp2(S0[r + 1]); lsum += e0 + e1; pk0[r >> 1] = cvt_pk(e0, e1); }
        __builtin_amdgcn_sched_barrier(0);
#pragma unroll
        for (int u = 0; u < 2; ++u) {
            const bf16x8 pbv = MK8(pk0[4 * u], pk0[4 * u + 1], pk0[4 * u + 2], pk0[4 * u + 3]);
            O0 = __builtin_amdgcn_mfma_f32_32x32x16_bf16(v0[u * 2 + 0], pbv, O0, 0, 0, 0);
            O1 = __builtin_amdgcn_mfma_f32_32x32x16_bf16(v0[u * 2 + 1], pbv, O1, 0, 0, 0);
        }
#pragma unroll
        for (int r = 0; r < 16; r += 2) { const float e0 = fexp2(S1[r]), e1 = fexp2(S1[r + 1]); lsum += e0 + e1; pk1[r >> 1] = cvt_pk(e0, e1); }
        __builtin_amdgcn_sched_barrier(0);
#pragma unroll
        for (int u = 0; u < 2; ++u) {
            const bf16x8 pbv = MK8(pk1[4 * u], pk1[4 * u + 1], pk1[4 * u + 2], pk1[4 * u + 3]);
            O0 = __builtin_amdgcn_mfma_f32_32x32x16_bf16(v1[u * 2 + 0], pbv, O0, 0, 0, 0);
            O1 = __builtin_amdgcn_mfma_f32_32x32x16_bf16(v1[u * 2 + 1], pbv, O1, 0, 0, 0);
        }
    };
    a1 = a2 = make_uint4(0u, 0u, 0u, 0u);
    AT_LOADA(0);
    AT_WRITE(a0, a1, a2, a3, a4, 0);
    AT_LOADA(1);
    __syncthreads();
    for (int kt = 0; kt < nkt; kt += 2) {
        compute(0);
        AT_WRITE(a0, a1, a2, a3, a4, 1);
        { const int k2 = kt + 2 < nkt ? kt + 2 : nkt - 1; AT_LOADA(k2); }
        __syncthreads();
        compute(1);
        AT_WRITE(a0, a1, a2, a3, a4, 0);
        { const int k3 = kt + 3 < nkt ? kt + 3 : nkt - 1; AT_LOADA(k3); }
        __syncthreads();
    }
#undef AT_LOADA
#undef AT_WRITE
    lsum += __shfl_xor(lsum, 32);
}

__device__ void attn_unit(const Params& p, int l, int b, int hh, int qbi, char* smem) {
    const int q0 = qbi < 64 ? 256 + qbi * 128 : (qbi - 64) * 128;
    const int nkt = qbi < 64 ? 132 : 4;
    const int tid = opaque_tid(), lane = tid & 63, wid = tid >> 6, l31 = lane & 31, hi = lane >> 5;
    const int qkey = q0 + wid * 32 + l31;
    const int row = qkey < 256 ? T_LAT + b * 256 + qkey : b * 8192 + qkey - 256;
    const float* kmx = (const float*)(p.ws + WS_KMAX) + (l * 4 + b) * 32;
    bf16_t* Y = (bf16_t*)(p.ws + WS_H);
    if (hh < 6) {
        const int h = hh;
        const bf16_t* VT = (const bf16_t*)(p.ws + WS_VDAT) + ((size_t)(b * 6 + h) * 64) * NKEY;
        f32x16 A0, A1, B0, B1; float la, lb;
        {
            const size_t off = (size_t)(b * 12 + 2 * h) * NKEY * 32;
            attn_pass<32>((const bf16_t*)(p.ws + WS_QDA) + off, (const bf16_t*)(p.ws + WS_KDA) + off, VT, q0, nkt, sqrtf(ld_coh(kmx + 2 * h)), smem, A0, A1, la);
        }
        {
            const size_t off = (size_t)(b * 12 + 2 * h + 1) * NKEY * 32;
            attn_pass<32>((const bf16_t*)(p.ws + WS_QDA) + off, (const bf16_t*)(p.ws + WS_KDA) + off, VT, q0, nkt, sqrtf(ld_coh(kmx + 2 * h + 1)), smem, B0, B1, lb);
        }
        const float lam = ((const float*)(p.ws + WS_LAM))[l];
        const float lam_init = 0.8f - 0.6f * expf(-0.3f * (float)l);
        const float ia = 1.0f / la, ib = lam / lb;
        float ss = 0.f;
#pragma unroll
        for (int r = 0; r < 16; ++r) { A0[r] = A0[r] * ia - B0[r] * ib; A1[r] = A1[r] * ia - B1[r] * ib; ss += A0[r] * A0[r] + A1[r] * A1[r]; }
        ss += __shfl_xor(ss, 32);
        const float rinv = rsqrtf(ss * (1.0f / 64.0f) + EPS) * (1.0f - lam_init);
        const float* g = p.da_subln_g + l * 64;
        bf16_t* yp = Y + (size_t)row * 1024 + h * 64;
#pragma unroll
        for (int q = 0; q < 4; ++q) {
            const int d = 8 * q + 4 * hi;
            const f32x4 g0 = *(const f32x4*)(g + d), g1 = *(const f32x4*)(g + 32 + d);
            uint2 w0, w1;
            w0.x = pack2(A0[4 * q] * rinv * g0[0], A0[4 * q + 1] * rinv * g0[1]); w0.y = pack2(A0[4 * q + 2] * rinv * g0[2], A0[4 * q + 3] * rinv * g0[3]);
            w1.x = pack2(A1[4 * q] * rinv * g1[0], A1[4 * q + 1] * rinv * g1[1]); w1.y = pack2(A1[4 * q + 2] * rinv * g1[2], A1[4 * q + 3] * rinv * g1[3]);
            *(uint2*)(yp + d) = w0; *(uint2*)(yp + 32 + d) = w1;
        }
    } else {
        const int h = hh - 6;
        const bf16_t* VT = (const bf16_t*)(p.ws + WS_VMLAT) + ((size_t)(b * 6 + h) * 64) * NKEY;
        const size_t off = (size_t)(b * 6 + h) * NKEY * 96;
        f32x16 A0, A1; float la;
        attn_pass<96>((const bf16_t*)(p.ws + WS_QMLA) + off, (const bf16_t*)(p.ws + WS_KMLA) + off, VT, q0, nkt, sqrtf(ld_coh(kmx + 12 + h)), smem, A0, A1, la);
        const float ia = 1.0f / la;
        bf16_t* yp = Y + (size_t)row * 1024 + 384 + h * 64;
#pragma unroll
        for (int q = 0; q < 4; ++q) {
            const int d = 8 * q + 4 * hi;
            uint2 w0, w1;
            w0.x = pack2(A0[4 * q] * ia, A0[4 * q + 1] * ia); w0.y = pack2(A0[4 * q + 2] * ia, A0[4 * q + 3] * ia);
            w1.x = pack2(A1[4 * q] * ia, A1[4 * q + 1] * ia); w1.y = pack2(A1[4 * q + 2] * ia, A1[4 * q + 3] * ia);
            *(uint2*)(yp + d) = w0; *(uint2*)(yp + 32 + d) = w1;
        }
    }
}

constexpr int HG_QT = 0, HG_KT = 4352, HG_KH = 8704, HG_VT = 13824, HG_DD = 16384, HG_OSEG = 17408;
template <int MODE>
__device__ void hgrn_pass(const Params& p, int l, int dir, int b, int h, int g, char* smem) {
    const int tid = opaque_tid(), lane = tid & 63, wid = tid >> 6, c = lane & 15, gq = lane >> 4;
    int r0, sgn;
    if (dir == 0) { r0 = g == 0 ? T_LAT + b * 256 : b * 8192 + (g - 1) * 256; sgn = 1; }
    else { r0 = g == 0 ? T_LAT + b * 256 + 255 : b * 8192 + 8191 - (g - 1) * 256; sgn = -1; }
    const bf16_t* HG = (const bf16_t*)(p.ws + WS_HG);
    const int k = tid >> 1, hf = tid & 1;
    const float lbv = ((const float*)(p.ws + WS_LB))[(dir * 4 + l) * 512 + h * 128 + k];
    const float omlb = 1.0f - lbv;
    const int zoff = 512 + dir * 512 + h * 128 + k, qoff = h * 128 + k;
    bf16_t* QT = (bf16_t*)(smem + HG_QT); bf16_t* KT = (bf16_t*)(smem + HG_KT); bf16_t* KH = (bf16_t*)(smem + HG_KH); bf16_t* VT = (bf16_t*)(smem + HG_VT);
    float* DD = (float*)(smem + HG_DD); bf16_t* OSEG = (bf16_t*)(smem + HG_OSEG);
    const int chain = (dir * 4 + b) * 4 + h;
    float* sst = (float*)(p.ws + WS_SST) + (size_t)(chain * 33 + g) * 8192;
    f32x4 S[8];
#pragma unroll
    for (int kb = 0; kb < 8; ++kb)
#pragma unroll
        for (int r = 0; r < 4; ++r) S[kb][r] = (MODE == 0) ? 0.f : sst[(16 * kb + 4 * gq + r) * 64 + 16 * wid + c];
    float btot = 0.f;
    bf16_t zr0, zr1, zr2, zr3, zr4, zr5, zr6, zr7, qr0 = 0, qr1 = 0, qr2 = 0, qr3 = 0, qr4 = 0, qr5 = 0, qr6 = 0, qr7 = 0; uint2 vv;
    const int vt_t = tid >> 4, vt_v4 = (tid & 15) * 4;
#define HG_ROW(SC, T) ((size_t)(r0 + sgn * ((SC) * 16 + (T))) * 2048)
#define HG_PREFETCH(SC) { const bf16_t* zb_ = HG + zoff; \
        zr0 = zb_[HG_ROW(SC, hf * 8 + 0)]; zr1 = zb_[HG_ROW(SC, hf * 8 + 1)]; zr2 = zb_[HG_ROW(SC, hf * 8 + 2)]; zr3 = zb_[HG_ROW(SC, hf * 8 + 3)]; \
        zr4 = zb_[HG_ROW(SC, hf * 8 + 4)]; zr5 = zb_[HG_ROW(SC, hf * 8 + 5)]; zr6 = zb_[HG_ROW(SC, hf * 8 + 6)]; zr7 = zb_[HG_ROW(SC, hf * 8 + 7)]; \
        if (MODE != 0) { const bf16_t* qb_ = HG + qoff; \
        qr0 = qb_[HG_ROW(SC, hf * 8 + 0)]; qr1 = qb_[HG_ROW(SC, hf * 8 + 1)]; qr2 = qb_[HG_ROW(SC, hf * 8 + 2)]; qr3 = qb_[HG_ROW(SC, hf * 8 + 3)]; \
        qr4 = qb_[HG_ROW(SC, hf * 8 + 4)]; qr5 = qb_[HG_ROW(SC, hf * 8 + 5)]; qr6 = qb_[HG_ROW(SC, hf * 8 + 6)]; qr7 = qb_[HG_ROW(SC, hf * 8 + 7)]; } \
        vv = *(const uint2*)(HG + HG_ROW(SC, vt_t) + 1536 + h * 64 + vt_v4); }
    HG_PREFETCH(0);
    for (int sc = 0; sc < 16; ++sc) {
        float bt[8], ky[8], qv[8];
        {
            const bf16_t zz[8] = {zr0, zr1, zr2, zr3, zr4, zr5, zr6, zr7};
            const bf16_t qq[8] = {qr0, qr1, qr2, qr3, qr4, qr5, qr6, qr7};
            float cum = 0.f;
#pragma unroll
            for (int i = 0; i < 8; ++i) {
                const float z = bf2f(zz[i]);
                const float e = fexp(-z);
                const float sg = __builtin_amdgcn_rcpf(1.0f + e);
                const float f = lbv + omlb * sg;
                cum += __builtin_amdgcn_logf(fmaxf(f, 1e-30f)) * 0.6931471805599453f;
                bt[i] = cum; ky[i] = omlb * (1.0f - sg); qv[i] = bf2f(qq[i]);
            }
            const float other = __shfl_xor(cum, 1);
            const float blast = cum + other;
            const float add = hf ? other : 0.f;
#pragma unroll
            for (int i = 0; i < 8; ++i) {
                const int t = hf * 8 + i;
                const float b_ = bt[i] + add;
                if (MODE != 0) {
                    QT[t * 136 + k] = f2bf(qv[i] * fexp(b_));
                    KT[t * 136 + k] = f2bf(ky[i] * fexp(fminf(-b_, 80.f)));
                }
                KH[k * 20 + t] = f2bf(ky[i] * fexp(blast - b_));
            }
            if (hf == 0) DD[k] = fexp(blast);
            btot += blast;
            VT[(vt_v4 + 0) * 20 + vt_t] = (bf16_t)(vv.x & 0xffff); VT[(vt_v4 + 1) * 20 + vt_t] = (bf16_t)(vv.x >> 16);
            VT[(vt_v4 + 2) * 20 + vt_t] = (bf16_t)(vv.y & 0xffff); VT[(vt_v4 + 3) * 20 + vt_t] = (bf16_t)(vv.y >> 16);
        }
        __syncthreads();
        { const int scn = sc < 15 ? sc + 1 : 15; HG_PREFETCH(scn); }
        const uint2 vtu = *(const uint2*)(VT + (16 * wid + c) * 20 + 4 * gq);
        const bf16x8 vtf = MK8(vtu.x, vtu.y, 0u, 0u);
        if (MODE != 0) {
            f32x4 AT = {0.f, 0.f, 0.f, 0.f};
#pragma unroll
            for (int ks = 0; ks < 4; ++ks) {
                const bf16x8 a = *(const bf16x8*)(KT + c * 136 + ks * 32 + gq * 8);
                const bf16x8 bq = *(const bf16x8*)(QT + c * 136 + ks * 32 + gq * 8);
                AT = __builtin_amdgcn_mfma_f32_16x16x32_bf16(a, bq, AT, 0, 0, 0);
            }
#pragma unroll
            for (int r = 0; r < 4; ++r) if (4 * gq + r > c) AT[r] = 0.f;
            const bf16x8 pfv = MK8(pack2(AT[0], AT[1]), pack2(AT[2], AT[3]), 0u, 0u);
            f32x4 oT = {0.f, 0.f, 0.f, 0.f};
            oT = __builtin_amdgcn_mfma_f32_16x16x32_bf16(vtf, pfv, oT, 0, 0, 0);
#pragma unroll
            for (int u = 0; u < 4; ++u) {
                const bf16x8 sfv = MK8(pack2(S[2 * u][0], S[2 * u][1]), pack2(S[2 * u][2], S[2 * u][3]), pack2(S[2 * u + 1][0], S[2 * u + 1][1]), pack2(S[2 * u + 1][2], S[2 * u + 1][3]));
                const uint2 q0 = *(const uint2*)(QT + c * 136 + 32 * u + 4 * gq), q1 = *(const uint2*)(QT + c * 136 + 32 * u + 16 + 4 * gq);
                const bf16x8 qpv = MK8(q0.x, q0.y, q1.x, q1.y);
                oT = __builtin_amdgcn_mfma_f32_16x16x32_bf16(sfv, qpv, oT, 0, 0, 0);
            }
            const int pos = sc * 16 + c;
            const int ti = (MODE == 1) ? pos : 255 - pos;
            bf16_t* op = OSEG + ti * 68 + 16 * wid + 4 * gq;
            if (MODE == 2) {
                const uint2 old = *(const uint2*)op;
                oT[0] += __uint_as_float(old.x << 16); oT[1] += __uint_as_float(old.x & 0xffff0000u);
                oT[2] += __uint_as_float(old.y << 16); oT[3] += __uint_as_float(old.y & 0xffff0000u);
            }
            uint2 w; w.x = pack2(oT[0], oT[1]); w.y = pack2(oT[2], oT[3]);
            *(uint2*)op = w;
        }
#pragma unroll
        for (int kb = 0; kb < 8; ++kb) {
            const uint2 khu = *(const uint2*)(KH + (16 * kb + c) * 20 + 4 * gq);
            const bf16x8 kh = MK8(khu.x, khu.y, 0u, 0u);
            const f32x4 d4 = *(const f32x4*)(DD + 16 * kb + 4 * gq);
            S[kb] = __builtin_amdgcn_mfma_f32_16x16x32_bf16(kh, vtf, S[kb] * d4, 0, 0, 0);
        }
        __syncthreads();
    }
    if (MODE == 0) {
#pragma unroll
        for (int kb = 0; kb < 8; ++kb)
#pragma unroll
            for (int r = 0; r < 4; ++r) sst[(16 * kb + 4 * gq + r) * 64 + 16 * wid + c] = S[kb][r];
        if (hf == 0) ((float*)(p.ws + WS_DSEG))[(size_t)(chain * 33 + g) * 128 + k] = fexp(btot);
    }
#undef HG_ROW
#undef HG_PREFETCH
}

struct H1Pre { bf16_t z0, z1, z2, z3, z4, z5, z6, z7; uint2 vv; };
struct H1Ctx { int r0, sgn, zoff, hv, chain, g; float lbv, omlb, btot; f32x4 S[8]; };
__device__ void hgrn_h1_pair(const Params& p, int l, int b, int h, int g, char* smem) {
    const int tid = opaque_tid(), lane = tid & 63, wid = tid >> 6, c = lane & 15, gq = lane >> 4;
    const int k = tid >> 1, hf = tid & 1, vt_t = tid >> 4, vt_v4 = (tid & 15) * 4;
    const bf16_t* HG = (const bf16_t*)(p.ws + WS_HG);
    auto init = [&](H1Ctx& X, int dir) {
        if (dir == 0) { X.r0 = g == 0 ? T_LAT + b * 256 : b * 8192 + (g - 1) * 256; X.sgn = 1; }
        else { X.r0 = g == 0 ? T_LAT + b * 256 + 255 : b * 8192 + 8191 - (g - 1) * 256; X.sgn = -1; }
        X.lbv = ((const float*)(p.ws + WS_LB))[(dir * 4 + l) * 512 + h * 128 + k]; X.omlb = 1.0f - X.lbv;
        X.zoff = 512 + dir * 512 + h * 128 + k; X.hv = 1536 + h * 64 + vt_v4; X.chain = (dir * 4 + b) * 4 + h; X.g = g; X.btot = 0.f;
#pragma unroll
        for (int kb = 0; kb < 8; ++kb) X.S[kb] = (f32x4){0.f, 0.f, 0.f, 0.f};
    };
    auto prefetch = [&](const H1Ctx& X, H1Pre& R, int sc) {
        const bf16_t* zb = HG + X.zoff;
#define H1_ROW(T) ((size_t)(X.r0 + X.sgn * (sc * 16 + (T))) * 2048)
        R.z0 = zb[H1_ROW(hf * 8 + 0)]; R.z1 = zb[H1_ROW(hf * 8 + 1)]; R.z2 = zb[H1_ROW(hf * 8 + 2)]; R.z3 = zb[H1_ROW(hf * 8 + 3)];
        R.z4 = zb[H1_ROW(hf * 8 + 4)]; R.z5 = zb[H1_ROW(hf * 8 + 5)]; R.z6 = zb[H1_ROW(hf * 8 + 6)]; R.z7 = zb[H1_ROW(hf * 8 + 7)];
        R.vv = *(const uint2*)(HG + H1_ROW(vt_t) + X.hv);
#undef H1_ROW
    };
    auto elem = [&](H1Ctx& X, const H1Pre& R, char* sm) {
        bf16_t* KH = (bf16_t*)(sm + HG_KH); bf16_t* VT = (bf16_t*)(sm + HG_VT); float* DD = (float*)(sm + HG_DD);
        const bf16_t zz[8] = {R.z0, R.z1, R.z2, R.z3, R.z4, R.z5, R.z6, R.z7};
        float bt[8], ky[8]; float cum = 0.f;
#pragma unroll
        for (int i = 0; i < 8; ++i) {
            const float e = fexp(-bf2f(zz[i]));
            const float sg = __builtin_amdgcn_rcpf(1.0f + e);
            cum += __builtin_amdgcn_logf(fmaxf(X.lbv + X.omlb * sg, 1e-30f)) * 0.6931471805599453f;
            bt[i] = cum; ky[i] = X.omlb * (1.0f - sg);
        }
        const float other = __shfl_xor(cum, 1);
        const float blast = cum + other, add = hf ? other : 0.f;
#pragma unroll
        for (int i = 0; i < 8; ++i) KH[k * 20 + hf * 8 + i] = f2bf(ky[i] * fexp(blast - (bt[i] + add)));
        if (hf == 0) DD[k] = fexp(blast);
        X.btot += blast;
        VT[(vt_v4 + 0) * 20 + vt_t] = (bf16_t)(R.vv.x & 0xffff); VT[(vt_v4 + 1) * 20 + vt_t] = (bf16_t)(R.vv.x >> 16);
        VT[(vt_v4 + 2) * 20 + vt_t] = (bf16_t)(R.vv.y & 0xffff); VT[(vt_v4 + 3) * 20 + vt_t] = (bf16_t)(R.vv.y >> 16);
    };
    auto update = [&](H1Ctx& X, const char* sm) {
        const bf16_t* KH = (const bf16_t*)(sm + HG_KH); const bf16_t* VT = (const bf16_t*)(sm + HG_VT); const float* DD = (const float*)(sm + HG_DD);
        const uint2 vtu = *(const uint2*)(VT + (16 * wid + c) * 20 + 4 * gq);
        const bf16x8 vtf = MK8(vtu.x, vtu.y, 0u, 0u);
#pragma unroll
        for (int kb = 0; kb < 8; ++kb) {
            const uint2 khu = *(const uint2*)(KH + (16 * kb + c) * 20 + 4 * gq);
            const f32x4 d4 = *(const f32x4*)(DD + 16 * kb + 4 * gq);
            X.S[kb] = __builtin_amdgcn_mfma_f32_16x16x32_bf16(MK8(khu.x, khu.y, 0u, 0u), vtf, X.S[kb] * d4, 0, 0, 0);
        }
    };
    auto store = [&](H1Ctx& X) {
        float* sst = (float*)(p.ws + WS_SST) + (size_t)(X.chain * 33 + X.g) * 8192;
#pragma unroll
        for (int kb = 0; kb < 8; ++kb)
#pragma unroll
            for (int r = 0; r < 4; ++r) sst[(16 * kb + 4 * gq + r) * 64 + 16 * wid + c] = X.S[kb][r];
        if (hf == 0) ((float*)(p.ws + WS_DSEG))[(size_t)(X.chain * 33 + X.g) * 128 + k] = fexp(X.btot);
    };
    H1Ctx A, B; H1Pre A0, A1, B0, B1;
    init(A, 0); init(B, 1);
    prefetch(A, A0, 0); prefetch(B, B0, 0); prefetch(A, A1, 1); prefetch(B, B1, 1);
    for (int sc = 0; sc < 16; sc += 2) {
        elem(A, A0, smem); elem(B, B0, smem + 17408);
        __syncthreads();
        { const int scn = sc + 2 < 16 ? sc + 2 : 15; prefetch(A, A0, scn); prefetch(B, B0, scn); }
        update(A, smem); update(B, smem + 17408);
        __syncthreads();
        elem(A, A1, smem); elem(B, B1, smem + 17408);
        __syncthreads();
        { const int scn = sc + 3 < 16 ? sc + 3 : 15; prefetch(A, A1, scn); prefetch(B, B1, scn); }
        update(A, smem); update(B, smem + 17408);
        __syncthreads();
    }
    store(A); store(B);
}
__device__ void hgrn3_unit(const Params& p, int l, int u, char* smem) {
    const int tb = u % 33, bh = u / 33, h = bh & 3, b = bh >> 2;
    hgrn_pass<1>(p, l, 0, b, h, tb, smem);
    hgrn_pass<2>(p, l, 1, b, h, tb == 0 ? 0 : 33 - tb, smem);
    const int ti = opaque_tid();
    const int row = tb == 0 ? T_LAT + b * 256 + ti : b * 8192 + (tb - 1) * 256 + ti;
    const bf16_t* OSEG = (const bf16_t*)(smem + HG_OSEG) + ti * 68;
    const bf16_t* gp = (const bf16_t*)(p.ws + WS_HG) + (size_t)row * 2048 + 1792 + h * 64;
    const float* gn = p.hg_norm_g + l * 64;
    bf16_t* yp = (bf16_t*)(p.ws + WS_H) + (size_t)row * 1024 + 768 + h * 64;
    float ss = 0.f;
#pragma unroll
    for (int q = 0; q < 16; ++q) {
        const uint2 w = *(const uint2*)(OSEG + q * 4);
        const float a0 = __uint_as_float(w.x << 16), a1 = __uint_as_float(w.x & 0xffff0000u), a2 = __uint_as_float(w.y << 16), a3 = __uint_as_float(w.y & 0xffff0000u);
        ss += a0 * a0 + a1 * a1 + a2 * a2 + a3 * a3;
    }
    const float rinv = rsqrtf(ss * (1.0f / 64.0f) + EPS);
#pragma unroll
    for (int q = 0; q < 16; ++q) {
        const uint2 w = *(const uint2*)(OSEG + q * 4);
        const uint2 gw = *(const uint2*)(gp + q * 4);
        float o[4] = {__uint_as_float(w.x << 16), __uint_as_float(w.x & 0xffff0000u), __uint_as_float(w.y << 16), __uint_as_float(w.y & 0xffff0000u)};
        const float gt[4] = {__uint_as_float(gw.x << 16), __uint_as_float(gw.x & 0xffff0000u), __uint_as_float(gw.y << 16), __uint_as_float(gw.y & 0xffff0000u)};
#pragma unroll
        for (int j = 0; j < 4; ++j) { const float sl = gt[j] / (1.0f + fexp(-gt[j])); o[j] = o[j] * rinv * gn[q * 4 + j] * sl; }
        uint2 ow; ow.x = pack2(o[0], o[1]); ow.y = pack2(o[2], o[3]);
        *(uint2*)(yp + q * 4) = ow;
    }
    __syncthreads();
}

__device__ void convert_T(const float* in, int K, int Nin, bf16_t* out, int Nout, int mode, const float* gs, size_t gtid, size_t gthreads) {
    const size_t total = (size_t)Nout * (K / 8);
    for (size_t idx = gtid; idx < total; idx += gthreads) {
        const int n = (int)(idx % Nout), k8 = (int)(idx / Nout);
        int src = n;
        if (mode == 1) {
            if (n < 1536) src = n; else if (n < 3584) src = n + 32; else if (n < 3616) src = n - 3584 + 1536; else src = -1;
        } else if (mode == 2) {
            const int hh = n >> 7, d = n & 127; src = d < 96 ? hh * 96 + d : -1;
        }
        float v[8];
#pragma unroll
        for (int j = 0; j < 8; ++j) {
            const int k = k8 * 8 + j;
            v[j] = src >= 0 ? in[(size_t)k * Nin + src] * (gs ? gs[k] : 1.0f) : 0.f;
        }
        uint4 w; w.x = pack2(v[0], v[1]); w.y = pack2(v[2], v[3]); w.z = pack2(v[4], v[5]); w.w = pack2(v[6], v[7]);
        *(uint4*)(out + (size_t)n * K + k8 * 8) = w;
    }
}
__device__ void convert_layer(const Params& p, int l, size_t gtid, size_t gthreads) {
    convert_T(p.w_in + (size_t)l * 1024 * 3616, 1024, 3616, (bf16_t*)(p.ws + WS_WIN), NIN, 1, nullptr, gtid, gthreads);
    convert_T(p.w_out + (size_t)l * 1024 * 1024, 1024, 1024, (bf16_t*)(p.ws + WS_WOUT), 1024, 0, nullptr, gtid, gthreads);
    convert_T(p.w_ff1 + (size_t)l * 1024 * 4096, 1024, 4096, (bf16_t*)(p.ws + WS_WFF1), 4096, 0, nullptr, gtid, gthreads);
    convert_T(p.w_ff2 + (size_t)l * 4096 * 1024, 4096, 1024, (bf16_t*)(p.ws + WS_WFF2), 1024, 0, nullptr, gtid, gthreads);
    convert_T(p.w_uq + (size_t)l * 256 * 576, 256, 576, (bf16_t*)(p.ws + WS_WUQ), 768, 2, p.g_cq + l * 256, gtid, gthreads);
    convert_T(p.w_ukv + (size_t)l * 128 * 768, 128, 768, (bf16_t*)(p.ws + WS_WUKV), 768, 0, p.g_ckv + l * 128, gtid, gthreads);
}
__device__ void adaln_phase(const Params& p, int l, const float* g, int shift_off, int scale_off, int nrows) {
    const int lane = opaque_tid() & 63;
    const int gw = blockIdx.x * 4 + (threadIdx.x >> 6), nw = gridDim.x * 4;
    bf16_t* H = (bf16_t*)(p.ws + WS_H);
    const bool from_input = (l == 0 && shift_off == 0);
    f32x4 v0, v1, v2, v3, n0, n1, n2, n3;
    v0 = v1 = v2 = v3 = n0 = n1 = n2 = n3 = (f32x4){0.f, 0.f, 0.f, 0.f};
    if (gw < nrows) { const float* xp = (from_input ? xrow_in(p, gw) : xrow(p, gw)) + lane * 4; v0 = *(const f32x4*)(xp); v1 = *(const f32x4*)(xp + 256); v2 = *(const f32x4*)(xp + 512); v3 = *(const f32x4*)(xp + 768); }
    for (int row = gw; row < nrows; row += nw) {
        const int nrow = row + nw;
        if (nrow < nrows) { const float* xp = (from_input ? xrow_in(p, nrow) : xrow(p, nrow)) + lane * 4; n0 = *(const f32x4*)(xp); n1 = *(const f32x4*)(xp + 256); n2 = *(const f32x4*)(xp + 512); n3 = *(const f32x4*)(xp + 768); }
        int b, key; bool lat; row_bk(row, b, key, lat);
        const float* md = (const float*)(p.ws + WS_MOD) + (size_t)(l * 5 + (lat ? b : 4)) * 6144;
        const f32x4 v[4] = {v0, v1, v2, v3};
        float ss = 0.f;
#pragma unroll
        for (int i = 0; i < 4; ++i) ss += v[i][0] * v[i][0] + v[i][1] * v[i][1] + v[i][2] * v[i][2] + v[i][3] * v[i][3];
#pragma unroll
        for (int o = 32; o >= 1; o >>= 1) ss += __shfl_xor(ss, o);
        const float rinv = rsqrtf(ss * (1.0f / 1024.0f) + EPS);
#pragma unroll
        for (int i = 0; i < 4; ++i) {
            const int d = i * 256 + lane * 4;
            const f32x4 gg = *(const f32x4*)(g + d), sh = *(const f32x4*)(md + shift_off + d), sc = *(const f32x4*)(md + scale_off + d);
            float o[4];
#pragma unroll
            for (int j = 0; j < 4; ++j) o[j] = v[i][j] * rinv * gg[j] * (1.0f + sc[j]) + sh[j];
            uint2 w; w.x = pack2(o[0], o[1]); w.y = pack2(o[2], o[3]);
            *(uint2*)(H + (size_t)row * 1024 + d) = w;
        }
        v0 = n0; v1 = n1; v2 = n2; v3 = n3;
    }
}
__device__ void phase0(const Params& p, char* smem) {
    const size_t gtid = (size_t)blockIdx.x * 256 + threadIdx.x, gthreads = (size_t)gridDim.x * 256;
    const int tid = opaque_tid();
    if (gtid < 2 * 512) {
        const int dir = (int)gtid >> 9, cidx = (int)gtid & 511;
        float e[4], mx = -1e30f, s = 0.f;
#pragma unroll
        for (int l = 0; l < 4; ++l) { e[l] = p.hg_lb[(dir * 4 + l) * 512 + cidx]; mx = fmaxf(mx, e[l]); }
#pragma unroll
        for (int l = 0; l < 4; ++l) { e[l] = expf(e[l] - mx); s += e[l]; }
        float cum = 0.f;
#pragma unroll
        for (int l = 0; l < 4; ++l) { if (l > 0) cum += e[l] / s; ((float*)(p.ws + WS_LB))[(dir * 4 + l) * 512 + cidx] = cum; }
    }
    if (gtid >= 1024 && gtid < 1024 + 1024) {
        const int i = (int)gtid - 1024, pos = i >> 3, f = i & 7;
        const float inv = powf(10000.0f, -(float)f / 8.0f);
        const float ang = (float)pos * inv;
        ((float*)(p.ws + WS_ROPE))[i * 2] = cosf(ang); ((float*)(p.ws + WS_ROPE))[i * 2 + 1] = sinf(ang);
    }
    if (gtid >= 2048 && gtid < 2048 + 4) {
        const int l = (int)gtid - 2048;
        float s1 = 0.f, s2 = 0.f;
        for (int i = 0; i < 32; ++i) { s1 += p.da_lambda[(l * 4 + 0) * 32 + i] * p.da_lambda[(l * 4 + 1) * 32 + i]; s2 += p.da_lambda[(l * 4 + 2) * 32 + i] * p.da_lambda[(l * 4 + 3) * 32 + i]; }
        ((float*)(p.ws + WS_LAM))[l] = expf(s1) - expf(s2) + (0.8f - 0.6f * expf(-0.3f * (float)l));
    }
    if (gtid >= 4096 && gtid < 4096 + 512) ((unsigned*)(p.ws + WS_KMAX))[gtid - 4096] = 0u;
    float* sl = (float*)smem;
    float* red = sl + 5 * 1024;
    for (int i = tid; i < 5 * 1024; i += 256) {
        const int r = i >> 10, d = i & 1023;
        const float cv = r < 4 ? p.c[r * 1024 + d] : p.c_ctx[d];
        sl[i] = cv / (1.0f + expf(-cv));
    }
    __syncthreads();
    for (int u = blockIdx.x; u < 4 * 96; u += gridDim.x) {
        const int l = u / 96, cb = u % 96, col = tid & 63, kg = tid >> 6;
        const float* w = p.w_mod + (size_t)l * 1024 * 6144 + cb * 64 + col;
        float a[5] = {0.f, 0.f, 0.f, 0.f, 0.f};
        for (int d = kg * 256; d < kg * 256 + 256; ++d) {
            const float wv = w[(size_t)d * 6144];
#pragma unroll
            for (int r = 0; r < 5; ++r) a[r] += sl[r * 1024 + d] * wv;
        }
#pragma unroll
        for (int r = 0; r < 5; ++r) red[(kg * 5 + r) * 64 + col] = a[r];
        __syncthreads();
        if (tid < 64) {
#pragma unroll
            for (int r = 0; r < 5; ++r) {
                const float s = red[(0 * 5 + r) * 64 + tid] + red[(1 * 5 + r) * 64 + tid] + red[(2 * 5 + r) * 64 + tid] + red[(3 * 5 + r) * 64 + tid];
                ((float*)(p.ws + WS_MOD))[(size_t)(l * 5 + r) * 6144 + cb * 64 + tid] = s + p.b_mod[l * 6144 + cb * 64 + tid];
            }
        }
        __syncthreads();
    }
}
__device__ void hgrn_scan(const Params& p) {
    const size_t gtid = (size_t)blockIdx.x * 256 + opaque_tid(), gthreads = (size_t)gridDim.x * 256;
    float* sstb = (float*)(p.ws + WS_SST);
    const float* dseg = (const float*)(p.ws + WS_DSEG);
    for (size_t i = gtid; i < (size_t)32 * 8192; i += gthreads) {
        const int chain = (int)(i >> 13), e = (int)(i & 8191), k = e >> 6;
        float S = 0.f;
        float* sp = sstb + (size_t)chain * 33 * 8192 + e;
        const float* dp = dseg + (size_t)chain * 33 * 128 + k;
#pragma unroll 1
        for (int g0 = 0; g0 < 33; g0 += 11) {
            float t[11], d[11];
#pragma unroll
            for (int q = 0; q < 11; ++q) { t[q] = sp[(size_t)(g0 + q) * 8192]; d[q] = dp[(g0 + q) * 128]; }
#pragma unroll
            for (int q = 0; q < 11; ++q) { sp[(size_t)(g0 + q) * 8192] = S; S = d[q] * S + t[q]; }
        }
    }
}
__device__ void final_norm(const Params& p) {
    const int lane = opaque_tid() & 63;
    const int gw = blockIdx.x * 4 + (threadIdx.x >> 6), nw = gridDim.x * 4;
    for (int row = gw; row < T_LAT; row += nw) {
        float* xp = p.out + (size_t)row * 1024;
        f32x4 v[4]; float ss = 0.f;
#pragma unroll
        for (int i = 0; i < 4; ++i) { v[i] = *(const f32x4*)(xp + i * 256 + lane * 4); ss += v[i][0] * v[i][0] + v[i][1] * v[i][1] + v[i][2] * v[i][2] + v[i][3] * v[i][3]; }
#pragma unroll
        for (int o = 32; o >= 1; o >>= 1) ss += __shfl_xor(ss, o);
        const float rinv = rsqrtf(ss * (1.0f / 1024.0f) + EPS);
#pragma unroll
        for (int i = 0; i < 4; ++i) {
            const f32x4 gg = *(const f32x4*)(p.g_final + i * 256 + lane * 4);
            f32x4 o;
#pragma unroll
            for (int j = 0; j < 4; ++j) o[j] = v[i][j] * rinv * gg[j];
            *(f32x4*)(xp + i * 256 + lane * 4) = o;
        }
    }
}


#define XB_TMO      128
#define XB_XCNT(j)  (256  + 64 * (j))
#define XB_XSUB(j)  (1280 + 64 * (j))
#define XB_XGEN(j)  (2304 + 64 * (j))
#define XB_TOP      3328
#define XB_TOPGEN   3392
#define XCD_BAR_WORDS 3456
#define XB_SPIN_CAP (1u << 22)
__device__ __forceinline__ unsigned xb_ld(unsigned* p)              { return __hip_atomic_load(p, __ATOMIC_RELAXED, __HIP_MEMORY_SCOPE_AGENT); }
__device__ __forceinline__ unsigned xb_add(unsigned* p, unsigned v) { return __hip_atomic_fetch_add(p, v, __ATOMIC_RELAXED, __HIP_MEMORY_SCOPE_AGENT); }
__device__ __forceinline__ unsigned xb_xcc_id() { return (unsigned)__builtin_amdgcn_s_getreg((3 << 11) | 20) & 0xFu; }
#define XB_SPIN(cond, bar) do { unsigned _sp = 0; while (cond) { __builtin_amdgcn_s_sleep(1); \
    if ((++_sp & 255u) == 0u) { if (xb_ld(&(bar)[XB_TMO])) break; if (_sp > XB_SPIN_CAP) { atomicAdd(&(bar)[XB_TMO], 1u); break; } } } } while (0)
__device__ __forceinline__ void xcd_barrier_complete(unsigned* bar, unsigned x, unsigned& nloc, unsigned& nx) {
    const unsigned G = gridDim.x;
    unsigned sum, cnt, mine, sp = 0u;
    for (;;) {
        sum = 0u; cnt = 0u; mine = 0u;
#pragma unroll
        for (unsigned j = 0; j < 16; ++j) { const unsigned c = xb_ld(&bar[XB_XCNT(j)]); sum += c; cnt += (c > 0u) ? 1u : 0u; mine = (j == x) ? c : mine; }
        if (sum == G) break;
        __builtin_amdgcn_s_sleep(1);
        if ((++sp & 255u) == 0u) { if (xb_ld(&bar[XB_TMO])) break; if (sp > XB_SPIN_CAP) { atomicAdd(&bar[XB_TMO], 1u); break; } }
    }
    nloc = mine > 0u ? mine : 1u; nx = cnt > 0u ? cnt : 1u;
}
__device__ __forceinline__ void gsync(char* ws, unsigned& epoch) {
    asm volatile("s_waitcnt vmcnt(0) lgkmcnt(0)" ::: "memory");
    __syncthreads();
    ++epoch;
    if (threadIdx.x == 0) {
        extern __shared__ __attribute__((aligned(16))) char smem_[];
        volatile unsigned* st = (volatile unsigned*)(smem_ + 73728 + 768);
        unsigned* bar = (unsigned*)(ws + WS_XBAR);
        const unsigned x = xb_xcc_id();
        __builtin_amdgcn_s_waitcnt(0);
        unsigned nloc = st[0], nx = st[1];
        if (nloc == 0u) { xcd_barrier_complete(bar, x, nloc, nx); st[0] = nloc; st[1] = nx; }
        const unsigned old = xb_add(&bar[XB_XSUB(x)], 1u);
        const unsigned gen = old / nloc;
        if (old + 1u == (gen + 1u) * nloc) {
            __builtin_amdgcn_fence(__ATOMIC_RELEASE, "agent");
            asm volatile("s_waitcnt vmcnt(0)" ::: "memory");
            const unsigned og = xb_add(&bar[XB_TOP], 1u);
            const unsigned tg = og / nx;
            if (og + 1u == (tg + 1u) * nx) xb_add(&bar[XB_TOPGEN], 1u);
            else XB_SPIN(xb_ld(&bar[XB_TOPGEN]) == tg, bar);
            __builtin_amdgcn_fence(__ATOMIC_ACQUIRE, "agent");
            xb_add(&bar[XB_XGEN(x)], 1u);
            asm volatile("s_waitcnt vmcnt(0)" ::: "memory");
        } else {
            XB_SPIN(xb_ld(&bar[XB_XGEN(x)]) == gen, bar);
            __builtin_amdgcn_fence(__ATOMIC_ACQUIRE, "agent");
            asm volatile("s_waitcnt vmcnt(0)" ::: "memory");
        }
    }
    __syncthreads();
}

__device__ __forceinline__ int next_unit(char* ws, int qidx, char* smem) {
    int* sh = (int*)(smem + 73728 + 512);
    __syncthreads();
    if (threadIdx.x == 0) *sh = (int)__hip_atomic_fetch_add((unsigned*)(ws + WS_BAR + 32) + qidx, 1u, __ATOMIC_RELAXED, __HIP_MEMORY_SCOPE_AGENT);
    __syncthreads();
    return *sh;
}

__device__ __forceinline__ bool tile_of(int r, int nt, int total, int& tm, int& tn, int G = 8) {
    const int bx = blockIdx.x, nx = gridDim.x >> 3;
    const int L = (r * 8 + (bx & 7)) * nx + (bx >> 3);
    if (L >= total || nx != 64) { if (nx == 64) return false; const int u = bx + r * gridDim.x; if (u >= total) return false; tm = u / nt; tn = u % nt; return true; }
    const int mg = L / (nt * G), rem = L % (nt * G);
    tn = rem / G; tm = mg * G + (rem % G);
    return true;
}
__device__ __forceinline__ Params launder(const Params& p) {
    Params q = p;
    GAS char* w = (GAS char*)p.ws; GAS float* o = (GAS float*)p.out;
    asm volatile("" : "+s"(w), "+s"(o));
    q.ws = (char*)w; q.out = (float*)o;
    return q;
}
__global__ void __launch_bounds__(256, 2) fwd_megakernel(Params p0) {
    extern __shared__ __attribute__((aligned(16))) char smem[];
    cg::grid_group grid = cg::this_grid();
    const size_t gtid = (size_t)blockIdx.x * 256 + threadIdx.x, gthreads = (size_t)gridDim.x * 256;
    float* rs = (float*)(smem + 73728);
    unsigned epoch = 0;
    if (threadIdx.x == 0) { volatile unsigned* st = (volatile unsigned*)(smem + 73728 + 768); st[0] = 0u; st[1] = 0u; (void)xb_add((unsigned*)(p0.ws + WS_XBAR) + XB_XCNT(xb_xcc_id()), 1u); }
    __syncthreads();
    grid.sync();

#ifndef OPK
#define OPK 1024
#define OPK0 0
#endif
#ifndef REP_SKIP_ATT
#define REP_SKIP_ATT 0
#endif
#ifndef REP_B
#define REP_B 1
#endif
#ifndef REP_D
#define REP_D 1
#endif
#ifndef REP_E
#define REP_E 1
#endif
#ifndef REP_H
#define REP_H 1
#endif
#ifndef PM
#define PM 0xffff
#endif
    { const Params p = launder(p0); if (PM & 1) phase0(p, smem); }
    { const Params p = launder(p0); if (PM & 2) convert_layer(p, 0, gtid, gthreads); }
    gsync(p0.ws, epoch);

    for (int l = 0; l < 4; ++l) {
        const bool last = (l == 3);
        { const Params p = launder(p0); if (PM & 4) adaln_phase(p, l, p.g_mix + l * 1024, 0, 1024, T_ALL); }
        { const Params p = launder(p0); if ((PM & 2) && l > 0) convert_layer(p, l, gtid, gthreads); }
        gsync(p0.ws, epoch);
        if (PM & 8) for (int rr = 0;; ++rr) {
            int tm, tn; if (!tile_of(rr, 29, 132 * 29, tm, tn, 4)) break;
            const Params p = launder(p0);
            Acc2 C;
            gemm_tile_core2((const bf16_t*)(p.ws + WS_H) + (size_t)tm * 256 * 1024, 1024, (const bf16_t*)(p.ws + WS_WIN) + (size_t)tn * 128 * 1024, 1024, 1024, smem, C);
            gemm2_stage(C, 0, smem);
            epi_inproj(p, l, tm * 256, tn, (const float*)smem);
            __syncthreads();
            gemm2_stage(C, 1, smem);
            epi_inproj(p, l, tm * 256 + 128, tn, (const float*)smem);
            __syncthreads();
        }
        gsync(p0.ws, epoch);
        for (int rep = 0; rep < REP_D; ++rep) { if (rep) gsync(p0.ws, epoch);
        for (;;) {
            const int u = next_unit(p0.ws, l * 2 + 0 + rep * 8, smem);
            if (u >= 528 + 2 * 1584) break;
            const Params p = launder(p0);
            if (u < 528) { if (PM & 16) {
                const int g = u % 33, ch = u / 33, h = ch & 3, b = (ch >> 2) & 3;
                hgrn_h1_pair(p, l, b, h, g, smem); }
            } else if (!(PM & 32)) {} else if (u < 528 + 1584) {
                const int v = u - 528, tm = v / 6, h = v % 6;
                row_rstd(p, 0, tm * 128, rs);
                gemm_tile_core((const bf16_t*)(p.ws + WS_CQ) + (size_t)tm * 128 * 256, 256, (const bf16_t*)(p.ws + WS_WUQ) + (size_t)h * 128 * 256, 256, 256, smem);
                epi_uq(p, tm * 128, h, (const float*)smem, rs);
                __syncthreads();
            } else {
                const int v = u - 528 - 1584, tm = v / 6, h = v % 6;
                row_rstd(p, 1, tm * 128, rs);
                gemm_tile_core((const bf16_t*)(p.ws + WS_CKV) + (size_t)tm * 128 * 128, 128, (const bf16_t*)(p.ws + WS_WUKV) + (size_t)h * 128 * 128, 128, 128, smem);
                epi_ukv(p, l, tm * 128, h, (const float*)smem, rs);
                __syncthreads();
            }
        } }
        gsync(p0.ws, epoch);
        { const Params p = launder(p0); if (PM & 64) hgrn_scan(p); }
        gsync(p0.ws, epoch);
        {
            { int* st2 = (int*)(smem + 73728 + 520); __syncthreads(); if (threadIdx.x == 0) { st2[0] = 0; } }
            for (;;) {
                    int* sh = (int*)(smem + 73728 + 512);
                    __syncthreads();
                    if (threadIdx.x == 0) {
                        const int qlen_ = 450 + (l == 3 ? 0 : 12);
                        const unsigned xq_ = xb_xcc_id() & 7u;
                        int dq_ = sh[2], got = -1, qq = 0;
                        while (dq_ < 8) {
                            qq = (int)((xq_ + dq_) & 7u);
                            const int v = (int)__hip_atomic_fetch_add((unsigned*)(p0.ws + WS_XBAR) + l * 8 + qq, 1u, __ATOMIC_RELAXED, __HIP_MEMORY_SCOPE_AGENT);
                            if (v < qlen_) { got = v; break; }
                            ++dq_;
                        }
                        sh[2] = dq_; sh[0] = got; sh[1] = qq;
                    }
                    __syncthreads();
                    const int i = __builtin_amdgcn_readfirstlane(sh[0]), q = __builtin_amdgcn_readfirstlane(sh[1]);
                    if (i < 0) break;
                    const Params p = launder(p0);
                    const int nh3 = (i + 2) / 3 < 66 ? (i + 2) / 3 : 66;
                    if (i < 450 && i % 3 == 0 && i / 3 < 66) { if (PM & 256) hgrn3_unit(p, l, q * 66 + i / 3, smem); }
                    else {
                        int b, hh, qbi;
                        if (i < 450) { const int a = i - nh3; const int bh = q + 8 * (a >> 6); qbi = a & 63; b = (bh / 6) & 3; hh = (bh >= 24 ? 6 : 0) + bh % 6; }
                        else { const int cidx = q * 12 + (i - 450); qbi = 64 + (cidx & 1); const int bh = cidx >> 1; hh = bh % 12; b = bh / 12; }
                        if (PM & 128) attn_unit(p, l, b, hh, qbi, smem);
                    }
            }
        }
        gsync(p0.ws, epoch);
        const int ntm = last ? 256 : 264;
        if (PM & 512) {
            if (!last && blockIdx.x < 64) {
                const Params p = launder(p0);
                const int tm = 256 + (blockIdx.x >> 3), tn = blockIdx.x & 7;
                gemm_tile_core((const bf16_t*)(p.ws + WS_H) + (size_t)tm * 128 * 1024, 1024, (const bf16_t*)(p.ws + WS_WOUT) + (size_t)tn * 128 * 1024, 1024, 1024, smem);
                epi_resid(p, l, tm * 128, tn * 128, 2 * 1024, (const float*)smem);
                __syncthreads();
            }
            for (int rr = 0;; ++rr) {
                int tm, tn; if (!tile_of(rr, 8, 128 * 8, tm, tn, 4)) break;
                const Params p = launder(p0);
                Acc2 C;
                gemm_tile_core2((const bf16_t*)(p.ws + WS_H) + (size_t)tm * 256 * 1024, 1024, (const bf16_t*)(p.ws + WS_WOUT) + (size_t)tn * 128 * 1024, 1024, 1024, smem, C);
                gemm2_stage(C, 0, smem);
                epi_resid(p, l, tm * 256, tn * 128, 2 * 1024, (const float*)smem);
                __syncthreads();
                gemm2_stage(C, 1, smem);
                epi_resid(p, l, tm * 256 + 128, tn * 128, 2 * 1024, (const float*)smem);
                __syncthreads();
            }
        }
        gsync(p0.ws, epoch);
        { const Params p = launder(p0); adaln_phase(p, l, p.g_mlp + l * 1024, 3 * 1024, 4 * 1024, ntm * 128); }
        gsync(p0.ws, epoch);
        if (PM & 1024) for (int rr = 0;; ++rr) {
            int tm, tn; if (!tile_of(rr, 32, (ntm / 2) * 32, tm, tn, 4)) break;
            const Params p = launder(p0);
            Acc2 C;
            gemm_tile_core2((const bf16_t*)(p.ws + WS_H) + (size_t)tm * 256 * 1024, 1024, (const bf16_t*)(p.ws + WS_WFF1) + (size_t)tn * 128 * 1024, 1024, 1024, smem, C);
            gemm2_stage(C, 0, smem);
            epi_ff1(p, tm * 256, tn * 128, (const float*)smem);
            __syncthreads();
            gemm2_stage(C, 1, smem);
            epi_ff1(p, tm * 256 + 128, tn * 128, (const float*)smem);
            __syncthreads();
        }
        gsync(p0.ws, epoch);
        if (PM & 2048) {
            if (!last && blockIdx.x < 64) {
                const Params p = launder(p0);
                const int tm = 256 + (blockIdx.x >> 3), tn = blockIdx.x & 7;
                gemm_tile_core((const bf16_t*)(p.ws + WS_H1) + (size_t)tm * 128 * 4096, 4096, (const bf16_t*)(p.ws + WS_WFF2) + (size_t)tn * 128 * 4096, 4096, 4096, smem);
                epi_resid(p, l, tm * 128, tn * 128, 5 * 1024, (const float*)smem);
                __syncthreads();
            }
            for (int rr = 0;; ++rr) {
                int tm, tn; if (!tile_of(rr, 8, 128 * 8, tm, tn, 4)) break;
                const Params p = launder(p0);
                Acc2 C;
                gemm_tile_core2((const bf16_t*)(p.ws + WS_H1) + (size_t)tm * 256 * 4096, 4096, (const bf16_t*)(p.ws + WS_WFF2) + (size_t)tn * 128 * 4096, 4096, 4096, smem, C);
                gemm2_stage(C, 0, smem);
                epi_resid(p, l, tm * 256, tn * 128, 5 * 1024, (const float*)smem);
                __syncthreads();
                gemm2_stage(C, 1, smem);
                epi_resid(p, l, tm * 256 + 128, tn * 128, 5 * 1024, (const float*)smem);
                __syncthreads();
            }
        }
        gsync(p0.ws, epoch);
    }
    { const Params p = launder(p0); final_norm(p); }
}

extern "C" void kernel_launch(void* const* d_in, const int* in_sizes, int n_in, void* d_out, int out_size, void* d_ws, size_t ws_size, hipStream_t stream) {
    static int grid_blocks = 0;
    if (!grid_blocks) {
        int dev = 0, cus = 0, per_cu = 0;
        hipGetDevice(&dev);
        hipDeviceGetAttribute(&cus, hipDeviceAttributeMultiprocessorCount, dev);
        hipFuncSetAttribute((const void*)fwd_megakernel, hipFuncAttributeMaxDynamicSharedMemorySize, SMEM_BYTES);
        hipOccupancyMaxActiveBlocksPerMultiprocessor(&per_cu, (const void*)fwd_megakernel, 256, SMEM_BYTES);
        if (per_cu < 1) per_cu = 1;
        if (per_cu > 2) per_cu = 2;
        grid_blocks = cus * per_cu;
        if (ws_size < WS_END2) fprintf(stderr, "workspace too small: %zu < %zu\n", ws_size, (size_t)WS_END2);
    }
    hipMemsetAsync((char*)d_ws + WS_BAR, 0, 128, stream);
    hipMemsetAsync((char*)d_ws + WS_XBAR, 0, XCD_BAR_WORDS * 4, stream);
    Params p{};
    const float** pp = (const float**)&p;
    for (int i = 0; i < 21; ++i) pp[i] = (const float*)d_in[i];
    p.out = (float*)d_out; p.ws = (char*)d_ws;
    void* args[] = {&p};
    hipError_t e = hipLaunchCooperativeKernel((const void*)fwd_megakernel, dim3(grid_blocks), dim3(256), args, SMEM_BYTES, stream);
    if (e != hipSuccess) fprintf(stderr, "cooperative launch failed: %s (grid %d)\n", hipGetErrorString(e), grid_blocks);
}
```

```cpp
#include <hip/hip_runtime.h>
#include <hip/hip_cooperative_groups.h>
#include <stdint.h>
#include <cstdio>
namespace cg = cooperative_groups;

#define GAS __attribute__((address_space(1)))
typedef unsigned short bf16_t;
typedef short bf16x8 __attribute__((ext_vector_type(8)));
typedef short bf16x4 __attribute__((ext_vector_type(4)));
typedef float f32x16 __attribute__((ext_vector_type(16)));
typedef float f32x4 __attribute__((ext_vector_type(4)));
typedef unsigned u32x4 __attribute__((ext_vector_type(4)));
typedef unsigned u32x2 __attribute__((ext_vector_type(2)));
#define MK8(a,b,c,d) __builtin_bit_cast(bf16x8, (u32x4){(a),(b),(c),(d)})
#define MK4(a,b) __builtin_bit_cast(bf16x4, (u32x2){(a),(b)})

constexpr int T_LAT = 32768, T_CTX = 1024, T_ALL = 33792, NKEY = 8448, DM = 1024, NIN = 3712, DFF = 4096;
constexpr float EPS = 1e-6f;
constexpr float LOG2E = 1.4426950408889634f;

constexpr size_t WS_WIN = 0;
constexpr size_t WS_WOUT = WS_WIN + (size_t)NIN * 1024 * 2;
constexpr size_t WS_WFF1 = WS_WOUT + (size_t)1024 * 1024 * 2;
constexpr size_t WS_WFF2 = WS_WFF1 + (size_t)4096 * 1024 * 2;
constexpr size_t WS_WUQ = WS_WFF2 + (size_t)4096 * 1024 * 2;
constexpr size_t WS_WUKV = WS_WUQ + (size_t)768 * 256 * 2;
constexpr size_t WS_XC = WS_WUKV + (size_t)768 * 128 * 2;
constexpr size_t WS_MOD = WS_XC + (size_t)1024 * 1024 * 4;
constexpr size_t WS_LB = WS_MOD + (size_t)4 * 5 * 6144 * 4;
constexpr size_t WS_LAM = WS_LB + (size_t)2 * 4 * 512 * 4;
constexpr size_t WS_ROPE = WS_LAM + 256;
constexpr size_t WS_KMAX = WS_ROPE + 8192;
constexpr size_t WS_DSEG = WS_KMAX + 2048;
constexpr size_t WS_H = WS_DSEG + (size_t)32 * 33 * 128 * 4;
constexpr size_t WS_R = WS_H + (size_t)T_ALL * 1024 * 2;
constexpr size_t WS_QDA = WS_R;
constexpr size_t WS_KDA = WS_QDA + (size_t)T_ALL * 384 * 2;
constexpr size_t WS_VDAT = WS_KDA + (size_t)T_ALL * 384 * 2;
constexpr size_t WS_QMLA = WS_VDAT + (size_t)T_ALL * 384 * 2;
constexpr size_t WS_KMLA = WS_QMLA + (size_t)T_ALL * 576 * 2;
constexpr size_t WS_VMLAT = WS_KMLA + (size_t)T_ALL * 576 * 2;
constexpr size_t WS_CQ = WS_VMLAT + (size_t)T_ALL * 384 * 2;
constexpr size_t WS_CKV = WS_CQ + (size_t)T_ALL * 256 * 2;
constexpr size_t WS_KR = WS_CKV + (size_t)T_ALL * 128 * 2;
constexpr size_t WS_HG = WS_KR + (size_t)T_ALL * 32 * 2;
constexpr size_t WS_SST = WS_HG + (size_t)T_ALL * 2048 * 2;
constexpr size_t WS_END = WS_SST + (size_t)32 * 33 * 8192 * 4;
constexpr size_t WS_XBAR = WS_END;
constexpr size_t WS_SSQ = WS_XBAR + 16384;
constexpr size_t WS_END2 = WS_SSQ + (size_t)T_ALL * 4 * 4;
constexpr size_t WS_H1 = WS_R;
constexpr size_t WS_BAR = WS_LAM + 128;
static_assert(WS_R + (size_t)T_ALL * 4096 * 2 <= WS_END + (64u << 20), "h1 overlay");
static_assert(WS_END2 <= 536870912ull, "workspace too large");
static_assert(WS_R + (size_t)T_ALL * 4096 * 2 <= 536870912ull, "workspace too large (h1)");

constexpr int SMEM_BYTES = 73728 + 1024;

struct Params {
    const float *x, *c, *ctx, *c_ctx, *w_mod, *b_mod, *g_mix, *g_mlp, *w_in, *w_out, *da_lambda, *da_subln_g, *g_cq, *g_ckv, *w_uq, *w_ukv, *hg_lb, *hg_norm_g, *w_ff1, *w_ff2, *g_final;
    float* out;
    char* ws;
};

__device__ __forceinline__ int opaque_tid() { int t = threadIdx.x; asm volatile("" : "+v"(t)); return t; }
__device__ __forceinline__ bf16_t f2bf(float f) { unsigned u = __float_as_uint(f); u += 0x7fffu + ((u >> 16) & 1u); return (bf16_t)(u >> 16); }
__device__ __forceinline__ float bf2f(bf16_t h) { return __uint_as_float(((unsigned)h) << 16); }
typedef __bf16 bf16v2_t __attribute__((ext_vector_type(2)));
typedef float f32v2_t __attribute__((ext_vector_type(2)));
__device__ __forceinline__ unsigned pack2(float a, float b) { const f32v2_t f = {a, b}; const bf16v2_t r = __builtin_convertvector(f, bf16v2_t); return __builtin_bit_cast(unsigned, r); }
__device__ __forceinline__ unsigned cvt_pk(float lo, float hi) { return pack2(lo, hi); }
__device__ __forceinline__ float ld_coh(const float* p) { return __hip_atomic_load(p, __ATOMIC_RELAXED, __HIP_MEMORY_SCOPE_AGENT); }
__device__ __forceinline__ float fexp2(float x) { return __builtin_amdgcn_exp2f(x); }
__device__ __forceinline__ float fexp(float x) { return __builtin_amdgcn_exp2f(x * LOG2E); }

__device__ __forceinline__ void row_bk(int row, int& b, int& key, bool& lat) {
    if (row < T_LAT) { b = row >> 13; key = 256 + (row & 8191); lat = true; }
    else { int r = row - T_LAT; b = r >> 8; key = r & 255; lat = false; }
}
__device__ __forceinline__ const float* xrow_in(const Params& p, int row) {
    return row < T_LAT ? p.x + (size_t)row * 1024 : p.ctx + (size_t)(row - T_LAT) * 1024;
}
__device__ __forceinline__ float* xrow(const Params& p, int row) {
    return row < T_LAT ? p.out + (size_t)row * 1024 : (float*)(p.ws + WS_XC) + (size_t)(row - T_LAT) * 1024;
}

__device__ __forceinline__ void gemm_tile_core(const bf16_t* __restrict__ A, int lda, const bf16_t* __restrict__ Bt, int ldb, int K, char* smem) {
    const int tid = opaque_tid(), lane = tid & 63, wid = tid >> 6;
    const int wm = wid >> 1, wn = wid & 1, l31 = lane & 31, hi = lane >> 5;
    f32x16 acc[2][2];
#pragma unroll
    for (int i = 0; i < 2; ++i)
#pragma unroll
        for (int j = 0; j < 2; ++j)
#pragma unroll
            for (int r = 0; r < 16; ++r) acc[i][j][r] = 0.f;
    const int lrow = tid >> 3, lkc = tid & 7;
    const bf16_t* ap = A + (size_t)lrow * lda + lkc * 8;
    const bf16_t* bp = Bt + (size_t)lrow * ldb + lkc * 8;
    uint4 p0, p1, p2, p3, p4, p5, p6, p7, q0, q1, q2, q3, q4, q5, q6, q7;
    const int nk = K >> 6;
    const size_t sA = (size_t)32 * lda, sB = (size_t)32 * ldb;
#define G_LOAD0(KT) { const bf16_t* a_ = ap + (KT) * 64; const bf16_t* b_ = bp + (KT) * 64; p0 = *(const uint4*)(a_); p1 = *(const uint4*)(a_ + sA); p2 = *(const uint4*)(a_ + 2 * sA); p3 = *(const uint4*)(a_ + 3 * sA); \
        p4 = *(const uint4*)(b_); p5 = *(const uint4*)(b_ + sB); p6 = *(const uint4*)(b_ + 2 * sB); p7 = *(const uint4*)(b_ + 3 * sB); }
#define G_LOAD1(KT) { const bf16_t* a_ = ap + (KT) * 64; const bf16_t* b_ = bp + (KT) * 64; q0 = *(const uint4*)(a_); q1 = *(const uint4*)(a_ + sA); q2 = *(const uint4*)(a_ + 2 * sA); q3 = *(const uint4*)(a_ + 3 * sA); \
        q4 = *(const uint4*)(b_); q5 = *(const uint4*)(b_ + sB); q6 = *(const uint4*)(b_ + 2 * sB); q7 = *(const uint4*)(b_ + 3 * sB); }
#define G_WRITE0(BUF) { char* wa_ = smem + (BUF) * 36864 + lrow * 144 + lkc * 16; char* wb_ = wa_ + 18432; *(uint4*)(wa_) = p0; *(uint4*)(wa_ + 4608) = p1; *(uint4*)(wa_ + 9216) = p2; *(uint4*)(wa_ + 13824) = p3; \
        *(uint4*)(wb_) = p4; *(uint4*)(wb_ + 4608) = p5; *(uint4*)(wb_ + 9216) = p6; *(uint4*)(wb_ + 13824) = p7; }
#define G_WRITE1(BUF) { char* wa_ = smem + (BUF) * 36864 + lrow * 144 + lkc * 16; char* wb_ = wa_ + 18432; *(uint4*)(wa_) = q0; *(uint4*)(wa_ + 4608) = q1; *(uint4*)(wa_ + 9216) = q2; *(uint4*)(wa_ + 13824) = q3; \
        *(uint4*)(wb_) = q4; *(uint4*)(wb_ + 4608) = q5; *(uint4*)(wb_ + 9216) = q6; *(uint4*)(wb_ + 13824) = q7; }
#define G_COMPUTE(BUF) { const char* sa = smem + (BUF) * 36864; const char* sb = sa + 18432; \
        _Pragma("unroll") for (int ks = 0; ks < 4; ++ks) { bf16x8 af[2], bfr[2]; \
            _Pragma("unroll") for (int i = 0; i < 2; ++i) af[i] = *(const bf16x8*)(sa + (wm * 64 + i * 32 + l31) * 144 + ks * 32 + hi * 16); \
            _Pragma("unroll") for (int j = 0; j < 2; ++j) bfr[j] = *(const bf16x8*)(sb + (wn * 64 + j * 32 + l31) * 144 + ks * 32 + hi * 16); \
            _Pragma("unroll") for (int i = 0; i < 2; ++i) _Pragma("unroll") for (int j = 0; j < 2; ++j) acc[i][j] = __builtin_amdgcn_mfma_f32_32x32x16_bf16(af[i], bfr[j], acc[i][j], 0, 0, 0); } }
    G_LOAD0(0);
    G_WRITE0(0);
    G_LOAD0(1);
    { const int k2 = nk > 2 ? 2 : nk - 1; G_LOAD1(k2); }
    __syncthreads();
    for (int kt = 0; kt < nk; kt += 2) {
        G_COMPUTE(0);
        G_WRITE0(1);
        { const int k3 = kt + 3 < nk ? kt + 3 : nk - 1; G_LOAD0(k3); }
        __syncthreads();
        G_COMPUTE(1);
        G_WRITE1(0);
        { const int k4 = kt + 4 < nk ? kt + 4 : nk - 1; G_LOAD1(k4); }
        __syncthreads();
    }
#undef G_LOAD0
#undef G_LOAD1
#undef G_WRITE0
#undef G_WRITE1
#undef G_COMPUTE
    float* cs = (float*)smem;
#pragma unroll
    for (int i = 0; i < 2; ++i)
#pragma unroll
        for (int j = 0; j < 2; ++j)
#pragma unroll
            for (int r = 0; r < 16; ++r)
                cs[(wm * 64 + i * 32 + 8 * (r >> 2) + 4 * hi + (r & 3)) * 132 + wn * 64 + j * 32 + l31] = acc[i][j][r];
    __syncthreads();
}


struct Acc2 { f32x16 a[4][2]; };
__device__ __forceinline__ void gemm_tile_core2(const bf16_t* __restrict__ A, int lda, const bf16_t* __restrict__ Bt, int ldb, int K, char* smem, Acc2& C) {
    const int tid = opaque_tid(), lane = tid & 63, wid = tid >> 6;
    const int wm = wid >> 1, wn = wid & 1, l31 = lane & 31, hi = lane >> 5;
#pragma unroll
    for (int i = 0; i < 4; ++i)
#pragma unroll
        for (int j = 0; j < 2; ++j)
#pragma unroll
            for (int r = 0; r < 16; ++r) C.a[i][j][r] = 0.f;
    const int lrow = tid >> 2, lkc = tid & 3;
    const bf16_t* ap = A + (size_t)lrow * lda + lkc * 8;
    const bf16_t* bp = Bt + (size_t)lrow * ldb + lkc * 8;
    const size_t sA = (size_t)64 * lda, sB = (size_t)64 * ldb;
    uint4 p0, p1, p2, p3, p4, p5, q0, q1, q2, q3, q4, q5;
    const int nk = K >> 5;
    constexpr int STG = 30720, BOFF = 20480;
#define H_LOAD0(KT) { const bf16_t* a_ = ap + (KT) * 32; const bf16_t* b_ = bp + (KT) * 32; p0 = *(const uint4*)(a_); p1 = *(const uint4*)(a_ + sA); p2 = *(const uint4*)(a_ + 2 * sA); p3 = *(const uint4*)(a_ + 3 * sA); \
        p4 = *(const uint4*)(b_); p5 = *(const uint4*)(b_ + sB); }
#define H_LOAD1(KT) { const bf16_t* a_ = ap + (KT) * 32; const bf16_t* b_ = bp + (KT) * 32; q0 = *(const uint4*)(a_); q1 = *(const uint4*)(a_ + sA); q2 = *(const uint4*)(a_ + 2 * sA); q3 = *(const uint4*)(a_ + 3 * sA); \
        q4 = *(const uint4*)(b_); q5 = *(const uint4*)(b_ + sB); }
#define H_WRITE0(BUF) { char* wa_ = smem + (BUF) * STG + lrow * 80 + lkc * 16; char* wb_ = wa_ + BOFF; *(uint4*)(wa_) = p0; *(uint4*)(wa_ + 5120) = p1; *(uint4*)(wa_ + 10240) = p2; *(uint4*)(wa_ + 15360) = p3; \
        *(uint4*)(wb_) = p4; *(uint4*)(wb_ + 5120) = p5; }
#define H_WRITE1(BUF) { char* wa_ = smem + (BUF) * STG + lrow * 80 + lkc * 16; char* wb_ = wa_ + BOFF; *(uint4*)(wa_) = q0; *(uint4*)(wa_ + 5120) = q1; *(uint4*)(wa_ + 10240) = q2; *(uint4*)(wa_ + 15360) = q3; \
        *(uint4*)(wb_) = q4; *(uint4*)(wb_ + 5120) = q5; }
#define H_COMPUTE(BUF) { const char* sa = smem + (BUF) * STG; const char* sb = sa + BOFF; \
        _Pragma("unroll") for (int ks = 0; ks < 2; ++ks) { bf16x8 af[4], bfr[2]; \
            _Pragma("unroll") for (int i = 0; i < 4; ++i) af[i] = *(const bf16x8*)(sa + (wm * 128 + i * 32 + l31) * 80 + ks * 32 + hi * 16); \
            _Pragma("unroll") for (int j = 0; j < 2; ++j) bfr[j] = *(const bf16x8*)(sb + (wn * 64 + j * 32 + l31) * 80 + ks * 32 + hi * 16); \
            _Pragma("unroll") for (int i = 0; i < 4; ++i) _Pragma("unroll") for (int j = 0; j < 2; ++j) C.a[i][j] = __builtin_amdgcn_mfma_f32_32x32x16_bf16(af[i], bfr[j], C.a[i][j], 0, 0, 0); } }
    H_LOAD0(0);
    H_WRITE0(0);
    H_LOAD0(1);
    { const int k2 = nk > 2 ? 2 : nk - 1; H_LOAD1(k2); }
    __syncthreads();
    for (int kt = 0; kt < nk; kt += 2) {
        H_COMPUTE(0);
        H_WRITE0(1);
        { const int k3 = kt + 3 < nk ? kt + 3 : nk - 1; H_LOAD0(k3); }
        __syncthreads();
        H_COMPUTE(1);
        H_WRITE1(0);
        { const int k4 = kt + 4 < nk ? kt + 4 : nk - 1; H_LOAD1(k4); }
        __syncthreads();
    }
#undef H_LOAD0
#undef H_LOAD1
#undef H_WRITE0
#undef H_WRITE1
#undef H_COMPUTE
}
__device__ __forceinline__ void gemm2_stage(const Acc2& C, int half, char* smem) {
    const int tid = opaque_tid(), lane = tid & 63, wid = tid >> 6;
    const int wm = wid >> 1, wn = wid & 1, l31 = lane & 31, hi = lane >> 5;
    float* cs = (float*)smem;
    if (wm == half) {
#pragma unroll
        for (int i = 0; i < 4; ++i)
#pragma unroll
            for (int j = 0; j < 2; ++j)
#pragma unroll
                for (int r = 0; r < 16; ++r)
                    cs[(i * 32 + 8 * (r >> 2) + 4 * hi + (r & 3)) * 132 + wn * 64 + j * 32 + l31] = C.a[i][j][r];
    }
    __syncthreads();
}

__device__ __forceinline__ void epi_copy_bf16(const float* cs, bf16_t* dst, int ld, int row0, int col0, float sc) {
    const int tid = opaque_tid(), c4 = (tid & 31) * 4, r0 = tid >> 5;
#pragma unroll 4
    for (int i = 0; i < 16; ++i) {
        const int r = r0 + 8 * i;
        const f32x4 v = *(const f32x4*)(cs + r * 132 + c4);
        uint2 w; w.x = pack2(v[0] * sc, v[1] * sc); w.y = pack2(v[2] * sc, v[3] * sc);
        *(uint2*)(dst + (size_t)(row0 + r) * ld + col0 + c4) = w;
    }
}
__device__ __forceinline__ void epi_store_T(const float* cs, int cbase, int ndcols, bf16_t* dstbase  , const float* rs) {
    const int tid = opaque_tid();
    const int items = ndcols * 16;
    for (int it = tid; it < items; it += 256) {
        const int c = it % ndcols, rg = it / ndcols;
        float v[8];
#pragma unroll
        for (int j = 0; j < 8; ++j) { v[j] = cs[(rg * 8 + j) * 132 + cbase + c]; if (rs) v[j] *= rs[rg * 8 + j]; }
        uint4 w; w.x = pack2(v[0], v[1]); w.y = pack2(v[2], v[3]); w.z = pack2(v[4], v[5]); w.w = pack2(v[6], v[7]);
        *(uint4*)(dstbase + (size_t)c * NKEY + rg * 8) = w;
    }
}
__device__ __forceinline__ void rope32(float (&v)[32], int n, const float* rope) {
#pragma unroll
    for (int a = 0; a < 2; ++a) {
        const int pos = a == 0 ? (n >> 6) : (n & 63);
#pragma unroll
        for (int f = 0; f < 8; ++f) {
            const float cs_ = rope[(pos * 8 + f) * 2], sn = rope[(pos * 8 + f) * 2 + 1];
            const float x1 = v[a * 16 + f], x2 = v[a * 16 + 8 + f];
            v[a * 16 + f] = x1 * cs_ - x2 * sn;
            v[a * 16 + 8 + f] = x2 * cs_ + x1 * sn;
        }
    }
}
__device__ __forceinline__ float wave_max(float v) {
#pragma unroll
    for (int o = 32; o >= 1; o >>= 1) v = fmaxf(v, __shfl_xor(v, o));
    return v;
}
__device__ __forceinline__ void store32_bf16(bf16_t* dst, const float (&v)[32], float sc) {
#pragma unroll
    for (int q = 0; q < 4; ++q) {
        uint4 w; w.x = pack2(v[q * 8 + 0] * sc, v[q * 8 + 1] * sc); w.y = pack2(v[q * 8 + 2] * sc, v[q * 8 + 3] * sc);
        w.z = pack2(v[q * 8 + 4] * sc, v[q * 8 + 5] * sc); w.w = pack2(v[q * 8 + 6] * sc, v[q * 8 + 7] * sc);
        *(uint4*)(dst + q * 8) = w;
    }
}

__device__ void epi_inproj(const Params& p, int l, int m0, int tn, const float* cs) {
    const int tid = opaque_tid();
    int b, key0; bool lat; row_bk(m0, b, key0, lat);
    const float* rope = (const float*)(p.ws + WS_ROPE);
    if (tn < 6 || tn == 28) {
        const int r = tid & 127, half = tid >> 7;
        const int row = m0 + r, key = key0 + r;
        const int ngrp = (tn == 28) ? 1 : 4;
        for (int gi = half; gi < ngrp; gi += 2) {
            float v[32];
#pragma unroll
            for (int q = 0; q < 8; ++q) { const f32x4 t = *(const f32x4*)(cs + r * 132 + gi * 32 + q * 4); v[q * 4] = t[0]; v[q * 4 + 1] = t[1]; v[q * 4 + 2] = t[2]; v[q * 4 + 3] = t[3]; }
            if (lat) rope32(v, row & 8191, rope);
            if (tn < 3) {
                bf16_t* dst = (bf16_t*)(p.ws + WS_QDA) + ((size_t)(b * 12 + tn * 4 + gi) * NKEY + key) * 32;
                store32_bf16(dst, v, 0.17677669529663687f * LOG2E);
            } else if (tn < 6) {
                const int hc = (tn - 3) * 4 + gi;
                bf16_t* dst = (bf16_t*)(p.ws + WS_KDA) + ((size_t)(b * 12 + hc) * NKEY + key) * 32;
                store32_bf16(dst, v, 1.0f);
                float n2 = 0.f;
#pragma unroll
                for (int q = 0; q < 32; ++q) n2 += v[q] * v[q];
                n2 = wave_max(n2);
                if ((tid & 63) == 0) atomicMax((unsigned*)(p.ws + WS_KMAX) + (l * 4 + b) * 32 + hc, __float_as_uint(n2));
            } else {
                bf16_t* dst = (bf16_t*)(p.ws + WS_KR) + (size_t)row * 32;
                store32_bf16(dst, v, 1.0f);
            }
        }
    } else if (tn < 9) {
        const int h0 = (tn - 6) * 2;
        bf16_t* dst = (bf16_t*)(p.ws + WS_VDAT) + ((size_t)(b * 6 + h0) * 64) * NKEY + key0;
        epi_store_T(cs, 0, 128, dst, nullptr);
    } else if (tn < 12) {
        if (tn < 11) epi_copy_bf16(cs, (bf16_t*)(p.ws + WS_CQ), 256, m0, (tn - 9) * 128, 1.0f);
        else epi_copy_bf16(cs, (bf16_t*)(p.ws + WS_CKV), 128, m0, 0, 1.0f);
        if (tid < 128) {
            float ssq = 0.f;
#pragma unroll 8
            for (int q = 0; q < 32; ++q) { const f32x4 t = *(const f32x4*)(cs + tid * 132 + q * 4); ssq += t[0] * t[0] + t[1] * t[1] + t[2] * t[2] + t[3] * t[3]; }
            ((float*)(p.ws + WS_SSQ))[(size_t)(m0 + tid) * 4 + (tn - 9)] = ssq;
        }
    } else {
        epi_copy_bf16(cs, (bf16_t*)(p.ws + WS_HG), 2048, m0, (tn - 12) * 128, 1.0f);
    }
}

__device__ __forceinline__ void row_rstd(const Params& p, int which  , int m0, float* rs) {
    const int tid = opaque_tid();
    if (tid < 128) {
        const float* q = (const float*)(p.ws + WS_SSQ) + (size_t)(m0 + tid) * 4;
        rs[tid] = which == 0 ? rsqrtf((q[0] + q[1]) * (1.0f / 256.0f) + EPS) : rsqrtf(q[2] * (1.0f / 128.0f) + EPS);
    }
}
__device__ void epi_uq(const Params& p, int m0, int h, const float* cs, const float* rs) {
    const int tid = opaque_tid(), r = tid & 127, half = tid >> 7;
    int b, key0; bool lat; row_bk(m0, b, key0, lat);
    const int row = m0 + r, key = key0 + r;
    const float sc = rs[r] * 0.10206207261596575f * LOG2E;
    bf16_t* dst = (bf16_t*)(p.ws + WS_QMLA) + ((size_t)(b * 6 + h) * NKEY + key) * 96;
    if (half == 0) {
        float v[32];
#pragma unroll
        for (int q = 0; q < 8; ++q) { const f32x4 t = *(const f32x4*)(cs + r * 132 + q * 4); v[q * 4] = t[0]; v[q * 4 + 1] = t[1]; v[q * 4 + 2] = t[2]; v[q * 4 + 3] = t[3]; }
        store32_bf16(dst, v, sc);
#pragma unroll
        for (int q = 0; q < 4; ++q) { const f32x4 t = *(const f32x4*)(cs + r * 132 + 32 + q * 4); v[q * 4] = t[0]; v[q * 4 + 1] = t[1]; v[q * 4 + 2] = t[2]; v[q * 4 + 3] = t[3]; }
#pragma unroll
        for (int q = 0; q < 2; ++q) {
            uint4 w; w.x = pack2(v[q * 8 + 0] * sc, v[q * 8 + 1] * sc); w.y = pack2(v[q * 8 + 2] * sc, v[q * 8 + 3] * sc);
            w.z = pack2(v[q * 8 + 4] * sc, v[q * 8 + 5] * sc); w.w = pack2(v[q * 8 + 6] * sc, v[q * 8 + 7] * sc);
            *(uint4*)(dst + 32 + q * 8) = w;
        }
    } else {
        float v[32];
#pragma unroll
        for (int q = 0; q < 4; ++q) { const f32x4 t = *(const f32x4*)(cs + r * 132 + 48 + q * 4); v[q * 4] = t[0]; v[q * 4 + 1] = t[1]; v[q * 4 + 2] = t[2]; v[q * 4 + 3] = t[3]; }
#pragma unroll
        for (int q = 0; q < 2; ++q) {
            uint4 w; w.x = pack2(v[q * 8 + 0] * sc, v[q * 8 + 1] * sc); w.y = pack2(v[q * 8 + 2] * sc, v[q * 8 + 3] * sc);
            w.z = pack2(v[q * 8 + 4] * sc, v[q * 8 + 5] * sc); w.w = pack2(v[q * 8 + 6] * sc, v[q * 8 + 7] * sc);
            *(uint4*)(dst + 48 + q * 8) = w;
        }
#pragma unroll
        for (int q = 0; q < 8; ++q) { const f32x4 t = *(const f32x4*)(cs + r * 132 + 64 + q * 4); v[q * 4] = t[0]; v[q * 4 + 1] = t[1]; v[q * 4 + 2] = t[2]; v[q * 4 + 3] = t[3]; }
        if (lat) rope32(v, row & 8191, (const float*)(p.ws + WS_ROPE));
        store32_bf16(dst + 64, v, sc);
    }
}
__device__ void epi_ukv(const Params& p, int l, int m0, int h, const float* cs, const float* rs) {
    const int tid = opaque_tid();
    int b, key0; bool lat; row_bk(m0, b, key0, lat);
    bf16_t* vdst = (bf16_t*)(p.ws + WS_VMLAT) + ((size_t)(b * 6 + h) * 64) * NKEY + key0;
    epi_store_T(cs, 64, 64, vdst, rs);
    if (tid < 128) {
        const int r = tid, row = m0 + r, key = key0 + r;
        const float sc = rs[r];
        bf16_t* dst = (bf16_t*)(p.ws + WS_KMLA) + ((size_t)(b * 6 + h) * NKEY + key) * 96;
        float n2 = 0.f;
        float v[32];
#pragma unroll
        for (int part = 0; part < 2; ++part) {
#pragma unroll
            for (int q = 0; q < 8; ++q) { const f32x4 t = *(const f32x4*)(cs + r * 132 + part * 32 + q * 4); v[q * 4] = t[0] * sc; v[q * 4 + 1] = t[1] * sc; v[q * 4 + 2] = t[2] * sc; v[q * 4 + 3] = t[3] * sc; }
#pragma unroll
            for (int q = 0; q < 32; ++q) n2 += v[q] * v[q];
            store32_bf16(dst + part * 32, v, 1.0f);
        }
        const bf16_t* kr = (const bf16_t*)(p.ws + WS_KR) + (size_t)row * 32;
#pragma unroll
        for (int q = 0; q < 4; ++q) {
            const uint4 w = *(const uint4*)(kr + q * 8);
            *(uint4*)(dst + 64 + q * 8) = w;
            const unsigned ww[4] = {w.x, w.y, w.z, w.w};
#pragma unroll
            for (int j = 0; j < 4; ++j) { const float f0 = __uint_as_float(ww[j] << 16), f1 = __uint_as_float(ww[j] & 0xffff0000u); n2 += f0 * f0 + f1 * f1; }
        }
        n2 = wave_max(n2);
        if ((tid & 63) == 0) atomicMax((unsigned*)(p.ws + WS_KMAX) + (l * 4 + b) * 32 + 12 + h, __float_as_uint(n2));
    }
}
__device__ __forceinline__ void epi_resid(const Params& p, int l, int m0, int n0, int goff, const float* cs) {
    const int tid = opaque_tid(), c4 = (tid & 31) * 4, r0 = tid >> 5;
    int b, key0; bool lat; row_bk(m0, b, key0, lat);
    const float* gate = (const float*)(p.ws + WS_MOD) + (size_t)(l * 5 + (lat ? b : 4)) * 6144 + goff + n0 + c4;
    const f32x4 g = *(const f32x4*)gate;
#pragma unroll 4
    for (int i = 0; i < 16; ++i) {
        const int r = r0 + 8 * i;
        const f32x4 v = *(const f32x4*)(cs + r * 132 + c4);
        float* xp = xrow(p, m0 + r) + n0 + c4;
        const float* xs = (l == 0 && goff == 2 * 1024) ? xrow_in(p, m0 + r) + n0 + c4 : xp;
        f32x4 x = *(const f32x4*)xs;
        x += g * v;
        *(f32x4*)xp = x;
    }
}
__device__ __forceinline__ void epi_ff1(const Params& p, int m0, int n0, const float* cs) {
    const int tid = opaque_tid(), c4 = (tid & 31) * 4, r0 = tid >> 5;
    bf16_t* dst = (bf16_t*)(p.ws + WS_H1);
#pragma unroll 4
    for (int i = 0; i < 16; ++i) {
        const int r = r0 + 8 * i;
        f32x4 v = *(const f32x4*)(cs + r * 132 + c4);
#pragma unroll
        for (int j = 0; j < 4; ++j) { const float t = fmaxf(v[j], 0.f); v[j] = t * t; }
        uint2 w; w.x = pack2(v[0], v[1]); w.y = pack2(v[2], v[3]);
        *(uint2*)(dst + (size_t)(m0 + r) * 4096 + n0 + c4) = w;
    }
}

template <int DQK>
__device__ __forceinline__ void attn_pass(const bf16_t* __restrict__ Qb, const bf16_t* __restrict__ Kb, const bf16_t* __restrict__ VTb,
                                          int q0, int nkt, float kmax, char* smem, f32x16& O0, f32x16& O1, float& lsum) {
    constexpr int KS = DQK * 2 + 16, VS = 136, STAGE = 64 * KS + 64 * VS, NKC = DQK / 32, CPR = DQK / 8;
    const int tid = opaque_tid(), lane = tid & 63, wid = tid >> 6, l31 = lane & 31, hi = lane >> 5;
    bf16x8 qf[DQK / 16];
    const bf16_t* qp = Qb + (size_t)(q0 + wid * 32 + l31) * DQK + hi * 8;
    float qn = 0.f;
#pragma unroll
    for (int ks = 0; ks < DQK / 16; ++ks) {
        qf[ks] = *(const bf16x8*)(qp + ks * 16);
#pragma unroll
        for (int j = 0; j < 8; ++j) { const float f = bf2f((bf16_t)qf[ks][j]); qn += f * f; }
    }
    qn += __shfl_xor(qn, 32);
    const float negm = -(sqrtf(qn) * kmax);
#pragma unroll
    for (int r = 0; r < 16; ++r) { O0[r] = 0.f; O1[r] = 0.f; }
    lsum = 0.f;
    const int kr0 = tid / CPR, kc0 = tid % CPR, kr1 = (tid + 256) / CPR, kc1 = (tid + 256) % CPR, kr2 = (tid + 512) / CPR, kc2 = (tid + 512) % CPR;
    const int vr0 = tid >> 3, vc0 = tid & 7;
    const bf16_t* vg = VTb + (size_t)vr0 * NKEY + vc0 * 8;
    uint4 a0, a1, a2, a3, a4;
#define AT_LOADA(KT) { const bf16_t* kp_ = Kb + (size_t)(KT) * 64 * DQK; a0 = *(const uint4*)(kp_ + (size_t)tid * 8); \
        if constexpr (NKC > 1) { a1 = *(const uint4*)(kp_ + (size_t)(tid + 256) * 8); a2 = *(const uint4*)(kp_ + (size_t)(tid + 512) * 8); } \
        a3 = *(const uint4*)(vg + (KT) * 64); a4 = *(const uint4*)(vg + (size_t)32 * NKEY + (KT) * 64); }
#define AT_WRITE(X0, X1, X2, X3, X4, BUF) { char* sk_ = smem + (BUF) * STAGE; char* sv_ = sk_ + 64 * KS; \
        *(uint4*)(sk_ + kr0 * KS + kc0 * 16) = X0; \
        if constexpr (NKC > 1) { *(uint4*)(sk_ + kr1 * KS + kc1 * 16) = X1; *(uint4*)(sk_ + kr2 * KS + kc2 * 16) = X2; } \
        { uint2* d_ = (uint2*)(sv_ + vr0 * VS + vc0 * 16); d_[0] = make_uint2(X3.x, X3.y); d_[1] = make_uint2(X3.z, X3.w); } \
        { uint2* d_ = (uint2*)(sv_ + (vr0 + 32) * VS + vc0 * 16); d_[0] = make_uint2(X4.x, X4.y); d_[1] = make_uint2(X4.z, X4.w); } }
    f32x16 NEG;
#pragma unroll
    for (int r = 0; r < 16; ++r) NEG[r] = negm;
    auto compute = [&](int buf) {
        const char* sk = smem + buf * STAGE; const char* sv = sk + 64 * KS;
        constexpr int NKS = DQK / 16;
        bf16x8 k0[NKS], k1[NKS], v0[4], v1[4];
#pragma unroll
        for (int ks = 0; ks < NKS; ++ks) k0[ks] = *(const bf16x8*)(sk + (l31)*KS + ks * 32 + hi * 16);
#pragma unroll
        for (int ks = 0; ks < NKS; ++ks) k1[ks] = *(const bf16x8*)(sk + (32 + l31) * KS + ks * 32 + hi * 16);
#pragma unroll
        for (int u = 0; u < 2; ++u)
#pragma unroll
            for (int db = 0; db < 2; ++db) {
                const char* vp = sv + (db * 32 + l31) * VS + (16 * u + 4 * hi) * 2;
                const uint2 x0 = *(const uint2*)vp, x1 = *(const uint2*)(vp + 16);
                v0[u * 2 + db] = MK8(x0.x, x0.y, x1.x, x1.y);
            }
        __builtin_amdgcn_sched_barrier(0);
        f32x16 S0, S1;
#pragma unroll
        for (int ks = 0; ks < NKS; ++ks) S0 = __builtin_amdgcn_mfma_f32_32x32x16_bf16(k0[ks], qf[ks], ks == 0 ? NEG : S0, 0, 0, 0);
#pragma unroll
        for (int ks = 0; ks < NKS; ++ks) S1 = __builtin_amdgcn_mfma_f32_32x32x16_bf16(k1[ks], qf[ks], ks == 0 ? NEG : S1, 0, 0, 0);
        __builtin_amdgcn_sched_barrier(0);
#pragma unroll
        for (int u = 0; u < 2; ++u)
#pragma unroll
            for (int db = 0; db < 2; ++db) {
                const char* vp = sv + (db * 32 + l31) * VS + (32 + 16 * u + 4 * hi) * 2;
                const uint2 x0 = *(const uint2*)vp, x1 = *(const uint2*)(vp + 16);
                v1[u * 2 + db] = MK8(x0.x, x0.y, x1.x, x1.y);
            }
        unsigned pk0[8], pk1[8];
#pragma unroll
        for (int r = 0; r < 16; r += 2) { const float e0 = fexp2(S0[r]), e1 = fexp2(S0[r + 1]); lsum += e0 + e1; pk0[r >> 1] = cvt_pk(e0, e1); }
        __builtin_amdgcn_sched_barrier(0);
#pragma unroll
        for (int u = 0; u < 2; ++u) {
            const bf16x8 pbv = MK8(pk0[4 * u], pk0[4 * u + 1], pk0[4 * u + 2], pk0[4 * u + 3]);
            O0 = __builtin_amdgcn_mfma_f32_32x32x16_bf16(v0[u * 2 + 0], pbv, O0, 0, 0, 0);
            O1 = __builtin_amdgcn_mfma_f32_32x32x16_bf16(v0[u * 2 + 1], pbv, O1, 0, 0, 0);
        }
#pragma unroll
        for (int r = 0; r < 16; r += 2) { const float e0 = fexp2(S1[r]), e1 = fexp2(S1[r + 1]); lsum += e0 + e1; pk1[r >> 1] = cvt_pk(e0, e1); }
        __builtin_amdgcn_sched_barrier(0);
#pragma unroll
        for (int u = 0; u < 2; ++u) {
            const bf16x8 pbv = MK8(pk1[4 * u], pk1[4 * u + 1], pk1[4 * u + 2], pk1[4 * u + 3]);
            O0 = __builtin_amdgcn_mfma_f32_32x32x16_bf16(v1[u * 2 + 0], pbv, O0, 0, 0, 0);
            O1 = __builtin_amdgcn_mfma_f32_32x32x16_bf16(v1[u * 2 + 1], pbv, O1, 0, 0, 0);
        }
    };
    a1 = a2 = make_uint4(0u, 0u, 0u, 0u);
    AT_LOADA(0);
    AT_WRITE(a0, a1, a2, a3, a4, 0);
    AT_LOADA(1);
    __syncthreads();
    for (int kt = 0; kt < nkt; kt += 2) {
        compute(0);
        AT_WRITE(a0, a1, a2, a3, a4, 1);
        { const int k2 = kt + 2 < nkt ? kt + 2 : nkt - 1; AT_LOADA(k2); }
        __syncthreads();
        compute(1);
        AT_WRITE(a0, a1, a2, a3, a4, 0);
        { const int k3 = kt + 3 < nkt ? kt + 3 : nkt - 1; AT_LOADA(k3); }
        __syncthreads();
    }
#undef AT_LOADA
#undef AT_WRITE
    lsum += __shfl_xor(lsum, 32);
}

__device__ void attn_unit(const Params& p, int l, int b, int hh, int qbi, char* smem) {
    const int q0 = qbi < 64 ? 256 + qbi * 128 : (qbi - 64) * 128;
    const int nkt = qbi < 64 ? 132 : 4;
    const int tid = opaque_tid(), lane = tid & 63, wid = tid >> 6, l31 = lane & 31, hi = lane >> 5;
    const int qkey = q0 + wid * 32 + l31;
    const int row = qkey < 256 ? T_LAT + b * 256 + qkey : b * 8192 + qkey - 256;
    const float* kmx = (const float*)(p.ws + WS_KMAX) + (l * 4 + b) * 32;
    bf16_t* Y = (bf16_t*)(p.ws + WS_H);
    if (hh < 6) {
        const int h = hh;
        const bf16_t* VT = (const bf16_t*)(p.ws + WS_VDAT) + ((size_t)(b * 6 + h) * 64) * NKEY;
        f32x16 A0, A1, B0, B1; float la, lb;
        {
            const size_t off = (size_t)(b * 12 + 2 * h) * NKEY * 32;
            attn_pass<32>((const bf16_t*)(p.ws + WS_QDA) + off, (const bf16_t*)(p.ws + WS_KDA) + off, VT, q0, nkt, sqrtf(ld_coh(kmx + 2 * h)), smem, A0, A1, la);
        }
        {
            const size_t off = (size_t)(b * 12 + 2 * h + 1) * NKEY * 32;
            attn_pass<32>((const bf16_t*)(p.ws + WS_QDA) + off, (const bf16_t*)(p.ws + WS_KDA) + off, VT, q0, nkt, sqrtf(ld_coh(kmx + 2 * h + 1)), smem, B0, B1, lb);
        }
        const float lam = ((const float*)(p.ws + WS_LAM))[l];
        const float lam_init = 0.8f - 0.6f * expf(-0.3f * (float)l);
        const float ia = 1.0f / la, ib = lam / lb;
        float ss = 0.f;
#pragma unroll
        for (int r = 0; r < 16; ++r) { A0[r] = A0[r] * ia - B0[r] * ib; A1[r] = A1[r] * ia - B1[r] * ib; ss += A0[r] * A0[r] + A1[r] * A1[r]; }
        ss += __shfl_xor(ss, 32);
        const float rinv = rsqrtf(ss * (1.0f / 64.0f) + EPS) * (1.0f - lam_init);
        const float* g = p.da_subln_g + l * 64;
        bf16_t* yp = Y + (size_t)row * 1024 + h * 64;
#pragma unroll
        for (int q = 0; q < 4; ++q) {
            const int d = 8 * q + 4 * hi;
            const f32x4 g0 = *(const f32x4*)(g + d), g1 = *(const f32x4*)(g + 32 + d);
            uint2 w0, w1;
            w0.x = pack2(A0[4 * q] * rinv * g0[0], A0[4 * q + 1] * rinv * g0[1]); w0.y = pack2(A0[4 * q + 2] * rinv * g0[2], A0[4 * q + 3] * rinv * g0[3]);
            w1.x = pack2(A1[4 * q] * rinv * g1[0], A1[4 * q + 1] * rinv * g1[1]); w1.y = pack2(A1[4 * q + 2] * rinv * g1[2], A1[4 * q + 3] * rinv * g1[3]);
            *(uint2*)(yp + d) = w0; *(uint2*)(yp + 32 + d) = w1;
        }
    } else {
        const int h = hh - 6;
        const bf16_t* VT = (const bf16_t*)(p.ws + WS_VMLAT) + ((size_t)(b * 6 + h) * 64) * NKEY;
        const size_t off = (size_t)(b * 6 + h) * NKEY * 96;
        f32x16 A0, A1; float la;
        attn_pass<96>((const bf16_t*)(p.ws + WS_QMLA) + off, (const bf16_t*)(p.ws + WS_KMLA) + off, VT, q0, nkt, sqrtf(ld_coh(kmx + 12 + h)), smem, A0, A1, la);
        const float ia = 1.0f / la;
        bf16_t* yp = Y + (size_t)row * 1024 + 384 + h * 64;
#pragma unroll
        for (int q = 0; q < 4; ++q) {
            const int d = 8 * q + 4 * hi;
            uint2 w0, w1;
            w0.x = pack2(A0[4 * q] * ia, A0[4 * q + 1] * ia); w0.y = pack2(A0[4 * q + 2] * ia, A0[4 * q + 3] * ia);
            w1.x = pack2(A1[4 * q] * ia, A1[4 * q + 1] * ia); w1.y = pack2(A1[4 * q + 2] * ia, A1[4 * q + 3] * ia);
            *(uint2*)(yp + d) = w0; *(uint2*)(yp + 32 + d) = w1;
        }
    }
}

constexpr int HG_QT = 0, HG_KT = 4352, HG_KH = 8704, HG_VT = 13824, HG_DD = 16384, HG_OSEG = 17408;
template <int MODE>
__device__ void hgrn_pass(const Params& p, int l, int dir, int b, int h, int g, char* smem) {
    const int tid = opaque_tid(), lane = tid & 63, wid = tid >> 6, c = lane & 15, gq = lane >> 4;
    int r0, sgn;
    if (dir == 0) { r0 = g == 0 ? T_LAT + b * 256 : b * 8192 + (g - 1) * 256; sgn = 1; }
    else { r0 = g == 0 ? T_LAT + b * 256 + 255 : b * 8192 + 8191 - (g - 1) * 256; sgn = -1; }
    const bf16_t* HG = (const bf16_t*)(p.ws + WS_HG);
    const int k = tid >> 1, hf = tid & 1;
    const float lbv = ((const float*)(p.ws + WS_LB))[(dir * 4 + l) * 512 + h * 128 + k];
    const float omlb = 1.0f - lbv;
    const int zoff = 512 + dir * 512 + h * 128 + k, qoff = h * 128 + k;
    bf16_t* QT = (bf16_t*)(smem + HG_QT); bf16_t* KT = (bf16_t*)(smem + HG_KT); bf16_t* KH = (bf16_t*)(smem + HG_KH); bf16_t* VT = (bf16_t*)(smem + HG_VT);
    float* DD = (float*)(smem + HG_DD); bf16_t* OSEG = (bf16_t*)(smem + HG_OSEG);
    const int chain = (dir * 4 + b) * 4 + h;
    float* sst = (float*)(p.ws + WS_SST) + (size_t)(chain * 33 + g) * 8192;
    f32x4 S[8];
#pragma unroll
    for (int kb = 0; kb < 8; ++kb)
#pragma unroll
        for (int r = 0; r < 4; ++r) S[kb][r] = (MODE == 0) ? 0.f : sst[(16 * kb + 4 * gq + r) * 64 + 16 * wid + c];
    float btot = 0.f;
    bf16_t zr0, zr1, zr2, zr3, zr4, zr5, zr6, zr7, qr0 = 0, qr1 = 0, qr2 = 0, qr3 = 0, qr4 = 0, qr5 = 0, qr6 = 0, qr7 = 0; uint2 vv;
    const int vt_t = tid >> 4, vt_v4 = (tid & 15) * 4;
#define HG_ROW(SC, T) ((size_t)(r0 + sgn * ((SC) * 16 + (T))) * 2048)
#define HG_PREFETCH(SC) { const bf16_t* zb_ = HG + zoff; \
        zr0 = zb_[HG_ROW(SC, hf * 8 + 0)]; zr1 = zb_[HG_ROW(SC, hf * 8 + 1)]; zr2 = zb_[HG_ROW(SC, hf * 8 + 2)]; zr3 = zb_[HG_ROW(SC, hf * 8 + 3)]; \
        zr4 = zb_[HG_ROW(SC, hf * 8 + 4)]; zr5 = zb_[HG_ROW(SC, hf * 8 + 5)]; zr6 = zb_[HG_ROW(SC, hf * 8 + 6)]; zr7 = zb_[HG_ROW(SC, hf * 8 + 7)]; \
        if (MODE != 0) { const bf16_t* qb_ = HG + qoff; \
        qr0 = qb_[HG_ROW(SC, hf * 8 + 0)]; qr1 = qb_[HG_ROW(SC, hf * 8 + 1)]; qr2 = qb_[HG_ROW(SC, hf * 8 + 2)]; qr3 = qb_[HG_ROW(SC, hf * 8 + 3)]; \
        qr4 = qb_[HG_ROW(SC, hf * 8 + 4)]; qr5 = qb_[HG_ROW(SC, hf * 8 + 5)]; qr6 = qb_[HG_ROW(SC, hf * 8 + 6)]; qr7 = qb_[HG_ROW(SC, hf * 8 + 7)]; } \
        vv = *(const uint2*)(HG + HG_ROW(SC, vt_t) + 1536 + h * 64 + vt_v4); }
    HG_PREFETCH(0);
    for (int sc = 0; sc < 16; ++sc) {
        float bt[8], ky[8], qv[8];
        {
            const bf16_t zz[8] = {zr0, zr1, zr2, zr3, zr4, zr5, zr6, zr7};
            const bf16_t qq[8] = {qr0, qr1, qr2, qr3, qr4, qr5, qr6, qr7};
            float cum = 0.f;
#pragma unroll
            for (int i = 0; i < 8; ++i) {
                const float z = bf2f(zz[i]);
                const float e = fexp(-z);
                const float sg = __builtin_amdgcn_rcpf(1.0f + e);
                const float f = lbv + omlb * sg;
                cum += __builtin_amdgcn_logf(fmaxf(f, 1e-30f)) * 0.6931471805599453f;
                bt[i] = cum; ky[i] = omlb * (1.0f - sg); qv[i] = bf2f(qq[i]);
            }
            const float other = __shfl_xor(cum, 1);
            const float blast = cum + other;
            const float add = hf ? other : 0.f;
#pragma unroll
            for (int i = 0; i < 8; ++i) {
                const int t = hf * 8 + i;
                const float b_ = bt[i] + add;
                if (MODE != 0) {
                    QT[t * 136 + k] = f2bf(qv[i] * fexp(b_));
                    KT[t * 136 + k] = f2bf(ky[i] * fexp(fminf(-b_, 80.f)));
                }
                KH[k * 20 + t] = f2bf(ky[i] * fexp(blast - b_));
            }
            if (hf == 0) DD[k] = fexp(blast);
            btot += blast;
            VT[(vt_v4 + 0) * 20 + vt_t] = (bf16_t)(vv.x & 0xffff); VT[(vt_v4 + 1) * 20 + vt_t] = (bf16_t)(vv.x >> 16);
            VT[(vt_v4 + 2) * 20 + vt_t] = (bf16_t)(vv.y & 0xffff); VT[(vt_v4 + 3) * 20 + vt_t] = (bf16_t)(vv.y >> 16);
        }
        __syncthreads();
        { const int scn = sc < 15 ? sc + 1 : 15; HG_PREFETCH(scn); }
        const uint2 vtu = *(const uint2*)(VT + (16 * wid + c) * 20 + 4 * gq);
        const bf16x8 vtf = MK8(vtu.x, vtu.y, 0u, 0u);
        if (MODE != 0) {
            f32x4 AT = {0.f, 0.f, 0.f, 0.f};
#pragma unroll
            for (int ks = 0; ks < 4; ++ks) {
                const bf16x8 a = *(const bf16x8*)(KT + c * 136 + ks * 32 + gq * 8);
                const bf16x8 bq = *(const bf16x8*)(QT + c * 136 + ks * 32 + gq * 8);
                AT = __builtin_amdgcn_mfma_f32_16x16x32_bf16(a, bq, AT, 0, 0, 0);
            }
#pragma unroll
            for (int r = 0; r < 4; ++r) if (4 * gq + r > c) AT[r] = 0.f;
            const bf16x8 pfv = MK8(pack2(AT[0], AT[1]), pack2(AT[2], AT[3]), 0u, 0u);
            f32x4 oT = {0.f, 0.f, 0.f, 0.f};
            oT = __builtin_amdgcn_mfma_f32_16x16x32_bf16(vtf, pfv, oT, 0, 0, 0);
#pragma unroll
            for (int u = 0; u < 4; ++u) {
                const bf16x8 sfv = MK8(pack2(S[2 * u][0], S[2 * u][1]), pack2(S[2 * u][2], S[2 * u][3]), pack2(S[2 * u + 1][0], S[2 * u + 1][1]), pack2(S[2 * u + 1][2], S[2 * u + 1][3]));
                const uint2 q0 = *(const uint2*)(QT + c * 136 + 32 * u + 4 * gq), q1 = *(const uint2*)(QT + c * 136 + 32 * u + 16 + 4 * gq);
                const bf16x8 qpv = MK8(q0.x, q0.y, q1.x, q1.y);
                oT = __builtin_amdgcn_mfma_f32_16x16x32_bf16(sfv, qpv, oT, 0, 0, 0);
            }
            const int pos = sc * 16 + c;
            const int ti = (MODE == 1) ? pos : 255 - pos;
            bf16_t* op = OSEG + ti * 68 + 16 * wid + 4 * gq;
            if (MODE == 2) {
                const uint2 old = *(const uint2*)op;
                oT[0] += __uint_as_float(old.x << 16); oT[1] += __uint_as_float(old.x & 0xffff0000u);
                oT[2] += __uint_as_float(old.y << 16); oT[3] += __uint_as_float(old.y & 0xffff0000u);
            }
            uint2 w; w.x = pack2(oT[0], oT[1]); w.y = pack2(oT[2], oT[3]);
            *(uint2*)op = w;
        }
#pragma unroll
        for (int kb = 0; kb < 8; ++kb) {
            const uint2 khu = *(const uint2*)(KH + (16 * kb + c) * 20 + 4 * gq);
            const bf16x8 kh = MK8(khu.x, khu.y, 0u, 0u);
            const f32x4 d4 = *(const f32x4*)(DD + 16 * kb + 4 * gq);
            S[kb] = __builtin_amdgcn_mfma_f32_16x16x32_bf16(kh, vtf, S[kb] * d4, 0, 0, 0);
        }
        __syncthreads();
    }
    if (MODE == 0) {
#pragma unroll
        for (int kb = 0; kb < 8; ++kb)
#pragma unroll
            for (int r = 0; r < 4; ++r) sst[(16 * kb + 4 * gq + r) * 64 + 16 * wid + c] = S[kb][r];
        if (hf == 0) ((float*)(p.ws + WS_DSEG))[(size_t)(chain * 33 + g) * 128 + k] = fexp(btot);
    }
#undef HG_ROW
#undef HG_PREFETCH
}

struct H1Pre { bf16_t z0, z1, z2, z3, z4, z5, z6, z7; uint2 vv; };
struct H1Ctx { int r0, sgn, zoff, hv, chain, g; float lbv, omlb, btot; f32x4 S[8]; };
__device__ void hgrn_h1_pair(const Params& p, int l, int b, int h, int g, char* smem) {
    const int tid = opaque_tid(), lane = tid & 63, wid = tid >> 6, c = lane & 15, gq = lane >> 4;
    const int k = tid >> 1, hf = tid & 1, vt_t = tid >> 4, vt_v4 = (tid & 15) * 4;
    const bf16_t* HG = (const bf16_t*)(p.ws + WS_HG);
    auto init = [&](H1Ctx& X, int dir) {
        if (dir == 0) { X.r0 = g == 0 ? T_LAT + b * 256 : b * 8192 + (g - 1) * 256; X.sgn = 1; }
        else { X.r0 = g == 0 ? T_LAT + b * 256 + 255 : b * 8192 + 8191 - (g - 1) * 256; X.sgn = -1; }
        X.lbv = ((const float*)(p.ws + WS_LB))[(dir * 4 + l) * 512 + h * 128 + k]; X.omlb = 1.0f - X.lbv;
        X.zoff = 512 + dir * 512 + h * 128 + k; X.hv = 1536 + h * 64 + vt_v4; X.chain = (dir * 4 + b) * 4 + h; X.g = g; X.btot = 0.f;
#pragma unroll
        for (int kb = 0; kb < 8; ++kb) X.S[kb] = (f32x4){0.f, 0.f, 0.f, 0.f};
    };
    auto prefetch = [&](const H1Ctx& X, H1Pre& R, int sc) {
        const bf16_t* zb = HG + X.zoff;
#define H1_ROW(T) ((size_t)(X.r0 + X.sgn * (sc * 16 + (T))) * 2048)
        R.z0 = zb[H1_ROW(hf * 8 + 0)]; R.z1 = zb[H1_ROW(hf * 8 + 1)]; R.z2 = zb[H1_ROW(hf * 8 + 2)]; R.z3 = zb[H1_ROW(hf * 8 + 3)];
        R.z4 = zb[H1_ROW(hf * 8 + 4)]; R.z5 = zb[H1_ROW(hf * 8 + 5)]; R.z6 = zb[H1_ROW(hf * 8 + 6)]; R.z7 = zb[H1_ROW(hf * 8 + 7)];
        R.vv = *(const uint2*)(HG + H1_ROW(vt_t) + X.hv);
#undef H1_ROW
    };
    auto elem = [&](H1Ctx& X, const H1Pre& R, char* sm) {
        bf16_t* KH = (bf16_t*)(sm + HG_KH); bf16_t* VT = (bf16_t*)(sm + HG_VT); float* DD = (float*)(sm + HG_DD);
        const bf16_t zz[8] = {R.z0, R.z1, R.z2, R.z3, R.z4, R.z5, R.z6, R.z7};
        float bt[8], ky[8]; float cum = 0.f;
#pragma unroll
        for (int i = 0; i < 8; ++i) {
            const float e = fexp(-bf2f(zz[i]));
            const float sg = __builtin_amdgcn_rcpf(1.0f + e);
            cum += __builtin_amdgcn_logf(fmaxf(X.lbv + X.omlb * sg, 1e-30f)) * 0.6931471805599453f;
            bt[i] = cum; ky[i] = X.omlb * (1.0f - sg);
        }
        const float other = __shfl_xor(cum, 1);
        const float blast = cum + other, add = hf ? other : 0.f;
#pragma unroll
        for (int i = 0; i < 8; ++i) KH[k * 20 + hf * 8 + i] = f2bf(ky[i] * fexp(blast - (bt[i] + add)));
        if (hf == 0) DD[k] = fexp(blast);
        X.btot += blast;
        VT[(vt_v4 + 0) * 20 + vt_t] = (bf16_t)(R.vv.x & 0xffff); VT[(vt_v4 + 1) * 20 + vt_t] = (bf16_t)(R.vv.x >> 16);
        VT[(vt_v4 + 2) * 20 + vt_t] = (bf16_t)(R.vv.y & 0xffff); VT[(vt_v4 + 3) * 20 + vt_t] = (bf16_t)(R.vv.y >> 16);
    };
    auto update = [&](H1Ctx& X, const char* sm) {
        const bf16_t* KH = (const bf16_t*)(sm + HG_KH); const bf16_t* VT = (const bf16_t*)(sm + HG_VT); const float* DD = (const float*)(sm + HG_DD);
        const uint2 vtu = *(const uint2*)(VT + (16 * wid + c) * 20 + 4 * gq);
        const bf16x8 vtf = MK8(vtu.x, vtu.y, 0u, 0u);
#pragma unroll
        for (int kb = 0; kb < 8; ++kb) {
            const uint2 khu = *(const uint2*)(KH + (16 * kb + c) * 20 + 4 * gq);
            const f32x4 d4 = *(const f32x4*)(DD + 16 * kb + 4 * gq);
            X.S[kb] = __builtin_amdgcn_mfma_f32_16x16x32_bf16(MK8(khu.x, khu.y, 0u, 0u), vtf, X.S[kb] * d4, 0, 0, 0);
        }
    };
    auto store = [&](H1Ctx& X) {
        float* sst = (float*)(p.ws + WS_SST) + (size_t)(X.chain * 33 + X.g) * 8192;
#pragma unroll
        for (int kb = 0; kb < 8; ++kb)
#pragma unroll
            for (int r = 0; r < 4; ++r) sst[(16 * kb + 4 * gq + r) * 64 + 16 * wid + c] = X.S[kb][r];
        if (hf == 0) ((float*)(p.ws + WS_DSEG))[(size_t)(X.chain * 33 + X.g) * 128 + k] = fexp(X.btot);
    };
    H1Ctx A, B; H1Pre A0, A1, B0, B1;
    init(A, 0); init(B, 1);
    prefetch(A, A0, 0); prefetch(B, B0, 0); prefetch(A, A1, 1); prefetch(B, B1, 1);
    for (int sc = 0; sc < 16; sc += 2) {
        elem(A, A0, smem); elem(B, B0, smem + 17408);
        __syncthreads();
        { const int scn = sc + 2 < 16 ? sc + 2 : 15; prefetch(A, A0, scn); prefetch(B, B0, scn); }
        update(A, smem); update(B, smem + 17408);
        __syncthreads();
        elem(A, A1, smem); elem(B, B1, smem + 17408);
        __syncthreads();
        { const int scn = sc + 3 < 16 ? sc + 3 : 15; prefetch(A, A1, scn); prefetch(B, B1, scn); }
        update(A, smem); update(B, smem + 17408);
        __syncthreads();
    }
    store(A); store(B);
}
__device__ void hgrn3_unit(const Params& p, int l, int u, char* smem) {
    const int tb = u % 33, bh = u / 33, h = bh & 3, b = bh >> 2;
    hgrn_pass<1>(p, l, 0, b, h, tb, smem);
    hgrn_pass<2>(p, l, 1, b, h, tb == 0 ? 0 : 33 - tb, smem);
    const int ti = opaque_tid();
    const int row = tb == 0 ? T_LAT + b * 256 + ti : b * 8192 + (tb - 1) * 256 + ti;
    const bf16_t* OSEG = (const bf16_t*)(smem + HG_OSEG) + ti * 68;
    const bf16_t* gp = (const bf16_t*)(p.ws + WS_HG) + (size_t)row * 2048 + 1792 + h * 64;
    const float* gn = p.hg_norm_g + l * 64;
    bf16_t* yp = (bf16_t*)(p.ws + WS_H) + (size_t)row * 1024 + 768 + h * 64;
    float ss = 0.f;
#pragma unroll
    for (int q = 0; q < 16; ++q) {
        const uint2 w = *(const uint2*)(OSEG + q * 4);
        const float a0 = __uint_as_float(w.x << 16), a1 = __uint_as_float(w.x & 0xffff0000u), a2 = __uint_as_float(w.y << 16), a3 = __uint_as_float(w.y & 0xffff0000u);
        ss += a0 * a0 + a1 * a1 + a2 * a2 + a3 * a3;
    }
    const float rinv = rsqrtf(ss * (1.0f / 64.0f) + EPS);
#pragma unroll
    for (int q = 0; q < 16; ++q) {
        const uint2 w = *(const uint2*)(OSEG + q * 4);
        const uint2 gw = *(const uint2*)(gp + q * 4);
        float o[4] = {__uint_as_float(w.x << 16), __uint_as_float(w.x & 0xffff0000u), __uint_as_float(w.y << 16), __uint_as_float(w.y & 0xffff0000u)};
        const float gt[4] = {__uint_as_float(gw.x << 16), __uint_as_float(gw.x & 0xffff0000u), __uint_as_float(gw.y << 16), __uint_as_float(gw.y & 0xffff0000u)};
#pragma unroll
        for (int j = 0; j < 4; ++j) { const float sl = gt[j] / (1.0f + fexp(-gt[j])); o[j] = o[j] * rinv * gn[q * 4 + j] * sl; }
        uint2 ow; ow.x = pack2(o[0], o[1]); ow.y = pack2(o[2], o[3]);
        *(uint2*)(yp + q * 4) = ow;
    }
    __syncthreads();
}

__device__ void convert_T(const float* in, int K, int Nin, bf16_t* out, int Nout, int mode, const float* gs, size_t gtid, size_t gthreads) {
    const size_t total = (size_t)Nout * (K / 8);
    for (size_t idx = gtid; idx < total; idx += gthreads) {
        const int n = (int)(idx % Nout), k8 = (int)(idx / Nout);
        int src = n;
        if (mode == 1) {
            if (n < 1536) src = n; else if (n < 3584) src = n + 32; else if (n < 3616) src = n - 3584 + 1536; else src = -1;
        } else if (mode == 2) {
            const int hh = n >> 7, d = n & 127; src = d < 96 ? hh * 96 + d : -1;
        }
        float v[8];
#pragma unroll
        for (int j = 0; j < 8; ++j) {
            const int k = k8 * 8 + j;
            v[j] = src >= 0 ? in[(size_t)k * Nin + src] * (gs ? gs[k] : 1.0f) : 0.f;
        }
        uint4 w; w.x = pack2(v[0], v[1]); w.y = pack2(v[2], v[3]); w.z = pack2(v[4], v[5]); w.w = pack2(v[6], v[7]);
        *(uint4*)(out + (size_t)n * K + k8 * 8) = w;
    }
}
__device__ void convert_layer(const Params& p, int l, size_t gtid, size_t gthreads) {
    convert_T(p.w_in + (size_t)l * 1024 * 3616, 1024, 3616, (bf16_t*)(p.ws + WS_WIN), NIN, 1, nullptr, gtid, gthreads);
    convert_T(p.w_out + (size_t)l * 1024 * 1024, 1024, 1024, (bf16_t*)(p.ws + WS_WOUT), 1024, 0, nullptr, gtid, gthreads);
    convert_T(p.w_ff1 + (size_t)l * 1024 * 4096, 1024, 4096, (bf16_t*)(p.ws + WS_WFF1), 4096, 0, nullptr, gtid, gthreads);
    convert_T(p.w_ff2 + (size_t)l * 4096 * 1024, 4096, 1024, (bf16_t*)(p.ws + WS_WFF2), 1024, 0, nullptr, gtid, gthreads);
    convert_T(p.w_uq + (size_t)l * 256 * 576, 256, 576, (bf16_t*)(p.ws + WS_WUQ), 768, 2, p.g_cq + l * 256, gtid, gthreads);
    convert_T(p.w_ukv + (size_t)l * 128 * 768, 128, 768, (bf16_t*)(p.ws + WS_WUKV), 768, 0, p.g_ckv + l * 128, gtid, gthreads);
}
__device__ void adaln_phase(const Params& p, int l, const float* g, int shift_off, int scale_off, int nrows) {
    const int lane = opaque_tid() & 63;
    const int gw = blockIdx.x * 4 + (threadIdx.x >> 6), nw = gridDim.x * 4;
    bf16_t* H = (bf16_t*)(p.ws + WS_H);
    const bool from_input = (l == 0 && shift_off == 0);
    f32x4 v0, v1, v2, v3, n0, n1, n2, n3;
    v0 = v1 = v2 = v3 = n0 = n1 = n2 = n3 = (f32x4){0.f, 0.f, 0.f, 0.f};
    if (gw < nrows) { const float* xp = (from_input ? xrow_in(p, gw) : xrow(p, gw)) + lane * 4; v0 = *(const f32x4*)(xp); v1 = *(const f32x4*)(xp + 256); v2 = *(const f32x4*)(xp + 512); v3 = *(const f32x4*)(xp + 768); }
    for (int row = gw; row < nrows; row += nw) {
        const int nrow = row + nw;
        if (nrow < nrows) { const float* xp = (from_input ? xrow_in(p, nrow) : xrow(p, nrow)) + lane * 4; n0 = *(const f32x4*)(xp); n1 = *(const f32x4*)(xp + 256); n2 = *(const f32x4*)(xp + 512); n3 = *(const f32x4*)(xp + 768); }
        int b, key; bool lat; row_bk(row, b, key, lat);
        const float* md = (const float*)(p.ws + WS_MOD) + (size_t)(l * 5 + (lat ? b : 4)) * 6144;
        const f32x4 v[4] = {v0, v1, v2, v3};
        float ss = 0.f;
#pragma unroll
        for (int i = 0; i < 4; ++i) ss += v[i][0] * v[i][0] + v[i][1] * v[i][1] + v[i][2] * v[i][2] + v[i][3] * v[i][3];
#pragma unroll
        for (int o = 32; o >= 1; o >>= 1) ss += __shfl_xor(ss, o);
        const float rinv = rsqrtf(ss * (1.0f / 1024.0f) + EPS);
#pragma unroll
        for (int i = 0; i < 4; ++i) {
            const int d = i * 256 + lane * 4;
            const f32x4 gg = *(const f32x4*)(g + d), sh = *(const f32x4*)(md + shift_off + d), sc = *(const f32x4*)(md + scale_off + d);
            float o[4];
#pragma unroll
            for (int j = 0; j < 4; ++j) o[j] = v[i][j] * rinv * gg[j] * (1.0f + sc[j]) + sh[j];
            uint2 w; w.x = pack2(o[0], o[1]); w.y = pack2(o[2], o[3]);
            *(uint2*)(H + (size_t)row * 1024 + d) = w;
        }
        v0 = n0; v1 = n1; v2 = n2; v3 = n3;
    }
}
__device__ void phase0(const Params& p, char* smem) {
    const size_t gtid = (size_t)blockIdx.x * 256 + threadIdx.x, gthreads = (size_t)gridDim.x * 256;
    const int tid = opaque_tid();
    if (gtid < 2 * 512) {
        const int dir = (int)gtid >> 9, cidx = (int)gtid & 511;
        float e[4], mx = -1e30f, s = 0.f;
#pragma unroll
        for (int l = 0; l < 4; ++l) { e[l] = p.hg_lb[(dir * 4 + l) * 512 + cidx]; mx = fmaxf(mx, e[l]); }
#pragma unroll
        for (int l = 0; l < 4; ++l) { e[l] = expf(e[l] - mx); s += e[l]; }
        float cum = 0.f;
#pragma unroll
        for (int l = 0; l < 4; ++l) { if (l > 0) cum += e[l] / s; ((float*)(p.ws + WS_LB))[(dir * 4 + l) * 512 + cidx] = cum; }
    }
    if (gtid >= 1024 && gtid < 1024 + 1024) {
        const int i = (int)gtid - 1024, pos = i >> 3, f = i & 7;
        const float inv = powf(10000.0f, -(float)f / 8.0f);
        const float ang = (float)pos * inv;
        ((float*)(p.ws + WS_ROPE))[i * 2] = cosf(ang); ((float*)(p.ws + WS_ROPE))[i * 2 + 1] = sinf(ang);
    }
    if (gtid >= 2048 && gtid < 2048 + 4) {
        const int l = (int)gtid - 2048;
        float s1 = 0.f, s2 = 0.f;
        for (int i = 0; i < 32; ++i) { s1 += p.da_lambda[(l * 4 + 0) * 32 + i] * p.da_lambda[(l * 4 + 1) * 32 + i]; s2 += p.da_lambda[(l * 4 + 2) * 32 + i] * p.da_lambda[(l * 4 + 3) * 32 + i]; }
        ((float*)(p.ws + WS_LAM))[l] = expf(s1) - expf(s2) + (0.8f - 0.6f * expf(-0.3f * (float)l));
    }
    if (gtid >= 4096 && gtid < 4096 + 512) ((unsigned*)(p.ws + WS_KMAX))[gtid - 4096] = 0u;
    float* sl = (float*)smem;
    float* red = sl + 5 * 1024;
    for (int i = tid; i < 5 * 1024; i += 256) {
        const int r = i >> 10, d = i & 1023;
        const float cv = r < 4 ? p.c[r * 1024 + d] : p.c_ctx[d];
        sl[i] = cv / (1.0f + expf(-cv));
    }
    __syncthreads();
    for (int u = blockIdx.x; u < 4 * 96; u += gridDim.x) {
        const int l = u / 96, cb = u % 96, col = tid & 63, kg = tid >> 6;
        const float* w = p.w_mod + (size_t)l * 1024 * 6144 + cb * 64 + col;
        float a[5] = {0.f, 0.f, 0.f, 0.f, 0.f};
        for (int d = kg * 256; d < kg * 256 + 256; ++d) {
            const float wv = w[(size_t)d * 6144];
#pragma unroll
            for (int r = 0; r < 5; ++r) a[r] += sl[r * 1024 + d] * wv;
        }
#pragma unroll
        for (int r = 0; r < 5; ++r) red[(kg * 5 + r) * 64 + col] = a[r];
        __syncthreads();
        if (tid < 64) {
#pragma unroll
            for (int r = 0; r < 5; ++r) {
                const float s = red[(0 * 5 + r) * 64 + tid] + red[(1 * 5 + r) * 64 + tid] + red[(2 * 5 + r) * 64 + tid] + red[(3 * 5 + r) * 64 + tid];
                ((float*)(p.ws + WS_MOD))[(size_t)(l * 5 + r) * 6144 + cb * 64 + tid] = s + p.b_mod[l * 6144 + cb * 64 + tid];
            }
        }
        __syncthreads();
    }
}
__device__ void hgrn_scan(const Params& p) {
    const size_t gtid = (size_t)blockIdx.x * 256 + opaque_tid(), gthreads = (size_t)gridDim.x * 256;
    float* sstb = (float*)(p.ws + WS_SST);
    const float* dseg = (const float*)(p.ws + WS_DSEG);
    for (size_t i = gtid; i < (size_t)32 * 8192; i += gthreads) {
        const int chain = (int)(i >> 13), e = (int)(i & 8191), k = e >> 6;
        float S = 0.f;
        float* sp = sstb + (size_t)chain * 33 * 8192 + e;
        const float* dp = dseg + (size_t)chain * 33 * 128 + k;
#pragma unroll 1
        for (int g0 = 0; g0 < 33; g0 += 11) {
            float t[11], d[11];
#pragma unroll
            for (int q = 0; q < 11; ++q) { t[q] = sp[(size_t)(g0 + q) * 8192]; d[q] = dp[(g0 + q) * 128]; }
#pragma unroll
            for (int q = 0; q < 11; ++q) { sp[(size_t)(g0 + q) * 8192] = S; S = d[q] * S + t[q]; }
        }
    }
}
__device__ void final_norm(const Params& p) {
    const int lane = opaque_tid() & 63;
    const int gw = blockIdx.x * 4 + (threadIdx.x >> 6), nw = gridDim.x * 4;
    for (int row = gw; row < T_LAT; row += nw) {
        float* xp = p.out + (size_t)row * 1024;
        f32x4 v[4]; float ss = 0.f;
#pragma unroll
        for (int i = 0; i < 4; ++i) { v[i] = *(const f32x4*)(xp + i * 256 + lane * 4); ss += v[i][0] * v[i][0] + v[i][1] * v[i][1] + v[i][2] * v[i][2] + v[i][3] * v[i][3]; }
#pragma unroll
        for (int o = 32; o >= 1; o >>= 1) ss += __shfl_xor(ss, o);
        const float rinv = rsqrtf(ss * (1.0f / 1024.0f) + EPS);
#pragma unroll
        for (int i = 0; i < 4; ++i) {
            const f32x4 gg = *(const f32x4*)(p.g_final + i * 256 + lane * 4);
            f32x4 o;
#pragma unroll
            for (int j = 0; j < 4; ++j) o[j] = v[i][j] * rinv * gg[j];
            *(f32x4*)(xp + i * 256 + lane * 4) = o;
        }
    }
}


#define XB_TMO      128
#define XB_XCNT(j)  (256  + 64 * (j))
#define XB_XSUB(j)  (1280 + 64 * (j))
#define XB_XGEN(j)  (2304 + 64 * (j))
#define XB_TOP      3328
#define XB_TOPGEN   3392
#define XCD_BAR_WORDS 3456
#define XB_SPIN_CAP (1u << 22)
__device__ __forceinline__ unsigned xb_ld(unsigned* p)              { return __hip_atomic_load(p, __ATOMIC_RELAXED, __HIP_MEMORY_SCOPE_AGENT); }
__device__ __forceinline__ unsigned xb_add(unsigned* p, unsigned v) { return __hip_atomic_fetch_add(p, v, __ATOMIC_RELAXED, __HIP_MEMORY_SCOPE_AGENT); }
__device__ __forceinline__ unsigned xb_xcc_id() { return (unsigned)__builtin_amdgcn_s_getreg((3 << 11) | 20) & 0xFu; }
#define XB_SPIN(cond, bar) do { unsigned _sp = 0; while (cond) { __builtin_amdgcn_s_sleep(1); \
    if ((++_sp & 255u) == 0u) { if (xb_ld(&(bar)[XB_TMO])) break; if (_sp > XB_SPIN_CAP) { atomicAdd(&(bar)[XB_TMO], 1u); break; } } } } while (0)
__device__ __forceinline__ void xcd_barrier_complete(unsigned* bar, unsigned x, unsigned& nloc, unsigned& nx) {
    const unsigned G = gridDim.x;
    unsigned sum, cnt, mine, sp = 0u;
    for (;;) {
        sum = 0u; cnt = 0u; mine = 0u;
#pragma unroll
        for (unsigned j = 0; j < 16; ++j) { const unsigned c = xb_ld(&bar[XB_XCNT(j)]); sum += c; cnt += (c > 0u) ? 1u : 0u; mine = (j == x) ? c : mine; }
        if (sum == G) break;
        __builtin_amdgcn_s_sleep(1);
        if ((++sp & 255u) == 0u) { if (xb_ld(&bar[XB_TMO])) break; if (sp > XB_SPIN_CAP) { atomicAdd(&bar[XB_TMO], 1u); break; } }
    }
    nloc = mine > 0u ? mine : 1u; nx = cnt > 0u ? cnt : 1u;
}
__device__ __forceinline__ void gsync(char* ws, unsigned& epoch) {
    asm volatile("s_waitcnt vmcnt(0) lgkmcnt(0)" ::: "memory");
    __syncthreads();
    ++epoch;
    if (threadIdx.x == 0) {
        extern __shared__ __attribute__((aligned(16))) char smem_[];
        volatile unsigned* st = (volatile unsigned*)(smem_ + 73728 + 768);
        unsigned* bar = (unsigned*)(ws + WS_XBAR);
        const unsigned x = xb_xcc_id();
        __builtin_amdgcn_s_waitcnt(0);
        unsigned nloc = st[0], nx = st[1];
        if (nloc == 0u) { xcd_barrier_complete(bar, x, nloc, nx); st[0] = nloc; st[1] = nx; }
        const unsigned old = xb_add(&bar[XB_XSUB(x)], 1u);
        const unsigned gen = old / nloc;
        if (old + 1u == (gen + 1u) * nloc) {
            __builtin_amdgcn_fence(__ATOMIC_RELEASE, "agent");
            asm volatile("s_waitcnt vmcnt(0)" ::: "memory");
            const unsigned og = xb_add(&bar[XB_TOP], 1u);
            const unsigned tg = og / nx;
            if (og + 1u == (tg + 1u) * nx) xb_add(&bar[XB_TOPGEN], 1u);
            else XB_SPIN(xb_ld(&bar[XB_TOPGEN]) == tg, bar);
            __builtin_amdgcn_fence(__ATOMIC_ACQUIRE, "agent");
            xb_add(&bar[XB_XGEN(x)], 1u);
            asm volatile("s_waitcnt vmcnt(0)" ::: "memory");
        } else {
            XB_SPIN(xb_ld(&bar[XB_XGEN(x)]) == gen, bar);
            __builtin_amdgcn_fence(__ATOMIC_ACQUIRE, "agent");
            asm volatile("s_waitcnt vmcnt(0)" ::: "memory");
        }
    }
    __syncthreads();
}

__device__ __forceinline__ int next_unit(char* ws, int qidx, char* smem) {
    int* sh = (int*)(smem + 73728 + 512);
    __syncthreads();
    if (threadIdx.x == 0) *sh = (int)__hip_atomic_fetch_add((unsigned*)(ws + WS_BAR + 32) + qidx, 1u, __ATOMIC_RELAXED, __HIP_MEMORY_SCOPE_AGENT);
    __syncthreads();
    return *sh;
}

__device__ __forceinline__ bool tile_of(int r, int nt, int total, int& tm, int& tn, int G = 8) {
    const int bx = blockIdx.x, nx = gridDim.x >> 3;
    const int L = (r * 8 + (bx & 7)) * nx + (bx >> 3);
    if (L >= total || nx != 64) { if (nx == 64) return false; const int u = bx + r * gridDim.x; if (u >= total) return false; tm = u / nt; tn = u % nt; return true; }
    const int mg = L / (nt * G), rem = L % (nt * G);
    tn = rem / G; tm = mg * G + (rem % G);
    return true;
}
__device__ __forceinline__ Params launder(const Params& p) {
    Params q = p;
    GAS char* w = (GAS char*)p.ws; GAS float* o = (GAS float*)p.out;
    asm volatile("" : "+s"(w), "+s"(o));
    q.ws = (char*)w; q.out = (float*)o;
    return q;
}
__global__ void __launch_bounds__(256, 2) fwd_megakernel(Params p0) {
    extern __shared__ __attribute__((aligned(16))) char smem[];
    cg::grid_group grid = cg::this_grid();
    const size_t gtid = (size_t)blockIdx.x * 256 + threadIdx.x, gthreads = (size_t)gridDim.x * 256;
    float* rs = (float*)(smem + 73728);
    unsigned epoch = 0;
    if (threadIdx.x == 0) { volatile unsigned* st = (volatile unsigned*)(smem + 73728 + 768); st[0] = 0u; st[1] = 0u; (void)xb_add((unsigned*)(p0.ws + WS_XBAR) + XB_XCNT(xb_xcc_id()), 1u); }
    __syncthreads();
    grid.sync();

#ifndef OPK
#define OPK 1024
#define OPK0 0
#endif
#ifndef REP_SKIP_ATT
#define REP_SKIP_ATT 0
#endif
#ifndef REP_B
#define REP_B 1
#endif
#ifndef REP_D
#define REP_D 1
#endif
#ifndef REP_E
#define REP_E 1
#endif
#ifndef REP_H
#define REP_H 1
#endif
#ifndef PM
#define PM 0xffff
#endif
    { const Params p = launder(p0); if (PM & 1) phase0(p, smem); }
    { const Params p = launder(p0); if (PM & 2) convert_layer(p, 0, gtid, gthreads); }
    gsync(p0.ws, epoch);

    for (int l = 0; l < 4; ++l) {
        const bool last = (l == 3);
        { const Params p = launder(p0); if (PM & 4) adaln_phase(p, l, p.g_mix + l * 1024, 0, 1024, T_ALL); }
        { const Params p = launder(p0); if ((PM & 2) && l > 0) convert_layer(p, l, gtid, gthreads); }
        gsync(p0.ws, epoch);
        const bool split_tail = (gridDim.x == 512);
        if ((PM & 8) && split_tail && blockIdx.x < 488) {
            const Params p = launder(p0);
            const int L = 3584 + (blockIdx.x >> 1), mg = L / 116, rem = L % 116;
            const int tn = rem >> 2, row0 = (mg * 4 + (rem & 3)) * 256 + (blockIdx.x & 1) * 128;
            gemm_tile_core((const bf16_t*)(p.ws + WS_H) + (size_t)row0 * 1024, 1024, (const bf16_t*)(p.ws + WS_WIN) + (size_t)tn * 128 * 1024, 1024, 1024, smem);
            epi_inproj(p, l, row0, tn, (const float*)smem);
            __syncthreads();
        }
        if (PM & 8) for (int rr = 0;; ++rr) {
            int tm, tn; if (!tile_of(rr, 29, split_tail ? 3584 : 132 * 29, tm, tn, 4)) break;
            const Params p = launder(p0);
            Acc2 C;
            gemm_tile_core2((const bf16_t*)(p.ws + WS_H) + (size_t)tm * 256 * 1024, 1024, (const bf16_t*)(p.ws + WS_WIN) + (size_t)tn * 128 * 1024, 1024, 1024, smem, C);
            gemm2_stage(C, 0, smem);
            epi_inproj(p, l, tm * 256, tn, (const float*)smem);
            __syncthreads();
            gemm2_stage(C, 1, smem);
            epi_inproj(p, l, tm * 256 + 128, tn, (const float*)smem);
            __syncthreads();
        }
        gsync(p0.ws, epoch);
        for (int rep = 0; rep < REP_D; ++rep) { if (rep) gsync(p0.ws, epoch);
        for (;;) {
            const int u = next_unit(p0.ws, l * 2 + 0 + rep * 8, smem);
            if (u >= 528 + 2 * 1584) break;
            const Params p = launder(p0);
            if (u < 528) { if (PM & 16) {
                const int g = u % 33, ch = u / 33, h = ch & 3, b = (ch >> 2) & 3;
                hgrn_h1_pair(p, l, b, h, g, smem); }
            } else if (!(PM & 32)) {} else if (u < 528 + 1584) {
                const int v = u - 528, tm = v / 6, h = v % 6;
                row_rstd(p, 0, tm * 128, rs);
                gemm_tile_core((const bf16_t*)(p.ws + WS_CQ) + (size_t)tm * 128 * 256, 256, (const bf16_t*)(p.ws + WS_WUQ) + (size_t)h * 128 * 256, 256, 256, smem);
                epi_uq(p, tm * 128, h, (const float*)smem, rs);
                __syncthreads();
            } else {
                const int v = u - 528 - 1584, tm = v / 6, h = v % 6;
                row_rstd(p, 1, tm * 128, rs);
                gemm_tile_core((const bf16_t*)(p.ws + WS_CKV) + (size_t)tm * 128 * 128, 128, (const bf16_t*)(p.ws + WS_WUKV) + (size_t)h * 128 * 128, 128, 128, smem);
                epi_ukv(p, l, tm * 128, h, (const float*)smem, rs);
                __syncthreads();
            }
        } }
        gsync(p0.ws, epoch);
        { const Params p = launder(p0); if (PM & 64) hgrn_scan(p); }
        gsync(p0.ws, epoch);
        {
            { int* st2 = (int*)(smem + 73728 + 520); __syncthreads(); if (threadIdx.x == 0) { st2[0] = 0; } }
            for (;;) {
                    int* sh = (int*)(smem + 73728 + 512);
                    __syncthreads();
                    if (threadIdx.x == 0) {
                        const int qlen_ = 450 + (l == 3 ? 0 : 12);
                        const unsigned xq_ = xb_xcc_id() & 7u;
                        int dq_ = sh[2], got = -1, qq = 0;
                        while (dq_ < 8) {
                            qq = (int)((xq_ + dq_) & 7u);
                            const int v = (int)__hip_atomic_fetch_add((unsigned*)(p0.ws + WS_XBAR) + l * 8 + qq, 1u, __ATOMIC_RELAXED, __HIP_MEMORY_SCOPE_AGENT);
                            if (v < qlen_) { got = v; break; }
                            ++dq_;
                        }
                        sh[2] = dq_; sh[0] = got; sh[1] = qq;
                    }
                    __syncthreads();
                    const int i = __builtin_amdgcn_readfirstlane(sh[0]), q = __builtin_amdgcn_readfirstlane(sh[1]);
                    if (i < 0) break;
                    const Params p = launder(p0);
                    const int nh3 = (i + 2) / 3 < 66 ? (i + 2) / 3 : 66;
                    if (i < 450 && i % 3 == 0 && i / 3 < 66) { if (PM & 256) hgrn3_unit(p, l, q * 66 + i / 3, smem); }
                    else {
                        int b, hh, qbi;
                        if (i < 450) { const int a = i - nh3; const int bh = q + 8 * (a >> 6); qbi = a & 63; b = (bh / 6) & 3; hh = (bh >= 24 ? 6 : 0) + bh % 6; }
                        else { const int cidx = q * 12 + (i - 450); qbi = 64 + (cidx & 1); const int bh = cidx >> 1; hh = bh % 12; b = bh / 12; }
                        if (PM & 128) attn_unit(p, l, b, hh, qbi, smem);
                    }
            }
        }
        gsync(p0.ws, epoch);
        const int ntm = last ? 256 : 264;
        if (PM & 512) {
            if (!last && blockIdx.x < 64) {
                const Params p = launder(p0);
                const int tm = 256 + (blockIdx.x >> 3), tn = blockIdx.x & 7;
                gemm_tile_core((const bf16_t*)(p.ws + WS_H) + (size_t)tm * 128 * 1024, 1024, (const bf16_t*)(p.ws + WS_WOUT) + (size_t)tn * 128 * 1024, 1024, 1024, smem);
                epi_resid(p, l, tm * 128, tn * 128, 2 * 1024, (const float*)smem);
                __syncthreads();
            }
            for (int rr = 0;; ++rr) {
                int tm, tn; if (!tile_of(rr, 8, 128 * 8, tm, tn, 4)) break;
                const Params p = launder(p0);
                Acc2 C;
                gemm_tile_core2((const bf16_t*)(p.ws + WS_H) + (size_t)tm * 256 * 1024, 1024, (const bf16_t*)(p.ws + WS_WOUT) + (size_t)tn * 128 * 1024, 1024, 1024, smem, C);
                gemm2_stage(C, 0, smem);
                epi_resid(p, l, tm * 256, tn * 128, 2 * 1024, (const float*)smem);
                __syncthreads();
                gemm2_stage(C, 1, smem);
                epi_resid(p, l, tm * 256 + 128, tn * 128, 2 * 1024, (const float*)smem);
                __syncthreads();
            }
        }
        gsync(p0.ws, epoch);
        { const Params p = launder(p0); adaln_phase(p, l, p.g_mlp + l * 1024, 3 * 1024, 4 * 1024, ntm * 128); }
        gsync(p0.ws, epoch);
        if ((PM & 1024) && !last && blockIdx.x < 256) {
            const Params p = launder(p0);
            const int tm = 256 + (blockIdx.x >> 5), tn = blockIdx.x & 31;
            gemm_tile_core((const bf16_t*)(p.ws + WS_H) + (size_t)tm * 128 * 1024, 1024, (const bf16_t*)(p.ws + WS_WFF1) + (size_t)tn * 128 * 1024, 1024, 1024, smem);
            epi_ff1(p, tm * 128, tn * 128, (const float*)smem);
            __syncthreads();
        }
        if (PM & 1024) for (int rr = 0;; ++rr) {
            int tm, tn; if (!tile_of(rr, 32, 128 * 32, tm, tn, 4)) break;
            const Params p = launder(p0);
            Acc2 C;
            gemm_tile_core2((const bf16_t*)(p.ws + WS_H) + (size_t)tm * 256 * 1024, 1024, (const bf16_t*)(p.ws + WS_WFF1) + (size_t)tn * 128 * 1024, 1024, 1024, smem, C);
            gemm2_stage(C, 0, smem);
            epi_ff1(p, tm * 256, tn * 128, (const float*)smem);
            __syncthreads();
            gemm2_stage(C, 1, smem);
            epi_ff1(p, tm * 256 + 128, tn * 128, (const float*)smem);
            __syncthreads();
        }
        gsync(p0.ws, epoch);
        if (PM & 2048) {
            if (!last && blockIdx.x < 64) {
                const Params p = launder(p0);
                const int tm = 256 + (blockIdx.x >> 3), tn = blockIdx.x & 7;
                gemm_tile_core((const bf16_t*)(p.ws + WS_H1) + (size_t)tm * 128 * 4096, 4096, (const bf16_t*)(p.ws + WS_WFF2) + (size_t)tn * 128 * 4096, 4096, 4096, smem);
                epi_resid(p, l, tm * 128, tn * 128, 5 * 1024, (const float*)smem);
                __syncthreads();
            }
            for (int rr = 0;; ++rr) {
                int tm, tn; if (!tile_of(rr, 8, 128 * 8, tm, tn, 4)) break;
                const Params p = launder(p0);
                Acc2 C;
                gemm_tile_core2((const bf16_t*)(p.ws + WS_H1) + (size_t)tm * 256 * 4096, 4096, (const bf16_t*)(p.ws + WS_WFF2) + (size_t)tn * 128 * 4096, 4096, 4096, smem, C);
                gemm2_stage(C, 0, smem);
                epi_resid(p, l, tm * 256, tn * 128, 5 * 1024, (const float*)smem);
                __syncthreads();
                gemm2_stage(C, 1, smem);
                epi_resid(p, l, tm * 256 + 128, tn * 128, 5 * 1024, (const float*)smem);
                __syncthreads();
            }
        }
        gsync(p0.ws, epoch);
    }
    { const Params p = launder(p0); final_norm(p); }
}

extern "C" void kernel_launch(void* const* d_in, const int* in_sizes, int n_in, void* d_out, int out_size, void* d_ws, size_t ws_size, hipStream_t stream) {
    static int grid_blocks = 0;
    if (!grid_blocks) {
        int dev = 0, cus = 0, per_cu = 0;
        hipGetDevice(&dev);
        hipDeviceGetAttribute(&cus, hipDeviceAttributeMultiprocessorCount, dev);
        hipFuncSetAttribute((const void*)fwd_megakernel, hipFuncAttributeMaxDynamicSharedMemorySize, SMEM_BYTES);
        hipOccupancyMaxActiveBlocksPerMultiprocessor(&per_cu, (const void*)fwd_megakernel, 256, SMEM_BYTES);
        if (per_cu < 1) per_cu = 1;
        if (per_cu > 2) per_cu = 2;
        grid_blocks = cus * per_cu;
        if (ws_size < WS_END2) fprintf(stderr, "workspace too small: %zu < %zu\n", ws_size, (size_t)WS_END2);
    }
    hipMemsetAsync((char*)d_ws + WS_BAR, 0, 128, stream);
    hipMemsetAsync((char*)d_ws + WS_XBAR, 0, XCD_BAR_WORDS * 4, stream);
    Params p{};
    const float** pp = (const float**)&p;
    for (int i = 0; i < 21; ++i) pp[i] = (const float*)d_in[i];
    p.out = (float*)d_out; p.ws = (char*)d_ws;
    void* args[] = {&p};
    hipError_t e = hipLaunchCooperativeKernel((const void*)fwd_megakernel, dim3(grid_blocks), dim3(256), args, SMEM_BYTES, stream);
    if (e != hipSuccess) fprintf(stderr, "cooperative launch failed: %s (grid %d)\n", hipGetErrorString(e), grid_blocks);
}
```

```cpp
#include <hip/hip_runtime.h>
#include <hip/hip_cooperative_groups.h>
#include <stdint.h>
#include <cstdio>
namespace cg = cooperative_groups;

#define GAS __attribute__((address_space(1)))
typedef unsigned short bf16_t;
typedef short bf16x8 __attribute__((ext_vector_type(8)));
typedef short bf16x4 __attribute__((ext_vector_type(4)));
typedef float f32x16 __attribute__((ext_vector_type(16)));
typedef float f32x4 __attribute__((ext_vector_type(4)));
typedef unsigned u32x4 __attribute__((ext_vector_type(4)));
typedef unsigned u32x2 __attribute__((ext_vector_type(2)));
#define MK8(a,b,c,d) __builtin_bit_cast(bf16x8, (u32x4){(a),(b),(c),(d)})
#define MK4(a,b) __builtin_bit_cast(bf16x4, (u32x2){(a),(b)})

constexpr int T_LAT = 32768, T_CTX = 1024, T_ALL = 33792, NKEY = 8448, DM = 1024, NIN = 3712, DFF = 4096;
constexpr float EPS = 1e-6f;
constexpr float LOG2E = 1.4426950408889634f;

constexpr size_t WS_WIN = 0;
constexpr size_t WS_WOUT = WS_WIN + (size_t)NIN * 1024 * 2;
constexpr size_t WS_WFF1 = WS_WOUT + (size_t)1024 * 1024 * 2;
constexpr size_t WS_WFF2 = WS_WFF1 + (size_t)4096 * 1024 * 2;
constexpr size_t WS_WUQ = WS_WFF2 + (size_t)4096 * 1024 * 2;
constexpr size_t WS_WUKV = WS_WUQ + (size_t)768 * 256 * 2;
constexpr size_t WS_XC = WS_WUKV + (size_t)768 * 128 * 2;
constexpr size_t WS_MOD = WS_XC + (size_t)1024 * 1024 * 4;
constexpr size_t WS_LB = WS_MOD + (size_t)4 * 5 * 6144 * 4;
constexpr size_t WS_LAM = WS_LB + (size_t)2 * 4 * 512 * 4;
constexpr size_t WS_ROPE = WS_LAM + 256;
constexpr size_t WS_KMAX = WS_ROPE + 8192;
constexpr size_t WS_DSEG = WS_KMAX + 2048;
constexpr size_t WS_H = WS_DSEG + (size_t)32 * 33 * 128 * 4;
constexpr size_t WS_R = WS_H + (size_t)T_ALL * 1024 * 2;
constexpr size_t WS_QDA = WS_R;
constexpr size_t WS_KDA = WS_QDA + (size_t)T_ALL * 384 * 2;
constexpr size_t WS_VDAT = WS_KDA + (size_t)T_ALL * 384 * 2;
constexpr size_t WS_QMLA = WS_VDAT + (size_t)T_ALL * 384 * 2;
constexpr size_t WS_KMLA = WS_QMLA + (size_t)T_ALL * 576 * 2;
constexpr size_t WS_VMLAT = WS_KMLA + (size_t)T_ALL * 576 * 2;
constexpr size_t WS_CQ = WS_VMLAT + (size_t)T_ALL * 384 * 2;
constexpr size_t WS_CKV = WS_CQ + (size_t)T_ALL * 256 * 2;
constexpr size_t WS_KR = WS_CKV + (size_t)T_ALL * 128 * 2;
constexpr size_t WS_HG = WS_KR + (size_t)T_ALL * 32 * 2;
constexpr size_t WS_SST = WS_HG + (size_t)T_ALL * 2048 * 2;
constexpr size_t WS_END = WS_SST + (size_t)32 * 33 * 8192 * 4;
constexpr size_t WS_XBAR = WS_END;
constexpr size_t WS_SSQ = WS_XBAR + 16384;
constexpr size_t WS_END2 = WS_SSQ + (size_t)T_ALL * 4 * 4;
constexpr size_t WS_H1 = WS_R;
constexpr size_t WS_BAR = WS_LAM + 128;
static_assert(WS_R + (size_t)T_ALL * 4096 * 2 <= WS_END + (64u << 20), "h1 overlay");
static_assert(WS_END2 <= 536870912ull, "workspace too large");
static_assert(WS_R + (size_t)T_ALL * 4096 * 2 <= 536870912ull, "workspace too large (h1)");

constexpr int SMEM_BYTES = 73728 + 1024;

struct Params {
    const float *x, *c, *ctx, *c_ctx, *w_mod, *b_mod, *g_mix, *g_mlp, *w_in, *w_out, *da_lambda, *da_subln_g, *g_cq, *g_ckv, *w_uq, *w_ukv, *hg_lb, *hg_norm_g, *w_ff1, *w_ff2, *g_final;
    float* out;
    char* ws;
};

__device__ __forceinline__ int opaque_tid() { int t = threadIdx.x; asm volatile("" : "+v"(t)); return t; }
__device__ __forceinline__ bf16_t f2bf(float f) { unsigned u = __float_as_uint(f); u += 0x7fffu + ((u >> 16) & 1u); return (bf16_t)(u >> 16); }
__device__ __forceinline__ float bf2f(bf16_t h) { return __uint_as_float(((unsigned)h) << 16); }
typedef __bf16 bf16v2_t __attribute__((ext_vector_type(2)));
typedef float f32v2_t __attribute__((ext_vector_type(2)));
__device__ __forceinline__ unsigned pack2(float a, float b) { const f32v2_t f = {a, b}; const bf16v2_t r = __builtin_convertvector(f, bf16v2_t); return __builtin_bit_cast(unsigned, r); }
__device__ __forceinline__ unsigned cvt_pk(float lo, float hi) { return pack2(lo, hi); }
__device__ __forceinline__ float ld_coh(const float* p) { return __hip_atomic_load(p, __ATOMIC_RELAXED, __HIP_MEMORY_SCOPE_AGENT); }
__device__ __forceinline__ float fexp2(float x) { return __builtin_amdgcn_exp2f(x); }
__device__ __forceinline__ float fexp(float x) { return __builtin_amdgcn_exp2f(x * LOG2E); }

__device__ __forceinline__ void row_bk(int row, int& b, int& key, bool& lat) {
    if (row < T_LAT) { b = row >> 13; key = 256 + (row & 8191); lat = true; }
    else { int r = row - T_LAT; b = r >> 8; key = r & 255; lat = false; }
}
__device__ __forceinline__ const float* xrow_in(const Params& p, int row) {
    return row < T_LAT ? p.x + (size_t)row * 1024 : p.ctx + (size_t)(row - T_LAT) * 1024;
}
__device__ __forceinline__ float* xrow(const Params& p, int row) {
    return row < T_LAT ? p.out + (size_t)row * 1024 : (float*)(p.ws + WS_XC) + (size_t)(row - T_LAT) * 1024;
}

__device__ __forceinline__ void gemm_tile_core(const bf16_t* __restrict__ A, int lda, const bf16_t* __restrict__ Bt, int ldb, int K, char* smem) {
    const int tid = opaque_tid(), lane = tid & 63, wid = tid >> 6;
    const int wm = wid >> 1, wn = wid & 1, l31 = lane & 31, hi = lane >> 5;
    f32x16 acc[2][2];
#pragma unroll
    for (int i = 0; i < 2; ++i)
#pragma unroll
        for (int j = 0; j < 2; ++j)
#pragma unroll
            for (int r = 0; r < 16; ++r) acc[i][j][r] = 0.f;
    const int lrow = tid >> 3, lkc = tid & 7;
    const bf16_t* ap = A + (size_t)lrow * lda + lkc * 8;
    const bf16_t* bp = Bt + (size_t)lrow * ldb + lkc * 8;
    uint4 p0, p1, p2, p3, p4, p5, p6, p7, q0, q1, q2, q3, q4, q5, q6, q7;
    const int nk = K >> 6;
    const size_t sA = (size_t)32 * lda, sB = (size_t)32 * ldb;
#define G_LOAD0(KT) { const bf16_t* a_ = ap + (KT) * 64; const bf16_t* b_ = bp + (KT) * 64; p0 = *(const uint4*)(a_); p1 = *(const uint4*)(a_ + sA); p2 = *(const uint4*)(a_ + 2 * sA); p3 = *(const uint4*)(a_ + 3 * sA); \
        p4 = *(const uint4*)(b_); p5 = *(const uint4*)(b_ + sB); p6 = *(const uint4*)(b_ + 2 * sB); p7 = *(const uint4*)(b_ + 3 * sB); }
#define G_LOAD1(KT) { const bf16_t* a_ = ap + (KT) * 64; const bf16_t* b_ = bp + (KT) * 64; q0 = *(const uint4*)(a_); q1 = *(const uint4*)(a_ + sA); q2 = *(const uint4*)(a_ + 2 * sA); q3 = *(const uint4*)(a_ + 3 * sA); \
        q4 = *(const uint4*)(b_); q5 = *(const uint4*)(b_ + sB); q6 = *(const uint4*)(b_ + 2 * sB); q7 = *(const uint4*)(b_ + 3 * sB); }
#define G_WRITE0(BUF) { char* wa_ = smem + (BUF) * 36864 + lrow * 144 + lkc * 16; char* wb_ = wa_ + 18432; *(uint4*)(wa_) = p0; *(uint4*)(wa_ + 4608) = p1; *(uint4*)(wa_ + 9216) = p2; *(uint4*)(wa_ + 13824) = p3; \
        *(uint4*)(wb_) = p4; *(uint4*)(wb_ + 4608) = p5; *(uint4*)(wb_ + 9216) = p6; *(uint4*)(wb_ + 13824) = p7; }
#define G_WRITE1(BUF) { char* wa_ = smem + (BUF) * 36864 + lrow * 144 + lkc * 16; char* wb_ = wa_ + 18432; *(uint4*)(wa_) = q0; *(uint4*)(wa_ + 4608) = q1; *(uint4*)(wa_ + 9216) = q2; *(uint4*)(wa_ + 13824) = q3; \
        *(uint4*)(wb_) = q4; *(uint4*)(wb_ + 4608) = q5; *(uint4*)(wb_ + 9216) = q6; *(uint4*)(wb_ + 13824) = q7; }
#define G_COMPUTE(BUF) { const char* sa = smem + (BUF) * 36864; const char* sb = sa + 18432; \
        _Pragma("unroll") for (int ks = 0; ks < 4; ++ks) { bf16x8 af[2], bfr[2]; \
            _Pragma("unroll") for (int i = 0; i < 2; ++i) af[i] = *(const bf16x8*)(sa + (wm * 64 + i * 32 + l31) * 144 + ks * 32 + hi * 16); \
            _Pragma("unroll") for (int j = 0; j < 2; ++j) bfr[j] = *(const bf16x8*)(sb + (wn * 64 + j * 32 + l31) * 144 + ks * 32 + hi * 16); \
            _Pragma("unroll") for (int i = 0; i < 2; ++i) _Pragma("unroll") for (int j = 0; j < 2; ++j) acc[i][j] = __builtin_amdgcn_mfma_f32_32x32x16_bf16(af[i], bfr[j], acc[i][j], 0, 0, 0); } }
    G_LOAD0(0);
    G_WRITE0(0);
    G_LOAD0(1);
    { const int k2 = nk > 2 ? 2 : nk - 1; G_LOAD1(k2); }
    __syncthreads();
    for (int kt = 0; kt < nk; kt += 2) {
        G_COMPUTE(0);
        G_WRITE0(1);
        { const int k3 = kt + 3 < nk ? kt + 3 : nk - 1; G_LOAD0(k3); }
        __syncthreads();
        G_COMPUTE(1);
        G_WRITE1(0);
        { const int k4 = kt + 4 < nk ? kt + 4 : nk - 1; G_LOAD1(k4); }
        __syncthreads();
    }
#undef G_LOAD0
#undef G_LOAD1
#undef G_WRITE0
#undef G_WRITE1
#undef G_COMPUTE
    float* cs = (float*)smem;
#pragma unroll
    for (int i = 0; i < 2; ++i)
#pragma unroll
        for (int j = 0; j < 2; ++j)
#pragma unroll
            for (int r = 0; r < 16; ++r)
                cs[(wm * 64 + i * 32 + 8 * (r >> 2) + 4 * hi + (r & 3)) * 132 + wn * 64 + j * 32 + l31] = acc[i][j][r];
    __syncthreads();
}


struct Acc2 { f32x16 a[4][2]; };
__device__ __forceinline__ void gemm_tile_core2(const bf16_t* __restrict__ A, int lda, const bf16_t* __restrict__ Bt, int ldb, int K, char* smem, Acc2& C) {
    const int tid = opaque_tid(), lane = tid & 63, wid = tid >> 6;
    const int wm = wid >> 1, wn = wid & 1, l31 = lane & 31, hi = lane >> 5;
#pragma unroll
    for (int i = 0; i < 4; ++i)
#pragma unroll
        for (int j = 0; j < 2; ++j)
#pragma unroll
            for (int r = 0; r < 16; ++r) C.a[i][j][r] = 0.f;
    const int lrow = tid >> 2, lkc = tid & 3;
    const bf16_t* ap = A + (size_t)lrow * lda + lkc * 8;
    const bf16_t* bp = Bt + (size_t)lrow * ldb + lkc * 8;
    const size_t sA = (size_t)64 * lda, sB = (size_t)64 * ldb;
    uint4 p0, p1, p2, p3, p4, p5, q0, q1, q2, q3, q4, q5;
    const int nk = K >> 5;
    constexpr int STG = 30720, BOFF = 20480;
#define H_LOAD0(KT) { const bf16_t* a_ = ap + (KT) * 32; const bf16_t* b_ = bp + (KT) * 32; p0 = *(const uint4*)(a_); p1 = *(const uint4*)(a_ + sA); p2 = *(const uint4*)(a_ + 2 * sA); p3 = *(const uint4*)(a_ + 3 * sA); \
        p4 = *(const uint4*)(b_); p5 = *(const uint4*)(b_ + sB); }
#define H_LOAD1(KT) { const bf16_t* a_ = ap + (KT) * 32; const bf16_t* b_ = bp + (KT) * 32; q0 = *(const uint4*)(a_); q1 = *(const uint4*)(a_ + sA); q2 = *(const uint4*)(a_ + 2 * sA); q3 = *(const uint4*)(a_ + 3 * sA); \
        q4 = *(const uint4*)(b_); q5 = *(const uint4*)(b_ + sB); }
#define H_WRITE0(BUF) { char* wa_ = smem + (BUF) * STG + lrow * 80 + lkc * 16; char* wb_ = wa_ + BOFF; *(uint4*)(wa_) = p0; *(uint4*)(wa_ + 5120) = p1; *(uint4*)(wa_ + 10240) = p2; *(uint4*)(wa_ + 15360) = p3; \
        *(uint4*)(wb_) = p4; *(uint4*)(wb_ + 5120) = p5; }
#define H_WRITE1(BUF) { char* wa_ = smem + (BUF) * STG + lrow * 80 + lkc * 16; char* wb_ = wa_ + BOFF; *(uint4*)(wa_) = q0; *(uint4*)(wa_ + 5120) = q1; *(uint4*)(wa_ + 10240) = q2; *(uint4*)(wa_ + 15360) = q3; \
        *(uint4*)(wb_) = q4; *(uint4*)(wb_ + 5120) = q5; }
#define H_COMPUTE(BUF) { const char* sa = smem + (BUF) * STG; const char* sb = sa + BOFF; \
        _Pragma("unroll") for (int ks = 0; ks < 2; ++ks) { bf16x8 af[4], bfr[2]; \
            _Pragma("unroll") for (int i = 0; i < 4; ++i) af[i] = *(const bf16x8*)(sa + (wm * 128 + i * 32 + l31) * 80 + ks * 32 + hi * 16); \
            _Pragma("unroll") for (int j = 0; j < 2; ++j) bfr[j] = *(const bf16x8*)(sb + (wn * 64 + j * 32 + l31) * 80 + ks * 32 + hi * 16); \
            _Pragma("unroll") for (int i = 0; i < 4; ++i) _Pragma("unroll") for (int j = 0; j < 2; ++j) C.a[i][j] = __builtin_amdgcn_mfma_f32_32x32x16_bf16(af[i], bfr[j], C.a[i][j], 0, 0, 0); } }
    H_LOAD0(0);
    H_WRITE0(0);
    H_LOAD0(1);
    { const int k2 = nk > 2 ? 2 : nk - 1; H_LOAD1(k2); }
    __syncthreads();
    for (int kt = 0; kt < nk; kt += 2) {
        H_COMPUTE(0);
        H_WRITE0(1);
        { const int k3 = kt + 3 < nk ? kt + 3 : nk - 1; H_LOAD0(k3); }
        __syncthreads();
        H_COMPUTE(1);
        H_WRITE1(0);
        { const int k4 = kt + 4 < nk ? kt + 4 : nk - 1; H_LOAD1(k4); }
        __syncthreads();
    }
#undef H_LOAD0
#undef H_LOAD1
#undef H_WRITE0
#undef H_WRITE1
#undef H_COMPUTE
}
__device__ __forceinline__ void gemm2_stage(const Acc2& C, int half, char* smem) {
    const int tid = opaque_tid(), lane = tid & 63, wid = tid >> 6;
    const int wm = wid >> 1, wn = wid & 1, l31 = lane & 31, hi = lane >> 5;
    float* cs = (float*)smem;
    if (wm == half) {
#pragma unroll
        for (int i = 0; i < 4; ++i)
#pragma unroll
            for (int j = 0; j < 2; ++j)
#pragma unroll
                for (int r = 0; r < 16; ++r)
                    cs[(i * 32 + 8 * (r >> 2) + 4 * hi + (r & 3)) * 132 + wn * 64 + j * 32 + l31] = C.a[i][j][r];
    }
    __syncthreads();
}

__device__ __forceinline__ void epi_copy_bf16(const float* cs, bf16_t* dst, int ld, int row0, int col0, float sc) {
    const int tid = opaque_tid(), c4 = (tid & 31) * 4, r0 = tid >> 5;
#pragma unroll 4
    for (int i = 0; i < 16; ++i) {
        const int r = r0 + 8 * i;
        const f32x4 v = *(const f32x4*)(cs + r * 132 + c4);
        uint2 w; w.x = pack2(v[0] * sc, v[1] * sc); w.y = pack2(v[2] * sc, v[3] * sc);
        *(uint2*)(dst + (size_t)(row0 + r) * ld + col0 + c4) = w;
    }
}
__device__ __forceinline__ void epi_store_T(const float* cs, int cbase, int ndcols, bf16_t* dstbase  , const float* rs) {
    const int tid = opaque_tid();
    const int items = ndcols * 16;
    for (int it = tid; it < items; it += 256) {
        const int c = it % ndcols, rg = it / ndcols;
        float v[8];
#pragma unroll
        for (int j = 0; j < 8; ++j) { v[j] = cs[(rg * 8 + j) * 132 + cbase + c]; if (rs) v[j] *= rs[rg * 8 + j]; }
        uint4 w; w.x = pack2(v[0], v[1]); w.y = pack2(v[2], v[3]); w.z = pack2(v[4], v[5]); w.w = pack2(v[6], v[7]);
        *(uint4*)(dstbase + (size_t)c * NKEY + rg * 8) = w;
    }
}
__device__ __forceinline__ void rope32(float (&v)[32], int n, const float* rope) {
#pragma unroll
    for (int a = 0; a < 2; ++a) {
        const int pos = a == 0 ? (n >> 6) : (n & 63);
#pragma unroll
        for (int f = 0; f < 8; ++f) {
            const float cs_ = rope[(pos * 8 + f) * 2], sn = rope[(pos * 8 + f) * 2 + 1];
            const float x1 = v[a * 16 + f], x2 = v[a * 16 + 8 + f];
            v[a * 16 + f] = x1 * cs_ - x2 * sn;
            v[a * 16 + 8 + f] = x2 * cs_ + x1 * sn;
        }
    }
}
__device__ __forceinline__ float wave_max(float v) {
#pragma unroll
    for (int o = 32; o >= 1; o >>= 1) v = fmaxf(v, __shfl_xor(v, o));
    return v;
}
__device__ __forceinline__ void store32_bf16(bf16_t* dst, const float (&v)[32], float sc) {
#pragma unroll
    for (int q = 0; q < 4; ++q) {
        uint4 w; w.x = pack2(v[q * 8 + 0] * sc, v[q * 8 + 1] * sc); w.y = pack2(v[q * 8 + 2] * sc, v[q * 8 + 3] * sc);
        w.z = pack2(v[q * 8 + 4] * sc, v[q * 8 + 5] * sc); w.w = pack2(v[q * 8 + 6] * sc, v[q * 8 + 7] * sc);
        *(uint4*)(dst + q * 8) = w;
    }
}

__device__ void epi_inproj(const Params& p, int l, int m0, int tn, const float* cs) {
    const int tid = opaque_tid();
    int b, key0; bool lat; row_bk(m0, b, key0, lat);
    const float* rope = (const float*)(p.ws + WS_ROPE);
    if (tn < 6 || tn == 28) {
        const int r = tid & 127, half = tid >> 7;
        const int row = m0 + r, key = key0 + r;
        const int ngrp = (tn == 28) ? 1 : 4;
        for (int gi = half; gi < ngrp; gi += 2) {
            float v[32];
#pragma unroll
            for (int q = 0; q < 8; ++q) { const f32x4 t = *(const f32x4*)(cs + r * 132 + gi * 32 + q * 4); v[q * 4] = t[0]; v[q * 4 + 1] = t[1]; v[q * 4 + 2] = t[2]; v[q * 4 + 3] = t[3]; }
            if (lat) rope32(v, row & 8191, rope);
            if (tn < 3) {
                bf16_t* dst = (bf16_t*)(p.ws + WS_QDA) + ((size_t)(b * 12 + tn * 4 + gi) * NKEY + key) * 32;
                store32_bf16(dst, v, 0.17677669529663687f * LOG2E);
            } else if (tn < 6) {
                const int hc = (tn - 3) * 4 + gi;
                bf16_t* dst = (bf16_t*)(p.ws + WS_KDA) + ((size_t)(b * 12 + hc) * NKEY + key) * 32;
                store32_bf16(dst, v, 1.0f);
                float n2 = 0.f;
#pragma unroll
                for (int q = 0; q < 32; ++q) n2 += v[q] * v[q];
                n2 = wave_max(n2);
                if ((tid & 63) == 0) atomicMax((unsigned*)(p.ws + WS_KMAX) + (l * 4 + b) * 32 + hc, __float_as_uint(n2));
            } else {
                bf16_t* dst = (bf16_t*)(p.ws + WS_KR) + (size_t)row * 32;
                store32_bf16(dst, v, 1.0f);
            }
        }
    } else if (tn < 9) {
        const int h0 = (tn - 6) * 2;
        bf16_t* dst = (bf16_t*)(p.ws + WS_VDAT) + ((size_t)(b * 6 + h0) * 64) * NKEY + key0;
        epi_store_T(cs, 0, 128, dst, nullptr);
    } else if (tn < 12) {
        if (tn < 11) epi_copy_bf16(cs, (bf16_t*)(p.ws + WS_CQ), 256, m0, (tn - 9) * 128, 1.0f);
        else epi_copy_bf16(cs, (bf16_t*)(p.ws + WS_CKV), 128, m0, 0, 1.0f);
        if (tid < 128) {
            float ssq = 0.f;
#pragma unroll 8
            for (int q = 0; q < 32; ++q) { const f32x4 t = *(const f32x4*)(cs + tid * 132 + q * 4); ssq += t[0] * t[0] + t[1] * t[1] + t[2] * t[2] + t[3] * t[3]; }
            ((float*)(p.ws + WS_SSQ))[(size_t)(m0 + tid) * 4 + (tn - 9)] = ssq;
        }
    } else {
        epi_copy_bf16(cs, (bf16_t*)(p.ws + WS_HG), 2048, m0, (tn - 12) * 128, 1.0f);
    }
}

__device__ __forceinline__ void row_rstd(const Params& p, int which  , int m0, float* rs) {
    const int tid = opaque_tid();
    if (tid < 128) {
        const float* q = (const float*)(p.ws + WS_SSQ) + (size_t)(m0 + tid) * 4;
        rs[tid] = which == 0 ? rsqrtf((q[0] + q[1]) * (1.0f / 256.0f) + EPS) : rsqrtf(q[2] * (1.0f / 128.0f) + EPS);
    }
}
__device__ void epi_uq(const Params& p, int m0, int h, const float* cs, const float* rs) {
    const int tid = opaque_tid(), r = tid & 127, half = tid >> 7;
    int b, key0; bool lat; row_bk(m0, b, key0, lat);
    const int row = m0 + r, key = key0 + r;
    const float sc = rs[r] * 0.10206207261596575f * LOG2E;
    bf16_t* dst = (bf16_t*)(p.ws + WS_QMLA) + ((size_t)(b * 6 + h) * NKEY + key) * 96;
    if (half == 0) {
        float v[32];
#pragma unroll
        for (int q = 0; q < 8; ++q) { const f32x4 t = *(const f32x4*)(cs + r * 132 + q * 4); v[q * 4] = t[0]; v[q * 4 + 1] = t[1]; v[q * 4 + 2] = t[2]; v[q * 4 + 3] = t[3]; }
        store32_bf16(dst, v, sc);
#pragma unroll
        for (int q = 0; q < 4; ++q) { const f32x4 t = *(const f32x4*)(cs + r * 132 + 32 + q * 4); v[q * 4] = t[0]; v[q * 4 + 1] = t[1]; v[q * 4 + 2] = t[2]; v[q * 4 + 3] = t[3]; }
#pragma unroll
        for (int q = 0; q < 2; ++q) {
            uint4 w; w.x = pack2(v[q * 8 + 0] * sc, v[q * 8 + 1] * sc); w.y = pack2(v[q * 8 + 2] * sc, v[q * 8 + 3] * sc);
            w.z = pack2(v[q * 8 + 4] * sc, v[q * 8 + 5] * sc); w.w = pack2(v[q * 8 + 6] * sc, v[q * 8 + 7] * sc);
            *(uint4*)(dst + 32 + q * 8) = w;
        }
    } else {
        float v[32];
#pragma unroll
        for (int q = 0; q < 4; ++q) { const f32x4 t = *(const f32x4*)(cs + r * 132 + 48 + q * 4); v[q * 4] = t[0]; v[q * 4 + 1] = t[1]; v[q * 4 + 2] = t[2]; v[q * 4 + 3] = t[3]; }
#pragma unroll
        for (int q = 0; q < 2; ++q) {
            uint4 w; w.x = pack2(v[q * 8 + 0] * sc, v[q * 8 + 1] * sc); w.y = pack2(v[q * 8 + 2] * sc, v[q * 8 + 3] * sc);
            w.z = pack2(v[q * 8 + 4] * sc, v[q * 8 + 5] * sc); w.w = pack2(v[q * 8 + 6] * sc, v[q * 8 + 7] * sc);
            *(uint4*)(dst + 48 + q * 8) = w;
        }
#pragma unroll
        for (int q = 0; q < 8; ++q) { const f32x4 t = *(const f32x4*)(cs + r * 132 + 64 + q * 4); v[q * 4] = t[0]; v[q * 4 + 1] = t[1]; v[q * 4 + 2] = t[2]; v[q * 4 + 3] = t[3]; }
        if (lat) rope32(v, row & 8191, (const float*)(p.ws + WS_ROPE));
        store32_bf16(dst + 64, v, sc);
    }
}
__device__ void epi_ukv(const Params& p, int l, int m0, int h, const float* cs, const float* rs) {
    const int tid = opaque_tid();
    int b, key0; bool lat; row_bk(m0, b, key0, lat);
    bf16_t* vdst = (bf16_t*)(p.ws + WS_VMLAT) + ((size_t)(b * 6 + h) * 64) * NKEY + key0;
    epi_store_T(cs, 64, 64, vdst, rs);
    if (tid < 128) {
        const int r = tid, row = m0 + r, key = key0 + r;
        const float sc = rs[r];
        bf16_t* dst = (bf16_t*)(p.ws + WS_KMLA) + ((size_t)(b * 6 + h) * NKEY + key) * 96;
        float n2 = 0.f;
        float v[32];
#pragma unroll
        for (int part = 0; part < 2; ++part) {
#pragma unroll
            for (int q = 0; q < 8; ++q) { const f32x4 t = *(const f32x4*)(cs + r * 132 + part * 32 + q * 4); v[q * 4] = t[0] * sc; v[q * 4 + 1] = t[1] * sc; v[q * 4 + 2] = t[2] * sc; v[q * 4 + 3] = t[3] * sc; }
#pragma unroll
            for (int q = 0; q < 32; ++q) n2 += v[q] * v[q];
            store32_bf16(dst + part * 32, v, 1.0f);
        }
        const bf16_t* kr = (const bf16_t*)(p.ws + WS_KR) + (size_t)row * 32;
#pragma unroll
        for (int q = 0; q < 4; ++q) {
            const uint4 w = *(const uint4*)(kr + q * 8);
            *(uint4*)(dst + 64 + q * 8) = w;
            const unsigned ww[4] = {w.x, w.y, w.z, w.w};
#pragma unroll
            for (int j = 0; j < 4; ++j) { const float f0 = __uint_as_float(ww[j] << 16), f1 = __uint_as_float(ww[j] & 0xffff0000u); n2 += f0 * f0 + f1 * f1; }
        }
        n2 = wave_max(n2);
        if ((tid & 63) == 0) atomicMax((unsigned*)(p.ws + WS_KMAX) + (l * 4 + b) * 32 + 12 + h, __float_as_uint(n2));
    }
}
__device__ __forceinline__ void epi_resid(const Params& p, int l, int m0, int n0, int goff, const float* cs) {
    const int tid = opaque_tid(), c4 = (tid & 31) * 4, r0 = tid >> 5;
    int b, key0; bool lat; row_bk(m0, b, key0, lat);
    const float* gate = (const float*)(p.ws + WS_MOD) + (size_t)(l * 5 + (lat ? b : 4)) * 6144 + goff + n0 + c4;
    const f32x4 g = *(const f32x4*)gate;
#pragma unroll 4
    for (int i = 0; i < 16; ++i) {
        const int r = r0 + 8 * i;
        const f32x4 v = *(const f32x4*)(cs + r * 132 + c4);
        float* xp = xrow(p, m0 + r) + n0 + c4;
        const float* xs = (l == 0 && goff == 2 * 1024) ? xrow_in(p, m0 + r) + n0 + c4 : xp;
        f32x4 x = *(const f32x4*)xs;
        x += g * v;
        *(f32x4*)xp = x;
    }
}
__device__ __forceinline__ void epi_ff1(const Params& p, int m0, int n0, const float* cs) {
    const int tid = opaque_tid(), c4 = (tid & 31) * 4, r0 = tid >> 5;
    bf16_t* dst = (bf16_t*)(p.ws + WS_H1);
#pragma unroll 4
    for (int i = 0; i < 16; ++i) {
        const int r = r0 + 8 * i;
        f32x4 v = *(const f32x4*)(cs + r * 132 + c4);
#pragma unroll
        for (int j = 0; j < 4; ++j) { const float t = fmaxf(v[j], 0.f); v[j] = t * t; }
        uint2 w; w.x = pack2(v[0], v[1]); w.y = pack2(v[2], v[3]);
        *(uint2*)(dst + (size_t)(m0 + r) * 4096 + n0 + c4) = w;
    }
}

template <int DQK>
__device__ __forceinline__ void attn_pass(const bf16_t* __restrict__ Qb, const bf16_t* __restrict__ Kb, const bf16_t* __restrict__ VTb,
                                          int q0, int nkt, float kmax, char* smem, f32x16& O0, f32x16& O1, float& lsum) {
    constexpr int KS = DQK * 2 + 16, VS = 136, STAGE = 64 * KS + 64 * VS, NKC = DQK / 32, CPR = DQK / 8;
    const int tid = opaque_tid(), lane = tid & 63, wid = tid >> 6, l31 = lane & 31, hi = lane >> 5;
    bf16x8 qf[DQK / 16];
    const bf16_t* qp = Qb + (size_t)(q0 + wid * 32 + l31) * DQK + hi * 8;
    float qn = 0.f;
#pragma unroll
    for (int ks = 0; ks < DQK / 16; ++ks) {
        qf[ks] = *(const bf16x8*)(qp + ks * 16);
#pragma unroll
        for (int j = 0; j < 8; ++j) { const float f = bf2f((bf16_t)qf[ks][j]); qn += f * f; }
    }
    qn += __shfl_xor(qn, 32);
    const float negm = -(sqrtf(qn) * kmax);
#pragma unroll
    for (int r = 0; r < 16; ++r) { O0[r] = 0.f; O1[r] = 0.f; }
    lsum = 0.f;
    const int kr0 = tid / CPR, kc0 = tid % CPR, kr1 = (tid + 256) / CPR, kc1 = (tid + 256) % CPR, kr2 = (tid + 512) / CPR, kc2 = (tid + 512) % CPR;
    const int vr0 = tid >> 3, vc0 = tid & 7;
    const bf16_t* vg = VTb + (size_t)vr0 * NKEY + vc0 * 8;
    uint4 a0, a1, a2, a3, a4;
#define AT_LOADA(KT) { const bf16_t* kp_ = Kb + (size_t)(KT) * 64 * DQK; a0 = *(const uint4*)(kp_ + (size_t)tid * 8); \
        if constexpr (NKC > 1) { a1 = *(const uint4*)(kp_ + (size_t)(tid + 256) * 8); a2 = *(const uint4*)(kp_ + (size_t)(tid + 512) * 8); } \
        a3 = *(const uint4*)(vg + (KT) * 64); a4 = *(const uint4*)(vg + (size_t)32 * NKEY + (KT) * 64); }
#define AT_WRITE(X0, X1, X2, X3, X4, BUF) { char* sk_ = smem + (BUF) * STAGE; char* sv_ = sk_ + 64 * KS; \
        *(uint4*)(sk_ + kr0 * KS + kc0 * 16) = X0; \
        if constexpr (NKC > 1) { *(uint4*)(sk_ + kr1 * KS + kc1 * 16) = X1; *(uint4*)(sk_ + kr2 * KS + kc2 * 16) = X2; } \
        { uint2* d_ = (uint2*)(sv_ + vr0 * VS + vc0 * 16); d_[0] = make_uint2(X3.x, X3.y); d_[1] = make_uint2(X3.z, X3.w); } \
        { uint2* d_ = (uint2*)(sv_ + (vr0 + 32) * VS + vc0 * 16); d_[0] = make_uint2(X4.x, X4.y); d_[1] = make_uint2(X4.z, X4.w); } }
    f32x16 NEG;
#pragma unroll
    for (int r = 0; r < 16; ++r) NEG[r] = negm;
    auto compute = [&](int buf) {
        const char* sk = smem + buf * STAGE; const char* sv = sk + 64 * KS;
        constexpr int NKS = DQK / 16;
        bf16x8 k0[NKS], k1[NKS], v0[4], v1[4];
#pragma unroll
        for (int ks = 0; ks < NKS; ++ks) k0[ks] = *(const bf16x8*)(sk + (l31)*KS + ks * 32 + hi * 16);
#pragma unroll
        for (int ks = 0; ks < NKS; ++ks) k1[ks] = *(const bf16x8*)(sk + (32 + l31) * KS + ks * 32 + hi * 16);
#pragma unroll
        for (int u = 0; u < 2; ++u)
#pragma unroll
            for (int db = 0; db < 2; ++db) {
                const char* vp = sv + (db * 32 + l31) * VS + (16 * u + 4 * hi) * 2;
                const uint2 x0 = *(const uint2*)vp, x1 = *(const uint2*)(vp + 16);
                v0[u * 2 + db] = MK8(x0.x, x0.y, x1.x, x1.y);
            }
        __builtin_amdgcn_sched_barrier(0);
        f32x16 S0, S1;
#pragma unroll
        for (int ks = 0; ks < NKS; ++ks) S0 = __builtin_amdgcn_mfma_f32_32x32x16_bf16(k0[ks], qf[ks], ks == 0 ? NEG : S0, 0, 0, 0);
#pragma unroll
        for (int ks = 0; ks < NKS; ++ks) S1 = __builtin_amdgcn_mfma_f32_32x32x16_bf16(k1[ks], qf[ks], ks == 0 ? NEG : S1, 0, 0, 0);
        __builtin_amdgcn_sched_barrier(0);
#pragma unroll
        for (int u = 0; u < 2; ++u)
#pragma unroll
            for (int db = 0; db < 2; ++db) {
                const char* vp = sv + (db * 32 + l31) * VS + (32 + 16 * u + 4 * hi) * 2;
                const uint2 x0 = *(const uint2*)vp, x1 = *(const uint2*)(vp + 16);
                v1[u * 2 + db] = MK8(x0.x, x0.y, x1.x, x1.y);
            }
        unsigned pk0[8], pk1[8];
#pragma unroll
        for (int r = 0; r < 16; r += 2) { const float e0 = fexp2(S0[r]), e1 = fexp2(S0[r + 1]); lsum += e0 + e1; pk0[r >> 1] = cvt_pk(e0, e1); }
        __builtin_amdgcn_sched_barrier(0);
#pragma unroll
        for (int u = 0; u < 2; ++u) {
            const bf16x8 pbv = MK8(pk0[4 * u], pk0[4 * u + 1], pk0[4 * u + 2], pk0[4 * u + 3]);
            O0 = __builtin_amdgcn_mfma_f32_32x32x16_bf16(v0[u * 2 + 0], pbv, O0, 0, 0, 0);
            O1 = __builtin_amdgcn_mfma_f32_32x32x16_bf16(v0[u * 2 + 1], pbv, O1, 0, 0, 0);
        }
#pragma unroll
        for (int r = 0; r < 16; r += 2) { const float e0 = fexp2(S1[r]), e1 = fexp2(S1[r + 1]); lsum += e0 + e1; pk1[r >> 1] = cvt_pk(e0, e1); }
        __builtin_amdgcn_sched_barrier(0);
#pragma unroll
        for (int u = 0; u < 2; ++u) {
            const bf16x8 pbv = MK8(pk1[4 * u], pk1[4 * u + 1], pk1[4 * u + 2], pk1[4 * u + 3]);
            O0 = __builtin_amdgcn_mfma_f32_32x32x16_bf16(v1[u * 2 + 0], pbv, O0, 0, 0, 0);
            O1 = __builtin_amdgcn_mfma_f32_32x32x16_bf16(v1[u * 2 + 1], pbv, O1, 0, 0, 0);
        }
    };
    a1 = a2 = make_uint4(0u, 0u, 0u, 0u);
    AT_LOADA(0);
    AT_WRITE(a0, a1, a2, a3, a4, 0);
    AT_LOADA(1);
    __syncthreads();
    for (int kt = 0; kt < nkt; kt += 2) {
        compute(0);
        AT_WRITE(a0, a1, a2, a3, a4, 1);
        { const int k2 = kt + 2 < nkt ? kt + 2 : nkt - 1; AT_LOADA(k2); }
        __syncthreads();
        compute(1);
        AT_WRITE(a0, a1, a2, a3, a4, 0);
        { const int k3 = kt + 3 < nkt ? kt + 3 : nkt - 1; AT_LOADA(k3); }
        __syncthreads();
    }
#undef AT_LOADA
#undef AT_WRITE
    lsum += __shfl_xor(lsum, 32);
}

__device__ void attn_unit(const Params& p, int l, int b, int hh, int qbi, char* smem) {
    const int q0 = qbi < 64 ? 256 + qbi * 128 : (qbi - 64) * 128;
    const int nkt = qbi < 64 ? 132 : 4;
    const int tid = opaque_tid(), lane = tid & 63, wid = tid >> 6, l31 = lane & 31, hi = lane >> 5;
    const int qkey = q0 + wid * 32 + l31;
    const int row = qkey < 256 ? T_LAT + b * 256 + qkey : b * 8192 + qkey - 256;
    const float* kmx = (const float*)(p.ws + WS_KMAX) + (l * 4 + b) * 32;
    bf16_t* Y = (bf16_t*)(p.ws + WS_H);
    if (hh < 6) {
        const int h = hh;
        const bf16_t* VT = (const bf16_t*)(p.ws + WS_VDAT) + ((size_t)(b * 6 + h) * 64) * NKEY;
        f32x16 A0, A1, B0, B1; float la, lb;
        {
            const size_t off = (size_t)(b * 12 + 2 * h) * NKEY * 32;
            attn_pass<32>((const bf16_t*)(p.ws + WS_QDA) + off, (const bf16_t*)(p.ws + WS_KDA) + off, VT, q0, nkt, sqrtf(ld_coh(kmx + 2 * h)), smem, A0, A1, la);
        }
        {
            const size_t off = (size_t)(b * 12 + 2 * h + 1) * NKEY * 32;
            attn_pass<32>((const bf16_t*)(p.ws + WS_QDA) + off, (const bf16_t*)(p.ws + WS_KDA) + off, VT, q0, nkt, sqrtf(ld_coh(kmx + 2 * h + 1)), smem, B0, B1, lb);
        }
        const float lam = ((const float*)(p.ws + WS_LAM))[l];
        const float lam_init = 0.8f - 0.6f * expf(-0.3f * (float)l);
        const float ia = 1.0f / la, ib = lam / lb;
        float ss = 0.f;
#pragma unroll
        for (int r = 0; r < 16; ++r) { A0[r] = A0[r] * ia - B0[r] * ib; A1[r] = A1[r] * ia - B1[r] * ib; ss += A0[r] * A0[r] + A1[r] * A1[r]; }
        ss += __shfl_xor(ss, 32);
        const float rinv = rsqrtf(ss * (1.0f / 64.0f) + EPS) * (1.0f - lam_init);
        const float* g = p.da_subln_g + l * 64;
        bf16_t* yp = Y + (size_t)row * 1024 + h * 64;
#pragma unroll
        for (int q = 0; q < 4; ++q) {
            const int d = 8 * q + 4 * hi;
            const f32x4 g0 = *(const f32x4*)(g + d), g1 = *(const f32x4*)(g + 32 + d);
            uint2 w0, w1;
            w0.x = pack2(A0[4 * q] * rinv * g0[0], A0[4 * q + 1] * rinv * g0[1]); w0.y = pack2(A0[4 * q + 2] * rinv * g0[2], A0[4 * q + 3] * rinv * g0[3]);
            w1.x = pack2(A1[4 * q] * rinv * g1[0], A1[4 * q + 1] * rinv * g1[1]); w1.y = pack2(A1[4 * q + 2] * rinv * g1[2], A1[4 * q + 3] * rinv * g1[3]);
            *(uint2*)(yp + d) = w0; *(uint2*)(yp + 32 + d) = w1;
        }
    } else {
        const int h = hh - 6;
        const bf16_t* VT = (const bf16_t*)(p.ws + WS_VMLAT) + ((size_t)(b * 6 + h) * 64) * NKEY;
        const size_t off = (size_t)(b * 6 + h) * NKEY * 96;
        f32x16 A0, A1; float la;
        attn_pass<96>((const bf16_t*)(p.ws + WS_QMLA) + off, (const bf16_t*)(p.ws + WS_KMLA) + off, VT, q0, nkt, sqrtf(ld_coh(kmx + 12 + h)), smem, A0, A1, la);
        const float ia = 1.0f / la;
        bf16_t* yp = Y + (size_t)row * 1024 + 384 + h * 64;
#pragma unroll
        for (int q = 0; q < 4; ++q) {
            const int d = 8 * q + 4 * hi;
            uint2 w0, w1;
            w0.x = pack2(A0[4 * q] * ia, A0[4 * q + 1] * ia); w0.y = pack2(A0[4 * q + 2] * ia, A0[4 * q + 3] * ia);
            w1.x = pack2(A1[4 * q] * ia, A1[4 * q + 1] * ia); w1.y = pack2(A1[4 * q + 2] * ia, A1[4 * q + 3] * ia);
            *(uint2*)(yp + d) = w0; *(uint2*)(yp + 32 + d) = w1;
        }
    }
}

constexpr int HG_QT = 0, HG_KT = 4352, HG_KH = 8704, HG_VT = 13824, HG_DD = 16384, HG_OSEG = 17408;
template <int MODE>
__device__ void hgrn_pass(const Params& p, int l, int dir, int b, int h, int g, char* smem) {
    const int tid = opaque_tid(), lane = tid & 63, wid = tid >> 6, c = lane & 15, gq = lane >> 4;
    int r0, sgn;
    if (dir == 0) { r0 = g == 0 ? T_LAT + b * 256 : b * 8192 + (g - 1) * 256; sgn = 1; }
    else { r0 = g == 0 ? T_LAT + b * 256 + 255 : b * 8192 + 8191 - (g - 1) * 256; sgn = -1; }
    const bf16_t* HG = (const bf16_t*)(p.ws + WS_HG);
    const int k = tid >> 1, hf = tid & 1;
    const float lbv = ((const float*)(p.ws + WS_LB))[(dir * 4 + l) * 512 + h * 128 + k];
    const float omlb = 1.0f - lbv;
    const int zoff = 512 + dir * 512 + h * 128 + k, qoff = h * 128 + k;
    bf16_t* QT = (bf16_t*)(smem + HG_QT); bf16_t* KT = (bf16_t*)(smem + HG_KT); bf16_t* KH = (bf16_t*)(smem + HG_KH); bf16_t* VT = (bf16_t*)(smem + HG_VT);
    float* DD = (float*)(smem + HG_DD); bf16_t* OSEG = (bf16_t*)(smem + HG_OSEG);
    const int chain = (dir * 4 + b) * 4 + h;
    float* sst = (float*)(p.ws + WS_SST) + (size_t)(chain * 33 + g) * 8192;
    f32x4 S[8];
#pragma unroll
    for (int kb = 0; kb < 8; ++kb)
#pragma unroll
        for (int r = 0; r < 4; ++r) S[kb][r] = (MODE == 0) ? 0.f : sst[(16 * kb + 4 * gq + r) * 64 + 16 * wid + c];
    float btot = 0.f;
    bf16_t zr0, zr1, zr2, zr3, zr4, zr5, zr6, zr7, qr0 = 0, qr1 = 0, qr2 = 0, qr3 = 0, qr4 = 0, qr5 = 0, qr6 = 0, qr7 = 0; uint2 vv;
    const int vt_t = tid >> 4, vt_v4 = (tid & 15) * 4;
#define HG_ROW(SC, T) ((size_t)(r0 + sgn * ((SC) * 16 + (T))) * 2048)
#define HG_PREFETCH(SC) { const bf16_t* zb_ = HG + zoff; \
        zr0 = zb_[HG_ROW(SC, hf * 8 + 0)]; zr1 = zb_[HG_ROW(SC, hf * 8 + 1)]; zr2 = zb_[HG_ROW(SC, hf * 8 + 2)]; zr3 = zb_[HG_ROW(SC, hf * 8 + 3)]; \
        zr4 = zb_[HG_ROW(SC, hf * 8 + 4)]; zr5 = zb_[HG_ROW(SC, hf * 8 + 5)]; zr6 = zb_[HG_ROW(SC, hf * 8 + 6)]; zr7 = zb_[HG_ROW(SC, hf * 8 + 7)]; \
        if (MODE != 0) { const bf16_t* qb_ = HG + qoff; \
        qr0 = qb_[HG_ROW(SC, hf * 8 + 0)]; qr1 = qb_[HG_ROW(SC, hf * 8 + 1)]; qr2 = qb_[HG_ROW(SC, hf * 8 + 2)]; qr3 = qb_[HG_ROW(SC, hf * 8 + 3)]; \
        qr4 = qb_[HG_ROW(SC, hf * 8 + 4)]; qr5 = qb_[HG_ROW(SC, hf * 8 + 5)]; qr6 = qb_[HG_ROW(SC, hf * 8 + 6)]; qr7 = qb_[HG_ROW(SC, hf * 8 + 7)]; } \
        vv = *(const uint2*)(HG + HG_ROW(SC, vt_t) + 1536 + h * 64 + vt_v4); }
    HG_PREFETCH(0);
    for (int sc = 0; sc < 16; ++sc) {
        float bt[8], ky[8], qv[8];
        {
            const bf16_t zz[8] = {zr0, zr1, zr2, zr3, zr4, zr5, zr6, zr7};
            const bf16_t qq[8] = {qr0, qr1, qr2, qr3, qr4, qr5, qr6, qr7};
            float cum = 0.f;
#pragma unroll
            for (int i = 0; i < 8; ++i) {
                const float z = bf2f(zz[i]);
                const float e = fexp(-z);
                const float sg = __builtin_amdgcn_rcpf(1.0f + e);
                const float f = lbv + omlb * sg;
                cum += __builtin_amdgcn_logf(fmaxf(f, 1e-30f)) * 0.6931471805599453f;
                bt[i] = cum; ky[i] = omlb * (1.0f - sg); qv[i] = bf2f(qq[i]);
            }
            const float other = __shfl_xor(cum, 1);
            const float blast = cum + other;
            const float add = hf ? other : 0.f;
#pragma unroll
            for (int i = 0; i < 8; ++i) {
                const int t = hf * 8 + i;
                const float b_ = bt[i] + add;
                if (MODE != 0) {
                    QT[t * 136 + k] = f2bf(qv[i] * fexp(b_));
                    KT[t * 136 + k] = f2bf(ky[i] * fexp(fminf(-b_, 80.f)));
                }
                KH[k * 20 + t] = f2bf(ky[i] * fexp(blast - b_));
            }
            if (hf == 0) DD[k] = fexp(blast);
            btot += blast;
            VT[(vt_v4 + 0) * 20 + vt_t] = (bf16_t)(vv.x & 0xffff); VT[(vt_v4 + 1) * 20 + vt_t] = (bf16_t)(vv.x >> 16);
            VT[(vt_v4 + 2) * 20 + vt_t] = (bf16_t)(vv.y & 0xffff); VT[(vt_v4 + 3) * 20 + vt_t] = (bf16_t)(vv.y >> 16);
        }
        __syncthreads();
        { const int scn = sc < 15 ? sc + 1 : 15; HG_PREFETCH(scn); }
        const uint2 vtu = *(const uint2*)(VT + (16 * wid + c) * 20 + 4 * gq);
        const bf16x8 vtf = MK8(vtu.x, vtu.y, 0u, 0u);
        if (MODE != 0) {
            f32x4 AT = {0.f, 0.f, 0.f, 0.f};
#pragma unroll
            for (int ks = 0; ks < 4; ++ks) {
                const bf16x8 a = *(const bf16x8*)(KT + c * 136 + ks * 32 + gq * 8);
                const bf16x8 bq = *(const bf16x8*)(QT + c * 136 + ks * 32 + gq * 8);
                AT = __builtin_amdgcn_mfma_f32_16x16x32_bf16(a, bq, AT, 0, 0, 0);
            }
#pragma unroll
            for (int r = 0; r < 4; ++r) if (4 * gq + r > c) AT[r] = 0.f;
            const bf16x8 pfv = MK8(pack2(AT[0], AT[1]), pack2(AT[2], AT[3]), 0u, 0u);
            f32x4 oT = {0.f, 0.f, 0.f, 0.f};
            oT = __builtin_amdgcn_mfma_f32_16x16x32_bf16(vtf, pfv, oT, 0, 0, 0);
#pragma unroll
            for (int u = 0; u < 4; ++u) {
                const bf16x8 sfv = MK8(pack2(S[2 * u][0], S[2 * u][1]), pack2(S[2 * u][2], S[2 * u][3]), pack2(S[2 * u + 1][0], S[2 * u + 1][1]), pack2(S[2 * u + 1][2], S[2 * u + 1][3]));
                const uint2 q0 = *(const uint2*)(QT + c * 136 + 32 * u + 4 * gq), q1 = *(const uint2*)(QT + c * 136 + 32 * u + 16 + 4 * gq);
                const bf16x8 qpv = MK8(q0.x, q0.y, q1.x, q1.y);
                oT = __builtin_amdgcn_mfma_f32_16x16x32_bf16(sfv, qpv, oT, 0, 0, 0);
            }
            const int pos = sc * 16 + c;
            const int ti = (MODE == 1) ? pos : 255 - pos;
            bf16_t* op = OSEG + ti * 68 + 16 * wid + 4 * gq;
            if (MODE == 2) {
                const uint2 old = *(const uint2*)op;
                oT[0] += __uint_as_float(old.x << 16); oT[1] += __uint_as_float(old.x & 0xffff0000u);
                oT[2] += __uint_as_float(old.y << 16); oT[3] += __uint_as_float(old.y & 0xffff0000u);
            }
            uint2 w; w.x = pack2(oT[0], oT[1]); w.y = pack2(oT[2], oT[3]);
            *(uint2*)op = w;
        }
#pragma unroll
        for (int kb = 0; kb < 8; ++kb) {
            const uint2 khu = *(const uint2*)(KH + (16 * kb + c) * 20 + 4 * gq);
            const bf16x8 kh = MK8(khu.x, khu.y, 0u, 0u);
            const f32x4 d4 = *(const f32x4*)(DD + 16 * kb + 4 * gq);
            S[kb] = __builtin_amdgcn_mfma_f32_16x16x32_bf16(kh, vtf, S[kb] * d4, 0, 0, 0);
        }
        __syncthreads();
    }
    if (MODE == 0) {
#pragma unroll
        for (int kb = 0; kb < 8; ++kb)
#pragma unroll
            for (int r = 0; r < 4; ++r) sst[(16 * kb + 4 * gq + r) * 64 + 16 * wid + c] = S[kb][r];
        if (hf == 0) ((float*)(p.ws + WS_DSEG))[(size_t)(chain * 33 + g) * 128 + k] = fexp(btot);
    }
#undef HG_ROW
#undef HG_PREFETCH
}

struct H1Pre { bf16_t z0, z1, z2, z3, z4, z5, z6, z7; uint2 vv; };
struct H1Ctx { int r0, sgn, zoff, hv, chain, g; float lbv, omlb, btot; f32x4 S[8]; };
__device__ void hgrn_h1_pair(const Params& p, int l, int b, int h, int g, char* smem) {
    const int tid = opaque_tid(), lane = tid & 63, wid = tid >> 6, c = lane & 15, gq = lane >> 4;
    const int k = tid >> 1, hf = tid & 1, vt_t = tid >> 4, vt_v4 = (tid & 15) * 4;
    const bf16_t* HG = (const bf16_t*)(p.ws + WS_HG);
    auto init = [&](H1Ctx& X, int dir) {
        if (dir == 0) { X.r0 = g == 0 ? T_LAT + b * 256 : b * 8192 + (g - 1) * 256; X.sgn = 1; }
        else { X.r0 = g == 0 ? T_LAT + b * 256 + 255 : b * 8192 + 8191 - (g - 1) * 256; X.sgn = -1; }
        X.lbv = ((const float*)(p.ws + WS_LB))[(dir * 4 + l) * 512 + h * 128 + k]; X.omlb = 1.0f - X.lbv;
        X.zoff = 512 + dir * 512 + h * 128 + k; X.hv = 1536 + h * 64 + vt_v4; X.chain = (dir * 4 + b) * 4 + h; X.g = g; X.btot = 0.f;
#pragma unroll
        for (int kb = 0; kb < 8; ++kb) X.S[kb] = (f32x4){0.f, 0.f, 0.f, 0.f};
    };
    auto prefetch = [&](const H1Ctx& X, H1Pre& R, int sc) {
        const bf16_t* zb = HG + X.zoff;
#define H1_ROW(T) ((size_t)(X.r0 + X.sgn * (sc * 16 + (T))) * 2048)
        R.z0 = zb[H1_ROW(hf * 8 + 0)]; R.z1 = zb[H1_ROW(hf * 8 + 1)]; R.z2 = zb[H1_ROW(hf * 8 + 2)]; R.z3 = zb[H1_ROW(hf * 8 + 3)];
        R.z4 = zb[H1_ROW(hf * 8 + 4)]; R.z5 = zb[H1_ROW(hf * 8 + 5)]; R.z6 = zb[H1_ROW(hf * 8 + 6)]; R.z7 = zb[H1_ROW(hf * 8 + 7)];
        R.vv = *(const uint2*)(HG + H1_ROW(vt_t) + X.hv);
#undef H1_ROW
    };
    auto elem = [&](H1Ctx& X, const H1Pre& R, char* sm) {
        bf16_t* KH = (bf16_t*)(sm + HG_KH); bf16_t* VT = (bf16_t*)(sm + HG_VT); float* DD = (float*)(sm + HG_DD);
        const bf16_t zz[8] = {R.z0, R.z1, R.z2, R.z3, R.z4, R.z5, R.z6, R.z7};
        float bt[8], ky[8]; float cum = 0.f;
#pragma unroll
        for (int i = 0; i < 8; ++i) {
            const float e = fexp(-bf2f(zz[i]));
            const float sg = __builtin_amdgcn_rcpf(1.0f + e);
            cum += __builtin_amdgcn_logf(fmaxf(X.lbv + X.omlb * sg, 1e-30f)) * 0.6931471805599453f;
            bt[i] = cum; ky[i] = X.omlb * (1.0f - sg);
        }
        const float other = __shfl_xor(cum, 1);
        const float blast = cum + other, add = hf ? other : 0.f;
#pragma unroll
        for (int i = 0; i < 8; ++i) KH[k * 20 + hf * 8 + i] = f2bf(ky[i] * fexp(blast - (bt[i] + add)));
        if (hf == 0) DD[k] = fexp(blast);
        X.btot += blast;
        VT[(vt_v4 + 0) * 20 + vt_t] = (bf16_t)(R.vv.x & 0xffff); VT[(vt_v4 + 1) * 20 + vt_t] = (bf16_t)(R.vv.x >> 16);
        VT[(vt_v4 + 2) * 20 + vt_t] = (bf16_t)(R.vv.y & 0xffff); VT[(vt_v4 + 3) * 20 + vt_t] = (bf16_t)(R.vv.y >> 16);
    };
    auto update = [&](H1Ctx& X, const char* sm) {
        const bf16_t* KH = (const bf16_t*)(sm + HG_KH); const bf16_t* VT = (const bf16_t*)(sm + HG_VT); const float* DD = (const float*)(sm + HG_DD);
        const uint2 vtu = *(const uint2*)(VT + (16 * wid + c) * 20 + 4 * gq);
        const bf16x8 vtf = MK8(vtu.x, vtu.y, 0u, 0u);
#pragma unroll
        for (int kb = 0; kb < 8; ++kb) {
            const uint2 khu = *(const uint2*)(KH + (16 * kb + c) * 20 + 4 * gq);
            const f32x4 d4 = *(const f32x4*)(DD + 16 * kb + 4 * gq);
            X.S[kb] = __builtin_amdgcn_mfma_f32_16x16x32_bf16(MK8(khu.x, khu.y, 0u, 0u), vtf, X.S[kb] * d4, 0, 0, 0);
        }
    };
    auto store = [&](H1Ctx& X) {
        float* sst = (float*)(p.ws + WS_SST) + (size_t)(X.chain * 33 + X.g) * 8192;
#pragma unroll
        for (int kb = 0; kb < 8; ++kb)
#pragma unroll
            for (int r = 0; r < 4; ++r) sst[(16 * kb + 4 * gq + r) * 64 + 16 * wid + c] = X.S[kb][r];
        if (hf == 0) ((float*)(p.ws + WS_DSEG))[(size_t)(X.chain * 33 + X.g) * 128 + k] = fexp(X.btot);
    };
    H1Ctx A, B; H1Pre A0, A1, B0, B1;
    init(A, 0); init(B, 1);
    prefetch(A, A0, 0); prefetch(B, B0, 0); prefetch(A, A1, 1); prefetch(B, B1, 1);
    for (int sc = 0; sc < 16; sc += 2) {
        elem(A, A0, smem); elem(B, B0, smem + 17408);
        __syncthreads();
        { const int scn = sc + 2 < 16 ? sc + 2 : 15; prefetch(A, A0, scn); prefetch(B, B0, scn); }
        update(A, smem); update(B, smem + 17408);
        __syncthreads();
        elem(A, A1, smem); elem(B, B1, smem + 17408);
        __syncthreads();
        { const int scn = sc + 3 < 16 ? sc + 3 : 15; prefetch(A, A1, scn); prefetch(B, B1, scn); }
        update(A, smem); update(B, smem + 17408);
        __syncthreads();
    }
    store(A); store(B);
}
__device__ void hgrn3_unit(const Params& p, int l, int u, char* smem) {
    const int tb = u % 33, bh = u / 33, h = bh & 3, b = bh >> 2;
    hgrn_pass<1>(p, l, 0, b, h, tb, smem);
    hgrn_pass<2>(p, l, 1, b, h, tb == 0 ? 0 : 33 - tb, smem);
    const int ti = opaque_tid();
    const int row = tb == 0 ? T_LAT + b * 256 + ti : b * 8192 + (tb - 1) * 256 + ti;
    const bf16_t* OSEG = (const bf16_t*)(smem + HG_OSEG) + ti * 68;
    const bf16_t* gp = (const bf16_t*)(p.ws + WS_HG) + (size_t)row * 2048 + 1792 + h * 64;
    const float* gn = p.hg_norm_g + l * 64;
    bf16_t* yp = (bf16_t*)(p.ws + WS_H) + (size_t)row * 1024 + 768 + h * 64;
    float ss = 0.f;
#pragma unroll
    for (int q = 0; q < 16; ++q) {
        const uint2 w = *(const uint2*)(OSEG + q * 4);
        const float a0 = __uint_as_float(w.x << 16), a1 = __uint_as_float(w.x & 0xffff0000u), a2 = __uint_as_float(w.y << 16), a3 = __uint_as_float(w.y & 0xffff0000u);
        ss += a0 * a0 + a1 * a1 + a2 * a2 + a3 * a3;
    }
    const float rinv = rsqrtf(ss * (1.0f / 64.0f) + EPS);
#pragma unroll
    for (int q = 0; q < 16; ++q) {
        const uint2 w = *(const uint2*)(OSEG + q * 4);
        const uint2 gw = *(const uint2*)(gp + q * 4);
        float o[4] = {__uint_as_float(w.x << 16), __uint_as_float(w.x & 0xffff0000u), __uint_as_float(w.y << 16), __uint_as_float(w.y & 0xffff0000u)};
        const float gt[4] = {__uint_as_float(gw.x << 16), __uint_as_float(gw.x & 0xffff0000u), __uint_as_float(gw.y << 16), __uint_as_float(gw.y & 0xffff0000u)};
#pragma unroll
        for (int j = 0; j < 4; ++j) { const float sl = gt[j] / (1.0f + fexp(-gt[j])); o[j] = o[j] * rinv * gn[q * 4 + j] * sl; }
        uint2 ow; ow.x = pack2(o[0], o[1]); ow.y = pack2(o[2], o[3]);
        *(uint2*)(yp + q * 4) = ow;
    }
    __syncthreads();
}

__device__ void convert_T(const float* in, int K, int Nin, bf16_t* out, int Nout, int mode, const float* gs, size_t gtid, size_t gthreads) {
    const size_t total = (size_t)Nout * (K / 8);
    for (size_t idx = gtid; idx < total; idx += gthreads) {
        const int n = (int)(idx % Nout), k8 = (int)(idx / Nout);
        int src = n;
        if (mode == 1) {
            if (n < 1536) src = n; else if (n < 3584) src = n + 32; else if (n < 3616) src = n - 3584 + 1536; else src = -1;
        } else if (mode == 2) {
            const int hh = n >> 7, d = n & 127; src = d < 96 ? hh * 96 + d : -1;
        }
        float v[8];
#pragma unroll
        for (int j = 0; j < 8; ++j) {
            const int k = k8 * 8 + j;
            v[j] = src >= 0 ? in[(size_t)k * Nin + src] * (gs ? gs[k] : 1.0f) : 0.f;
        }
        uint4 w; w.x = pack2(v[0], v[1]); w.y = pack2(v[2], v[3]); w.z = pack2(v[4], v[5]); w.w = pack2(v[6], v[7]);
        *(uint4*)(out + (size_t)n * K + k8 * 8) = w;
    }
}
__device__ void convert_layer(const Params& p, int l, size_t gtid, size_t gthreads) {
    convert_T(p.w_in + (size_t)l * 1024 * 3616, 1024, 3616, (bf16_t*)(p.ws + WS_WIN), NIN, 1, nullptr, gtid, gthreads);
    convert_T(p.w_out + (size_t)l * 1024 * 1024, 1024, 1024, (bf16_t*)(p.ws + WS_WOUT), 1024, 0, nullptr, gtid, gthreads);
    convert_T(p.w_ff1 + (size_t)l * 1024 * 4096, 1024, 4096, (bf16_t*)(p.ws + WS_WFF1), 4096, 0, nullptr, gtid, gthreads);
    convert_T(p.w_ff2 + (size_t)l * 4096 * 1024, 4096, 1024, (bf16_t*)(p.ws + WS_WFF2), 1024, 0, nullptr, gtid, gthreads);
    convert_T(p.w_uq + (size_t)l * 256 * 576, 256, 576, (bf16_t*)(p.ws + WS_WUQ), 768, 2, p.g_cq + l * 256, gtid, gthreads);
    convert_T(p.w_ukv + (size_t)l * 128 * 768, 128, 768, (bf16_t*)(p.ws + WS_WUKV), 768, 0, p.g_ckv + l * 128, gtid, gthreads);
}
__device__ void adaln_phase(const Params& p, int l, const float* g, int shift_off, int scale_off, int nrows) {
    const int lane = opaque_tid() & 63;
    const int gw = blockIdx.x * 4 + (threadIdx.x >> 6), nw = gridDim.x * 4;
    bf16_t* H = (bf16_t*)(p.ws + WS_H);
    const bool from_input = (l == 0 && shift_off == 0);
    f32x4 v0, v1, v2, v3, n0, n1, n2, n3;
    v0 = v1 = v2 = v3 = n0 = n1 = n2 = n3 = (f32x4){0.f, 0.f, 0.f, 0.f};
    if (gw < nrows) { const float* xp = (from_input ? xrow_in(p, gw) : xrow(p, gw)) + lane * 4; v0 = *(const f32x4*)(xp); v1 = *(const f32x4*)(xp + 256); v2 = *(const f32x4*)(xp + 512); v3 = *(const f32x4*)(xp + 768); }
    for (int row = gw; row < nrows; row += nw) {
        const int nrow = row + nw;
        if (nrow < nrows) { const float* xp = (from_input ? xrow_in(p, nrow) : xrow(p, nrow)) + lane * 4; n0 = *(const f32x4*)(xp); n1 = *(const f32x4*)(xp + 256); n2 = *(const f32x4*)(xp + 512); n3 = *(const f32x4*)(xp + 768); }
        int b, key; bool lat; row_bk(row, b, key, lat);
        const float* md = (const float*)(p.ws + WS_MOD) + (size_t)(l * 5 + (lat ? b : 4)) * 6144;
        const f32x4 v[4] = {v0, v1, v2, v3};
        float ss = 0.f;
#pragma unroll
        for (int i = 0; i < 4; ++i) ss += v[i][0] * v[i][0] + v[i][1] * v[i][1] + v[i][2] * v[i][2] + v[i][3] * v[i][3];
#pragma unroll
        for (int o = 32; o >= 1; o >>= 1) ss += __shfl_xor(ss, o);
        const float rinv = rsqrtf(ss * (1.0f / 1024.0f) + EPS);
#pragma unroll
        for (int i = 0; i < 4; ++i) {
            const int d = i * 256 + lane * 4;
            const f32x4 gg = *(const f32x4*)(g + d), sh = *(const f32x4*)(md + shift_off + d), sc = *(const f32x4*)(md + scale_off + d);
            float o[4];
#pragma unroll
            for (int j = 0; j < 4; ++j) o[j] = v[i][j] * rinv * gg[j] * (1.0f + sc[j]) + sh[j];
            uint2 w; w.x = pack2(o[0], o[1]); w.y = pack2(o[2], o[3]);
            *(uint2*)(H + (size_t)row * 1024 + d) = w;
        }
        v0 = n0; v1 = n1; v2 = n2; v3 = n3;
    }
}
__device__ void phase0(const Params& p, char* smem) {
    const size_t gtid = (size_t)blockIdx.x * 256 + threadIdx.x, gthreads = (size_t)gridDim.x * 256;
    const int tid = opaque_tid();
    if (gtid < 2 * 512) {
        const int dir = (int)gtid >> 9, cidx = (int)gtid & 511;
        float e[4], mx = -1e30f, s = 0.f;
#pragma unroll
        for (int l = 0; l < 4; ++l) { e[l] = p.hg_lb[(dir * 4 + l) * 512 + cidx]; mx = fmaxf(mx, e[l]); }
#pragma unroll
        for (int l = 0; l < 4; ++l) { e[l] = expf(e[l] - mx); s += e[l]; }
        float cum = 0.f;
#pragma unroll
        for (int l = 0; l < 4; ++l) { if (l > 0) cum += e[l] / s; ((float*)(p.ws + WS_LB))[(dir * 4 + l) * 512 + cidx] = cum; }
    }
    if (gtid >= 1024 && gtid < 1024 + 1024) {
        const int i = (int)gtid - 1024, pos = i >> 3, f = i & 7;
        const float inv = powf(10000.0f, -(float)f / 8.0f);
        const float ang = (float)pos * inv;
        ((float*)(p.ws + WS_ROPE))[i * 2] = cosf(ang); ((float*)(p.ws + WS_ROPE))[i * 2 + 1] = sinf(ang);
    }
    if (gtid >= 2048 && gtid < 2048 + 4) {
        const int l = (int)gtid - 2048;
        float s1 = 0.f, s2 = 0.f;
        for (int i = 0; i < 32; ++i) { s1 += p.da_lambda[(l * 4 + 0) * 32 + i] * p.da_lambda[(l * 4 + 1) * 32 + i]; s2 += p.da_lambda[(l * 4 + 2) * 32 + i] * p.da_lambda[(l * 4 + 3) * 32 + i]; }
        ((float*)(p.ws + WS_LAM))[l] = expf(s1) - expf(s2) + (0.8f - 0.6f * expf(-0.3f * (float)l));
    }
    if (gtid >= 4096 && gtid < 4096 + 512) ((unsigned*)(p.ws + WS_KMAX))[gtid - 4096] = 0u;
    float* sl = (float*)smem;
    float* red = sl + 5 * 1024;
    for (int i = tid; i < 5 * 1024; i += 256) {
        const int r = i >> 10, d = i & 1023;
        const float cv = r < 4 ? p.c[r * 1024 + d] : p.c_ctx[d];
        sl[i] = cv / (1.0f + expf(-cv));
    }
    __syncthreads();
    for (int u = blockIdx.x; u < 4 * 96; u += gridDim.x) {
        const int l = u / 96, cb = u % 96, col = tid & 63, kg = tid >> 6;
        const float* w = p.w_mod + (size_t)l * 1024 * 6144 + cb * 64 + col;
        float a[5] = {0.f, 0.f, 0.f, 0.f, 0.f};
        for (int d = kg * 256; d < kg * 256 + 256; ++d) {
            const float wv = w[(size_t)d * 6144];
#pragma unroll
            for (int r = 0; r < 5; ++r) a[r] += sl[r * 1024 + d] * wv;
        }
#pragma unroll
        for (int r = 0; r < 5; ++r) red[(kg * 5 + r) * 64 + col] = a[r];
        __syncthreads();
        if (tid < 64) {
#pragma unroll
            for (int r = 0; r < 5; ++r) {
                const float s = red[(0 * 5 + r) * 64 + tid] + red[(1 * 5 + r) * 64 + tid] + red[(2 * 5 + r) * 64 + tid] + red[(3 * 5 + r) * 64 + tid];
                ((float*)(p.ws + WS_MOD))[(size_t)(l * 5 + r) * 6144 + cb * 64 + tid] = s + p.b_mod[l * 6144 + cb * 64 + tid];
            }
        }
        __syncthreads();
    }
}
__device__ void hgrn_scan(const Params& p) {
    const size_t gtid = (size_t)blockIdx.x * 256 + opaque_tid(), gthreads = (size_t)gridDim.x * 256;
    float* sstb = (float*)(p.ws + WS_SST);
    const float* dseg = (const float*)(p.ws + WS_DSEG);
    for (size_t i = gtid; i < (size_t)32 * 8192; i += gthreads) {
        const int chain = (int)(i >> 13), e = (int)(i & 8191), k = e >> 6;
        float S = 0.f;
        float* sp = sstb + (size_t)chain * 33 * 8192 + e;
        const float* dp = dseg + (size_t)chain * 33 * 128 + k;
#pragma unroll 1
        for (int g0 = 0; g0 < 33; g0 += 11) {
            float t[11], d[11];
#pragma unroll
            for (int q = 0; q < 11; ++q) { t[q] = sp[(size_t)(g0 + q) * 8192]; d[q] = dp[(g0 + q) * 128]; }
#pragma unroll
            for (int q = 0; q < 11; ++q) { sp[(size_t)(g0 + q) * 8192] = S; S = d[q] * S + t[q]; }
        }
    }
}
__device__ void final_norm(const Params& p) {
    const int lane = opaque_tid() & 63;
    const int gw = blockIdx.x * 4 + (threadIdx.x >> 6), nw = gridDim.x * 4;
    for (int row = gw; row < T_LAT; row += nw) {
        float* xp = p.out + (size_t)row * 1024;
        f32x4 v[4]; float ss = 0.f;
#pragma unroll
        for (int i = 0; i < 4; ++i) { v[i] = *(const f32x4*)(xp + i * 256 + lane * 4); ss += v[i][0] * v[i][0] + v[i][1] * v[i][1] + v[i][2] * v[i][2] + v[i][3] * v[i][3]; }
#pragma unroll
        for (int o = 32; o >= 1; o >>= 1) ss += __shfl_xor(ss, o);
        const float rinv = rsqrtf(ss * (1.0f / 1024.0f) + EPS);
#pragma unroll
        for (int i = 0; i < 4; ++i) {
            const f32x4 gg = *(const f32x4*)(p.g_final + i * 256 + lane * 4);
            f32x4 o;
#pragma unroll
            for (int j = 0; j < 4; ++j) o[j] = v[i][j] * rinv * gg[j];
            *(f32x4*)(xp + i * 256 + lane * 4) = o;
        }
    }
}


#define XB_TMO      128
#define XB_XCNT(j)  (256  + 64 * (j))
#define XB_XSUB(j)  (1280 + 64 * (j))
#define XB_XGEN(j)  (2304 + 64 * (j))
#define XB_TOP      3328
#define XB_TOPGEN   3392
#define XCD_BAR_WORDS 3456
#define XB_SPIN_CAP (1u << 22)
__device__ __forceinline__ unsigned xb_ld(unsigned* p)              { return __hip_atomic_load(p, __ATOMIC_RELAXED, __HIP_MEMORY_SCOPE_AGENT); }
__device__ __forceinline__ unsigned xb_add(unsigned* p, unsigned v) { return __hip_atomic_fetch_add(p, v, __ATOMIC_RELAXED, __HIP_MEMORY_SCOPE_AGENT); }
__device__ __forceinline__ unsigned xb_xcc_id() { return (unsigned)__builtin_amdgcn_s_getreg((3 << 11) | 20) & 0xFu; }
#define XB_SPIN(cond, bar) do { unsigned _sp = 0; while (cond) { __builtin_amdgcn_s_sleep(0); \
    if ((++_sp & 255u) == 0u) { if (xb_ld(&(bar)[XB_TMO])) break; if (_sp > XB_SPIN_CAP) { atomicAdd(&(bar)[XB_TMO], 1u); break; } } } } while (0)
__device__ __forceinline__ void xcd_barrier_complete(unsigned* bar, unsigned x, unsigned& nloc, unsigned& nx) {
    const unsigned G = gridDim.x;
    unsigned sum, cnt, mine, sp = 0u;
    for (;;) {
        sum = 0u; cnt = 0u; mine = 0u;
#pragma unroll
        for (unsigned j = 0; j < 16; ++j) { const unsigned c = xb_ld(&bar[XB_XCNT(j)]); sum += c; cnt += (c > 0u) ? 1u : 0u; mine = (j == x) ? c : mine; }
        if (sum == G) break;
        __builtin_amdgcn_s_sleep(1);
        if ((++sp & 255u) == 0u) { if (xb_ld(&bar[XB_TMO])) break; if (sp > XB_SPIN_CAP) { atomicAdd(&bar[XB_TMO], 1u); break; } }
    }
    nloc = mine > 0u ? mine : 1u; nx = cnt > 0u ? cnt : 1u;
}
__device__ __forceinline__ void gsync(char* ws, unsigned& epoch) {
    asm volatile("s_waitcnt vmcnt(0) lgkmcnt(0)" ::: "memory");
    __syncthreads();
    ++epoch;
    if (threadIdx.x == 0) {
        extern __shared__ __attribute__((aligned(16))) char smem_[];
        volatile unsigned* st = (volatile unsigned*)(smem_ + 73728 + 768);
        unsigned* bar = (unsigned*)(ws + WS_XBAR);
        const unsigned x = xb_xcc_id();
        __builtin_amdgcn_s_waitcnt(0);
        unsigned nloc = st[0], nx = st[1];
        if (nloc == 0u) { xcd_barrier_complete(bar, x, nloc, nx); st[0] = nloc; st[1] = nx; }
        const unsigned old = xb_add(&bar[XB_XSUB(x)], 1u);
        const unsigned gen = old / nloc;
        if (old + 1u == (gen + 1u) * nloc) {
            __builtin_amdgcn_fence(__ATOMIC_RELEASE, "agent");
            asm volatile("s_waitcnt vmcnt(0)" ::: "memory");
            const unsigned og = xb_add(&bar[XB_TOP], 1u);
            const unsigned tg = og / nx;
            if (og + 1u == (tg + 1u) * nx) xb_add(&bar[XB_TOPGEN], 1u);
            else XB_SPIN(xb_ld(&bar[XB_TOPGEN]) == tg, bar);
            __builtin_amdgcn_fence(__ATOMIC_ACQUIRE, "agent");
            xb_add(&bar[XB_XGEN(x)], 1u);
            asm volatile("s_waitcnt vmcnt(0)" ::: "memory");
        } else {
            XB_SPIN(xb_ld(&bar[XB_XGEN(x)]) == gen, bar);
            __builtin_amdgcn_fence(__ATOMIC_ACQUIRE, "agent");
            asm volatile("s_waitcnt vmcnt(0)" ::: "memory");
        }
    }
    __syncthreads();
}

__device__ __forceinline__ int next_unit(char* ws, int qidx, char* smem) {
    int* sh = (int*)(smem + 73728 + 512);
    __syncthreads();
    if (threadIdx.x == 0) *sh = (int)__hip_atomic_fetch_add((unsigned*)(ws + WS_BAR + 32) + qidx, 1u, __ATOMIC_RELAXED, __HIP_MEMORY_SCOPE_AGENT);
    __syncthreads();
    return *sh;
}

__device__ __forceinline__ bool tile_of(int r, int nt, int total, int& tm, int& tn, int G = 8) {
    const int bx = blockIdx.x, nx = gridDim.x >> 3;
    const int L = (r * 8 + (bx & 7)) * nx + (bx >> 3);
    if (L >= total || nx != 64) { if (nx == 64) return false; const int u = bx + r * gridDim.x; if (u >= total) return false; tm = u / nt; tn = u % nt; return true; }
    const int mg = L / (nt * G), rem = L % (nt * G);
    tn = rem / G; tm = mg * G + (rem % G);
    return true;
}
__device__ __forceinline__ Params launder(const Params& p) {
    Params q = p;
    GAS char* w = (GAS char*)p.ws; GAS float* o = (GAS float*)p.out;
    asm volatile("" : "+s"(w), "+s"(o));
    q.ws = (char*)w; q.out = (float*)o;
    return q;
}
__global__ void __launch_bounds__(256, 2) fwd_megakernel(Params p0) {
    extern __shared__ __attribute__((aligned(16))) char smem[];
    cg::grid_group grid = cg::this_grid();
    const size_t gtid = (size_t)blockIdx.x * 256 + threadIdx.x, gthreads = (size_t)gridDim.x * 256;
    float* rs = (float*)(smem + 73728);
    unsigned epoch = 0;
    if (threadIdx.x == 0) { volatile unsigned* st = (volatile unsigned*)(smem + 73728 + 768); st[0] = 0u; st[1] = 0u; (void)xb_add((unsigned*)(p0.ws + WS_XBAR) + XB_XCNT(xb_xcc_id()), 1u); }
    __syncthreads();
    grid.sync();

#ifndef OPK
#define OPK 1024
#define OPK0 0
#endif
#ifndef REP_SKIP_ATT
#define REP_SKIP_ATT 0
#endif
#ifndef REP_B
#define REP_B 1
#endif
#ifndef REP_D
#define REP_D 1
#endif
#ifndef REP_E
#define REP_E 1
#endif
#ifndef REP_H
#define REP_H 1
#endif
#ifndef PM
#define PM 0xffff
#endif
    { const Params p = launder(p0); if (PM & 1) phase0(p, smem); }
    { const Params p = launder(p0); if (PM & 2) convert_layer(p, 0, gtid, gthreads); }
    gsync(p0.ws, epoch);

    for (int l = 0; l < 4; ++l) {
        const bool last = (l == 3);
        { const Params p = launder(p0); if (PM & 4) adaln_phase(p, l, p.g_mix + l * 1024, 0, 1024, T_ALL); }
        { const Params p = launder(p0); if ((PM & 2) && l > 0) convert_layer(p, l, gtid, gthreads); }
        gsync(p0.ws, epoch);
        const bool split_tail = (gridDim.x == 512);
        if ((PM & 8) && split_tail && blockIdx.x < 488) {
            const Params p = launder(p0);
            const int L = 3584 + (blockIdx.x >> 1), mg = L / 116, rem = L % 116;
            const int tn = rem >> 2, row0 = (mg * 4 + (rem & 3)) * 256 + (blockIdx.x & 1) * 128;
            gemm_tile_core((const bf16_t*)(p.ws + WS_H) + (size_t)row0 * 1024, 1024, (const bf16_t*)(p.ws + WS_WIN) + (size_t)tn * 128 * 1024, 1024, 1024, smem);
            epi_inproj(p, l, row0, tn, (const float*)smem);
            __syncthreads();
        }
        if (PM & 8) for (int rr = 0;; ++rr) {
            int tm, tn; if (!tile_of(rr, 29, split_tail ? 3584 : 132 * 29, tm, tn, 4)) break;
            const Params p = launder(p0);
            Acc2 C;
            gemm_tile_core2((const bf16_t*)(p.ws + WS_H) + (size_t)tm * 256 * 1024, 1024, (const bf16_t*)(p.ws + WS_WIN) + (size_t)tn * 128 * 1024, 1024, 1024, smem, C);
            gemm2_stage(C, 0, smem);
            epi_inproj(p, l, tm * 256, tn, (const float*)smem);
            __syncthreads();
            gemm2_stage(C, 1, smem);
            epi_inproj(p, l, tm * 256 + 128, tn, (const float*)smem);
            __syncthreads();
        }
        gsync(p0.ws, epoch);
        for (int rep = 0; rep < REP_D; ++rep) { if (rep) gsync(p0.ws, epoch);
        for (;;) {
            const int u = next_unit(p0.ws, l * 2 + 0 + rep * 8, smem);
            if (u >= 528 + 2 * 1584) break;
            const Params p = launder(p0);
            if (u < 528) { if (PM & 16) {
                const int g = u % 33, ch = u / 33, h = ch & 3, b = (ch >> 2) & 3;
                hgrn_h1_pair(p, l, b, h, g, smem); }
            } else if (!(PM & 32)) {} else if (u < 528 + 1584) {
                const int v = u - 528, tm = v / 6, h = v % 6;
                row_rstd(p, 0, tm * 128, rs);
                gemm_tile_core((const bf16_t*)(p.ws + WS_CQ) + (size_t)tm * 128 * 256, 256, (const bf16_t*)(p.ws + WS_WUQ) + (size_t)h * 128 * 256, 256, 256, smem);
                epi_uq(p, tm * 128, h, (const float*)smem, rs);
                __syncthreads();
            } else {
                const int v = u - 528 - 1584, tm = v / 6, h = v % 6;
                row_rstd(p, 1, tm * 128, rs);
                gemm_tile_core((const bf16_t*)(p.ws + WS_CKV) + (size_t)tm * 128 * 128, 128, (const bf16_t*)(p.ws + WS_WUKV) + (size_t)h * 128 * 128, 128, 128, smem);
                epi_ukv(p, l, tm * 128, h, (const float*)smem, rs);
                __syncthreads();
            }
        } }
        gsync(p0.ws, epoch);
        { const Params p = launder(p0); if (PM & 64) hgrn_scan(p); }
        gsync(p0.ws, epoch);
        {
            { int* st2 = (int*)(smem + 73728 + 520); __syncthreads(); if (threadIdx.x == 0) { st2[0] = 0; } }
            for (;;) {
                    int* sh = (int*)(smem + 73728 + 512);
                    __syncthreads();
                    if (threadIdx.x == 0) {
                        const int qlen_ = 450 + (l == 3 ? 0 : 12);
                        const unsigned xq_ = xb_xcc_id() & 7u;
                        int dq_ = sh[2], got = -1, qq = 0;
                        while (dq_ < 8) {
                            qq = (int)((xq_ + dq_) & 7u);
                            const int v = (int)__hip_atomic_fetch_add((unsigned*)(p0.ws + WS_XBAR) + l * 8 + qq, 1u, __ATOMIC_RELAXED, __HIP_MEMORY_SCOPE_AGENT);
                            if (v < qlen_) { got = v; break; }
                            ++dq_;
                        }
                        sh[2] = dq_; sh[0] = got; sh[1] = qq;
                    }
                    __syncthreads();
                    const int i = __builtin_amdgcn_readfirstlane(sh[0]), q = __builtin_amdgcn_readfirstlane(sh[1]);
                    if (i < 0) break;
                    const Params p = launder(p0);
                    const int nh3 = (i + 2) / 3 < 66 ? (i + 2) / 3 : 66;
                    if (i < 450 && i % 3 == 0 && i / 3 < 66) { if (PM & 256) hgrn3_unit(p, l, q * 66 + i / 3, smem); }
                    else {
                        int b, hh, qbi;
                        if (i < 450) { const int a = i - nh3; const int bh = q + 8 * (a >> 6); qbi = a & 63; b = (bh / 6) & 3; hh = (bh >= 24 ? 6 : 0) + bh % 6; }
                        else { const int cidx = q * 12 + (i - 450); qbi = 64 + (cidx & 1); const int bh = cidx >> 1; hh = bh % 12; b = bh / 12; }
                        if (PM & 128) attn_unit(p, l, b, hh, qbi, smem);
                    }
            }
        }
        gsync(p0.ws, epoch);
        const int ntm = last ? 256 : 264;
        if (PM & 512) {
            if (!last && blockIdx.x < 64) {
                const Params p = launder(p0);
                const int tm = 256 + (blockIdx.x >> 3), tn = blockIdx.x & 7;
                gemm_tile_core((const bf16_t*)(p.ws + WS_H) + (size_t)tm * 128 * 1024, 1024, (const bf16_t*)(p.ws + WS_WOUT) + (size_t)tn * 128 * 1024, 1024, 1024, smem);
                epi_resid(p, l, tm * 128, tn * 128, 2 * 1024, (const float*)smem);
                __syncthreads();
            }
            for (int rr = 0;; ++rr) {
                int tm, tn; if (!tile_of(rr, 8, 128 * 8, tm, tn, 4)) break;
                const Params p = launder(p0);
                Acc2 C;
                gemm_tile_core2((const bf16_t*)(p.ws + WS_H) + (size_t)tm * 256 * 1024, 1024, (const bf16_t*)(p.ws + WS_WOUT) + (size_t)tn * 128 * 1024, 1024, 1024, smem, C);
                gemm2_stage(C, 0, smem);
                epi_resid(p, l, tm * 256, tn * 128, 2 * 1024, (const float*)smem);
                __syncthreads();
                gemm2_stage(C, 1, smem);
                epi_resid(p, l, tm * 256 + 128, tn * 128, 2 * 1024, (const float*)smem);
                __syncthreads();
            }
        }
        gsync(p0.ws, epoch);
        { const Params p = launder(p0); adaln_phase(p, l, p.g_mlp + l * 1024, 3 * 1024, 4 * 1024, ntm * 128); }
        gsync(p0.ws, epoch);
        if ((PM & 1024) && !last && blockIdx.x < 256) {
            const Params p = launder(p0);
            const int tm = 256 + (blockIdx.x >> 5), tn = blockIdx.x & 31;
            gemm_tile_core((const bf16_t*)(p.ws + WS_H) + (size_t)tm * 128 * 1024, 1024, (const bf16_t*)(p.ws + WS_WFF1) + (size_t)tn * 128 * 1024, 1024, 1024, smem);
            epi_ff1(p, tm * 128, tn * 128, (const float*)smem);
            __syncthreads();
        }
        if (PM & 1024) for (int rr = 0;; ++rr) {
            int tm, tn; if (!tile_of(rr, 32, 128 * 32, tm, tn, 4)) break;
            const Params p = launder(p0);
            Acc2 C;
            gemm_tile_core2((const bf16_t*)(p.ws + WS_H) + (size_t)tm * 256 * 1024, 1024, (const bf16_t*)(p.ws + WS_WFF1) + (size_t)tn * 128 * 1024, 1024, 1024, smem, C);
            gemm2_stage(C, 0, smem);
            epi_ff1(p, tm * 256, tn * 128, (const float*)smem);
            __syncthreads();
            gemm2_stage(C, 1, smem);
            epi_ff1(p, tm * 256 + 128, tn * 128, (const float*)smem);
            __syncthreads();
        }
        gsync(p0.ws, epoch);
        if (PM & 2048) {
            if (!last && blockIdx.x < 64) {
                const Params p = launder(p0);
                const int tm = 256 + (blockIdx.x >> 3), tn = blockIdx.x & 7;
                gemm_tile_core((const bf16_t*)(p.ws + WS_H1) + (size_t)tm * 128 * 4096, 4096, (const bf16_t*)(p.ws + WS_WFF2) + (size_t)tn * 128 * 4096, 4096, 4096, smem);
                epi_resid(p, l, tm * 128, tn * 128, 5 * 1024, (const float*)smem);
                __syncthreads();
            }
            for (int rr = 0;; ++rr) {
                int tm, tn; if (!tile_of(rr, 8, 128 * 8, tm, tn, 4)) break;
                const Params p = launder(p0);
                Acc2 C;
                gemm_tile_core2((const bf16_t*)(p.ws + WS_H1) + (size_t)tm * 256 * 4096, 4096, (const bf16_t*)(p.ws + WS_WFF2) + (size_t)tn * 128 * 4096, 4096, 4096, smem, C);
                gemm2_stage(C, 0, smem);
                epi_resid(p, l, tm * 256, tn * 128, 5 * 1024, (const float*)smem);
                __syncthreads();
                gemm2_stage(C, 1, smem);
                epi_resid(p, l, tm * 256 + 128, tn * 128, 5 * 1024, (const float*)smem);
                __syncthreads();
            }
        }
        gsync(p0.ws, epoch);
    }
    { const Params p = launder(p0); final_norm(p); }
}

extern "C" void kernel_launch(void* const* d_in, const int* in_sizes, int n_in, void* d_out, int out_size, void* d_ws, size_t ws_size, hipStream_t stream) {
    static int grid_blocks = 0;
    if (!grid_blocks) {
        int dev = 0, cus = 0, per_cu = 0;
        hipGetDevice(&dev);
        hipDeviceGetAttribute(&cus, hipDeviceAttributeMultiprocessorCount, dev);
        hipFuncSetAttribute((const void*)fwd_megakernel, hipFuncAttributeMaxDynamicSharedMemorySize, SMEM_BYTES);
        hipOccupancyMaxActiveBlocksPerMultiprocessor(&per_cu, (const void*)fwd_megakernel, 256, SMEM_BYTES);
        if (per_cu < 1) per_cu = 1;
        if (per_cu > 2) per_cu = 2;
        grid_blocks = cus * per_cu;
        if (ws_size < WS_END2) fprintf(stderr, "workspace too small: %zu < %zu\n", ws_size, (size_t)WS_END2);
    }
    hipMemsetAsync((char*)d_ws + WS_BAR, 0, 128, stream);
    hipMemsetAsync((char*)d_ws + WS_XBAR, 0, XCD_BAR_WORDS * 4, stream);
    Params p{};
    const float** pp = (const float**)&p;
    for (int i = 0; i < 21; ++i) pp[i] = (const float*)d_in[i];
    p.out = (float*)d_out; p.ws = (char*)d_ws;
    void* args[] = {&p};
    hipError_t e = hipLaunchCooperativeKernel((const void*)fwd_megakernel, dim3(grid_blocks), dim3(256), args, SMEM_BYTES, stream);
    if (e != hipSuccess) fprintf(stderr, "cooperative launch failed: %s (grid %d)\n", hipGetErrorString(e), grid_blocks);
}
```
